# Optimizing an MI355X kernel written in HIP

```python
import jax, jax.numpy as jnp
from jax import lax
import numpy as np


D_MODEL = 1024
BATCH = 1
SEQ = 16384
DEPTH = 1
DEC_BATCH = 128
DEC_SEQ = 4
PAST_LEN = 16384
PAGE_SIZE = 128

MIX_WIDTH = D_MODEL
GLA_WIDTH = MIX_WIDTH // 2
GLA_HEADS = 4
GLA_HEAD_V = GLA_WIDTH // GLA_HEADS
GLA_HEAD_K = GLA_HEAD_V // 2
GLA_KEY_WIDTH = GLA_HEADS * GLA_HEAD_K
GLA_GATE_RANK = 16
GLA_GATE_TAU = 16.0
GLA_CHUNK = 64
SWA_WIDTH = MIX_WIDTH - GLA_WIDTH
SWA_HEAD_DIM = 64
SWA_Q_HEADS = SWA_WIDTH // SWA_HEAD_DIM
SWA_KV_HEADS = 2
SWA_GROUP = SWA_Q_HEADS // SWA_KV_HEADS
SWA_KV_WIDTH = SWA_KV_HEADS * SWA_HEAD_DIM
WINDOW = 128
D_IN = 2 * GLA_KEY_WIDTH + 2 * GLA_WIDTH + GLA_GATE_RANK + SWA_WIDTH + 2 * SWA_KV_WIDTH
D_FF = 2816
NORM_EPS = 1e-6

kernel_name = 'hymba_gla_swa_macaron_step'


def _rms_norm(x, g):
    xf = x.astype(jnp.float32)
    y = xf * lax.rsqrt(jnp.mean(xf * xf, axis=-1, keepdims=True) + NORM_EPS)
    return (y * g.astype(jnp.float32)).astype(x.dtype)


def _swiglu(h, w_gate, w_up, w_down):
    return (jax.nn.silu(h @ w_gate) * (h @ w_up)) @ w_down


def _split_proj(proj):
    widths = (GLA_KEY_WIDTH, GLA_KEY_WIDTH, GLA_WIDTH, GLA_WIDTH, GLA_GATE_RANK,
              SWA_WIDTH, SWA_KV_WIDTH, SWA_KV_WIDTH)
    offsets = []
    acc = 0
    for w in widths[:-1]:
        acc += w
        offsets.append(acc)
    return jnp.split(proj, offsets, axis=-1)


def _gla_chunked(q, k, v, log_a, s0):
    b, t, h, dk = q.shape
    dv = v.shape[-1]
    c = min(GLA_CHUNK, t)
    n = t // c

    def to_chunks(a):
        return jnp.moveaxis(a.reshape(b, n, c, h, a.shape[-1]), 1, 0)

    causal = jnp.tril(jnp.ones((c, c), dtype=bool))[None, :, :, None, None]

    def step(s, inp):
        qc, kc, vc, gc = inp
        cum = jnp.cumsum(gc, axis=1)
        diff = cum[:, :, None] - cum[:, None, :]
        decay = jnp.exp(jnp.where(causal, diff, -jnp.inf))
        attn = jnp.einsum('bihd,bjhd,bijhd->bhij', qc, kc, decay)
        o = (jnp.einsum('bhij,bjhv->bihv', attn, vc)
             + jnp.einsum('bihd,bhdv->bihv', qc * jnp.exp(cum), s))
        last = cum[:, -1]
        s = (s * jnp.exp(last)[..., None]
             + jnp.einsum('bjhd,bjhv->bhdv', kc * jnp.exp(last[:, None] - cum), vc))
        return s, o

    s, o = lax.scan(step, s0, (to_chunks(q), to_chunks(k), to_chunks(v), to_chunks(log_a)))
    return jnp.moveaxis(o, 0, 1).reshape(b, t, h, dv), s


def _sink_softmax(scores, mask, sinks):
    s = jnp.where(mask, scores, -jnp.inf)
    sink = sinks[:, :, None, None]
    m = jnp.maximum(jnp.max(s, axis=-1, keepdims=True), sink)
    p = jnp.exp(s - m)
    denom = jnp.sum(p, axis=-1, keepdims=True) + jnp.exp(sink - m)
    return p / denom


def _swa_prompt(q, k, v, sinks):
    b, s, _, hd = q.shape
    w = WINDOW
    nb = s // w
    qb = q.reshape(b, nb, w, SWA_KV_HEADS, SWA_GROUP, hd)
    pad = ((0, 0), (1, 0), (0, 0), (0, 0), (0, 0))
    kb = k.reshape(b, nb, w, SWA_KV_HEADS, hd)
    vb = v.reshape(b, nb, w, SWA_KV_HEADS, hd)
    kk = jnp.concatenate([jnp.pad(kb[:, :-1], pad), kb], axis=2)
    vv = jnp.concatenate([jnp.pad(vb[:, :-1], pad), vb], axis=2)
    scores = jnp.einsum('bnqhgd,bnkhd->bnhgqk', qb, kk,
                        preferred_element_type=jnp.float32) * (hd ** -0.5)
    qi = jnp.arange(w)[:, None] + w
    kj = jnp.arange(2 * w)[None, :]
    band = (kj <= qi) & (qi - kj < w)
    first = (jnp.arange(nb)[:, None, None] > 0) | (kj[None] >= w)
    mask = (band[None] & first)[None, :, None, None]
    p = _sink_softmax(scores, mask, sinks)
    o = jnp.einsum('bnhgqk,bnkhd->bnqhgd', p.astype(v.dtype), vv).reshape(b, s, SWA_WIDTH)
    cw = min(WINDOW, s)
    return o, k[:, s - cw:], v[:, s - cw:]


def _swa_sample(q, k, v, k_cache, v_cache, sinks):
    b, t, _, hd = q.shape
    cw = k_cache.shape[1]
    kk = jnp.concatenate([k_cache, k], axis=1)
    vv = jnp.concatenate([v_cache, v], axis=1)
    qg = q.reshape(b, t, SWA_KV_HEADS, SWA_GROUP, hd)
    scores = jnp.einsum('bqhgd,bkhd->bhgqk', qg, kk,
                        preferred_element_type=jnp.float32) * (hd ** -0.5)
    rel = jnp.arange(cw + t)[None, :] - cw
    qi = jnp.arange(t)[:, None]
    mask = ((rel <= qi) & (qi - rel < WINDOW))[None, None, None]
    p = _sink_softmax(scores, mask, sinks)
    o = jnp.einsum('bhgqk,bkhd->bqhgd', p.astype(v.dtype), vv).reshape(b, t, SWA_WIDTH)
    return o, kk[:, -cw:], vv[:, -cw:]


def _layer(x, gla_s0, k_cache, v_cache, p):
    b, t, _ = x.shape
    f32 = jnp.float32
    x = x + 0.5 * _swiglu(_rms_norm(x, p['ffn1_norm']), p['ffn1_w_gate'], p['ffn1_w_up'], p['ffn1_w_down'])
    h = _rms_norm(x, p['mix_norm'])
    q_g, k_g, v_g, r_g, a_lr, q_s, k_s, v_s = _split_proj(h @ p['w_in'])

    def heads(a, n):
        return a.reshape(b, t, n, -1)

    log_a = jax.nn.log_sigmoid((a_lr @ p['w_gate_up'] + p['b_gate']).astype(f32)) / GLA_GATE_TAU
    o_g, s_new = _gla_chunked(heads(q_g.astype(f32) * GLA_HEAD_K ** -0.5, GLA_HEADS),
                              heads(k_g.astype(f32), GLA_HEADS),
                              heads(v_g.astype(f32), GLA_HEADS),
                              heads(log_a, GLA_HEADS),
                              gla_s0.astype(f32))
    o_g = _rms_norm(o_g.astype(x.dtype), p['gla_head_norm'].reshape(GLA_HEADS, GLA_HEAD_V))
    o_g = o_g.reshape(b, t, GLA_WIDTH) * jax.nn.silu(r_g)
    sinks = p['swa_sinks'].astype(f32).reshape(SWA_KV_HEADS, SWA_GROUP)
    q_s = heads(q_s, SWA_Q_HEADS)
    k_s = heads(k_s, SWA_KV_HEADS)
    v_s = heads(v_s, SWA_KV_HEADS)
    if k_cache is None:
        o_s, k_buf, v_buf = _swa_prompt(q_s, k_s, v_s, sinks)
    else:
        o_s, k_buf, v_buf = _swa_sample(q_s, k_s, v_s, k_cache, v_cache, sinks)
    o_s = _rms_norm(o_s, p['swa_out_norm'])
    x = x + jnp.concatenate([o_g, o_s], axis=-1) @ p['w_out']
    x = x + 0.5 * _swiglu(_rms_norm(x, p['ffn2_norm']), p['ffn2_w_gate'], p['ffn2_w_up'], p['ffn2_w_down'])
    return x, s_new.astype(x.dtype), k_buf, v_buf


def setup_inputs(seed: int = 0) -> dict:
    key = jax.random.key(seed)
    ks = jax.random.split(key, 24)
    f32 = jnp.float32

    def nrm(k, shape, scale):
        return scale * jax.random.normal(k, shape, f32)

    def gain(k, n):
        return 1.0 + 0.02 * jax.random.normal(k, (DEPTH, n), f32)

    cache_w = min(WINDOW, PAST_LEN)
    return {
        'x_prompt': nrm(ks[0], (BATCH, SEQ, D_MODEL), 1.0),
        'x_sample': nrm(ks[1], (DEC_BATCH, DEC_SEQ, D_MODEL), 1.0),
        'state_gla': nrm(ks[2], (DEPTH, DEC_BATCH, GLA_HEADS, GLA_HEAD_K, GLA_HEAD_V), 0.5),
        'cache_swa_k': nrm(ks[3], (DEPTH, DEC_BATCH, cache_w, SWA_KV_HEADS, SWA_HEAD_DIM), 1.0),
        'cache_swa_v': nrm(ks[4], (DEPTH, DEC_BATCH, cache_w, SWA_KV_HEADS, SWA_HEAD_DIM), 1.0),
        'ffn1_norm': gain(ks[5], D_MODEL),
        'ffn1_w_gate': nrm(ks[6], (DEPTH, D_MODEL, D_FF), D_MODEL ** -0.5),
        'ffn1_w_up': nrm(ks[7], (DEPTH, D_MODEL, D_FF), D_MODEL ** -0.5),
        'ffn1_w_down': nrm(ks[8], (DEPTH, D_FF, D_MODEL), D_FF ** -0.5),
        'mix_norm': gain(ks[9], D_MODEL),
        'w_in': nrm(ks[10], (DEPTH, D_MODEL, D_IN), D_MODEL ** -0.5),
        'w_gate_up': nrm(ks[11], (DEPTH, GLA_GATE_RANK, GLA_KEY_WIDTH), GLA_GATE_RANK ** -0.5),
        'b_gate': nrm(ks[12], (DEPTH, GLA_KEY_WIDTH), 0.1),
        'gla_head_norm': gain(ks[13], GLA_WIDTH),
        'swa_out_norm': gain(ks[14], SWA_WIDTH),
        'swa_sinks': nrm(ks[15], (DEPTH, SWA_Q_HEADS), 1.0),
        'w_out': nrm(ks[16], (DEPTH, MIX_WIDTH, D_MODEL), MIX_WIDTH ** -0.5),
        'ffn2_norm': gain(ks[17], D_MODEL),
        'ffn2_w_gate': nrm(ks[18], (DEPTH, D_MODEL, D_FF), D_MODEL ** -0.5),
        'ffn2_w_up': nrm(ks[19], (DEPTH, D_MODEL, D_FF), D_MODEL ** -0.5),
        'ffn2_w_down': nrm(ks[20], (DEPTH, D_FF, D_MODEL), D_FF ** -0.5),
        'final_norm': 1.0 + 0.02 * jax.random.normal(ks[21], (D_MODEL,), f32),
    }


def reference(x_prompt, x_sample, state_gla, cache_swa_k, cache_swa_v,
              ffn1_norm, ffn1_w_gate, ffn1_w_up, ffn1_w_down,
              mix_norm, w_in, w_gate_up, b_gate, gla_head_norm, swa_out_norm, swa_sinks, w_out,
              ffn2_norm, ffn2_w_gate, ffn2_w_up, ffn2_w_down, final_norm):
    yp = x_prompt
    ys = x_sample
    sp, kp, vp, ss, ksm, vsm = [], [], [], [], [], []
    for l in range(DEPTH):
        p = {
            'ffn1_norm': ffn1_norm[l], 'ffn1_w_gate': ffn1_w_gate[l],
            'ffn1_w_up': ffn1_w_up[l], 'ffn1_w_down': ffn1_w_down[l],
            'mix_norm': mix_norm[l], 'w_in': w_in[l], 'w_gate_up': w_gate_up[l], 'b_gate': b_gate[l],
            'gla_head_norm': gla_head_norm[l], 'swa_out_norm': swa_out_norm[l],
            'swa_sinks': swa_sinks[l], 'w_out': w_out[l],
            'ffn2_norm': ffn2_norm[l], 'ffn2_w_gate': ffn2_w_gate[l],
            'ffn2_w_up': ffn2_w_up[l], 'ffn2_w_down': ffn2_w_down[l],
        }
        gla0 = jnp.zeros((yp.shape[0], GLA_HEADS, GLA_HEAD_K, GLA_HEAD_V), yp.dtype)
        yp, s_p, k_p, v_p = _layer(yp, gla0, None, None, p)
        ys, s_s, k_s, v_s = _layer(ys, state_gla[l], cache_swa_k[l], cache_swa_v[l], p)
        sp.append(s_p)
        kp.append(k_p)
        vp.append(v_p)
        ss.append(s_s)
        ksm.append(k_s)
        vsm.append(v_s)
    y_prompt = _rms_norm(yp, final_norm)
    y_sample = _rms_norm(ys, final_norm)
    return (y_prompt, y_sample, jnp.stack(sp), jnp.stack(kp), jnp.stack(vp),
            jnp.stack(ss), jnp.stack(ksm), jnp.stack(vsm))
```

```cpp
#include <hip/hip_runtime.h>
#include <hip/hip_cooperative_groups.h>
#include <cstdio>
#include <cstdint>
namespace cg = cooperative_groups;
#define MK_N_LAUNCHES 11

constexpr int D = 1024, SEQ = 16384, NSAMP = 512, M = SEQ + NSAMP, FF = 2816, DIN = 2320, NPROJ = 2560;
constexpr int DECB = 128, DECT = 4;
constexpr float EPS = 1e-6f;
namespace pg8 {
#define PG8_LAS __attribute__((address_space(3)))
typedef unsigned short bf16_t;
typedef short bf16x8 __attribute__((ext_vector_type(8)));
typedef float f32x4 __attribute__((ext_vector_type(4)));
typedef unsigned u32x4 __attribute__((ext_vector_type(4)));
constexpr int BM = 256, BK = 64, HALF = 128, HTB = HALF * BK * 2  , STAGE_BYTES = 8 * HTB, NXCD = 8, WGM = 8;

__host__ __device__ __forceinline__ int lds_byte(int r, int c) { const int st = (r >> 4) * 2 + (c >> 5), rr = r & 15, cc = c & 31, ob = rr * 64 + cc * 2; return st * 1024 + (ob ^ (((ob >> 9) & 1) << 5)); }
__host__ __device__ __forceinline__ void stage_rc(int b, int& R, int& C) { const int st = b / 1024, sb = b % 1024, swz = sb ^ (((sb >> 9) & 1) << 5); R = (st >> 1) * 16 + swz / 64; C = (st & 1) * 32 + (swz % 64) / 2; }
__host__ __device__ __forceinline__ int perm32(int rho) { const int n = rho >> 4, i = rho & 15; return 8 * (i >> 2) + 4 * n + (i & 3); }

struct Unit { int pm, pn; };
struct Gemm { const bf16_t* A; const bf16_t* Bt; int M, N, K; };

struct StaticOrder {
    int nM, nN, nwg, G, c;
    __host__ __device__ void init(int M, int N, int G_, int c_) { nM = M / BM; nN = N / BM; nwg = nM * nN; G = G_; c = c_; }
    __host__ __device__ bool next(int i, Unit& u) const {
        const long L = (long)i * G + c; if (L >= nwg) return false;
        int wgid = (int)L; { const int q = nwg / NXCD, r = nwg % NXCD, xcd = wgid % NXCD, off = wgid / NXCD; wgid = (xcd < r ? xcd * (q + 1) : r * (q + 1) + (xcd - r) * q) + off; }
        const int nig = WGM * nN, gid = wgid / nig, fm = gid * WGM, gsz = (nM - fm) < WGM ? (nM - fm) : WGM;
        u.pm = fm + ((wgid % nig) % gsz); u.pn = (wgid % nig) / gsz; return true;
    }
    __device__ __forceinline__ void a_ready(const Unit&) const {}
    __device__ __forceinline__ void done(const Unit&) const {}
};

__device__ __forceinline__ unsigned cvt_pk_bf16(float lo, float hi) { unsigned r; asm volatile("v_cvt_pk_bf16_f32 %0, %1, %2" : "=v"(r) : "v"(lo), "v"(hi)); return r; }
typedef float f32x2 __attribute__((ext_vector_type(2)));
__device__ __forceinline__ float row_rs16(const float* ss, int row) {
    const f32x4* p = (const f32x4*)(ss + (size_t)row * 16);
    const f32x4 t = (p[0] + p[1]) + (p[2] + p[3]);
    return rsqrtf(((t[0] + t[1]) + (t[2] + t[3])) * (1.0f / 1024.0f) + 1e-6f);
}
__device__ __forceinline__ float silu_f(float g) { return g * __builtin_amdgcn_rcpf(1.0f + __builtin_amdgcn_exp2f(-1.4426950408889634f * g)); }

struct EpiGU {
    static constexpr bool PERM = true, AFTER_DRAIN = false;
    bf16_t* H; const float* ss;
    __device__ __forceinline__ void operator()(const f32x4 (&acc)[2][2][4][2], const Unit& u, int wr, int wc, int fr, int fq) const {
        const int row0 = u.pm * BM + wr * 64 + fr;
        const int col0 = u.pn * 128 + wc * 32 + 8 * fq;
#pragma unroll
        for (int ai = 0; ai < 2; ++ai)
#pragma unroll
            for (int m = 0; m < 4; ++m) {
                const int row = row0 + ai * HALF + m * 16;
                float rs = 1.0f;
                if (ss) rs = row_rs16(ss, row);
                float h[8];
#pragma unroll
                for (int n = 0; n < 2; ++n)
#pragma unroll
                    for (int e = 0; e < 4; ++e) { const float g = acc[ai][0][m][n][e] * rs, up = acc[ai][1][m][n][e] * rs; h[4 * n + e] = silu_f(g) * up; }
                u32x4 w; w.x = cvt_pk_bf16(h[0], h[1]); w.y = cvt_pk_bf16(h[2], h[3]); w.z = cvt_pk_bf16(h[4], h[5]); w.w = cvt_pk_bf16(h[6], h[7]);
                *(u32x4*)(H + (size_t)row * 2816 + col0) = w;
            }
    }
};

struct EpiRes {
    static constexpr bool PERM = true, AFTER_DRAIN = false;
    const float* xp; const float* xs; float* out; bf16_t* xn; const float* gain; float* ss; float scale;
    __device__ __forceinline__ void operator()(const f32x4 (&acc)[2][2][4][2], const Unit& u, int wr, int wc, int fr, int fq) const {
        const int row0 = u.pm * BM + wr * 64 + fr;
        const int col0 = u.pn * BM + wc * 32 + 8 * fq;
        f32x4 gv[2][2];
#pragma unroll
        for (int bj = 0; bj < 2; ++bj)
#pragma unroll
            for (int n = 0; n < 2; ++n) gv[bj][n] = xn ? *(const f32x4*)(gain + col0 + bj * HALF + 4 * n) : (f32x4){1.f, 1.f, 1.f, 1.f};
#pragma unroll
        for (int ai = 0; ai < 2; ++ai)
#pragma unroll
            for (int m = 0; m < 4; ++m) {
                const int row = row0 + ai * HALF + m * 16;
                const float* rp = (row < 16384 ? xp + (size_t)row * 1024 : xs + (size_t)(row - 16384) * 1024) + col0;
                float* op = out + (size_t)row * 1024 + col0;
                float sq = 0.f;
#pragma unroll
                for (int bj = 0; bj < 2; ++bj) {
                    const f32x4 r0 = *(const f32x4*)(rp + bj * HALF), r1 = *(const f32x4*)(rp + bj * HALF + 4);
                    const f32x4 v0 = r0 + acc[ai][bj][m][0] * scale, v1 = r1 + acc[ai][bj][m][1] * scale;
                    *(f32x4*)(op + bj * HALF) = v0; *(f32x4*)(op + bj * HALF + 4) = v1;
                    sq += (v0[0] * v0[0] + v0[1] * v0[1]) + (v0[2] * v0[2] + v0[3] * v0[3]);
                    sq += (v1[0] * v1[0] + v1[1] * v1[1]) + (v1[2] * v1[2] + v1[3] * v1[3]);
                    if (xn) { const f32x4 a = v0 * gv[bj][0], b = v1 * gv[bj][1];
                        u32x4 w; w.x = cvt_pk_bf16(a[0], a[1]); w.y = cvt_pk_bf16(a[2], a[3]); w.z = cvt_pk_bf16(b[0], b[1]); w.w = cvt_pk_bf16(b[2], b[3]);
                        *(u32x4*)(xn + (size_t)row * 1024 + col0 + bj * HALF) = w; }
                }
                sq += __shfl_xor(sq, 16); sq += __shfl_xor(sq, 32);
                if (fq == 0) ss[(size_t)row * 16 + u.pn * 4 + wc] = sq;
            }
    }
};

struct EpiProj {
    static constexpr bool PERM = true, AFTER_DRAIN = false;
    const float* ss; bf16_t *qg, *kg, *vg, *rg, *qs, *kvs; float* alr; float *ckp, *cvp, *cks, *cvs;
    __device__ __forceinline__ void operator()(const f32x4 (&acc)[2][2][4][2], const Unit& u, int wr, int wc, int fr, int fq) const {
        const int row0 = u.pm * BM + wr * 64 + fr;
        const int pn = u.pn;
#pragma unroll
        for (int ai = 0; ai < 2; ++ai)
#pragma unroll
            for (int m = 0; m < 4; ++m) {
                const int row = row0 + ai * HALF + m * 16;
                const float rs = row_rs16(ss, row);
#pragma unroll
                for (int bj = 0; bj < 2; ++bj) {
                    const int cl = bj * HALF + wc * 32 + 8 * fq;
                    f32x4 v0 = acc[ai][bj][m][0] * rs, v1 = acc[ai][bj][m][1] * rs;
                    if (pn == 9) {
                        if (cl < 16) { float* p = alr + (size_t)row * 16 + cl; *(f32x4*)p = v0; *(f32x4*)(p + 4) = v1; }
                        continue;
                    }
                    bf16_t* dst;
                    if (pn == 0) { dst = qg + (size_t)row * 256 + cl; v0 = v0 * 0.125f; v1 = v1 * 0.125f; }
                    else if (pn == 1) { dst = kg + (size_t)row * 256 + cl; }
                    else if (pn < 4) { dst = vg + (size_t)row * 512 + (pn - 2) * 256 + cl; }
                    else if (pn < 6) { dst = rg + (size_t)row * 512 + (pn - 4) * 256 + cl;
#pragma unroll
                        for (int e = 0; e < 4; ++e) { v0[e] = silu_f(v0[e]); v1[e] = silu_f(v1[e]); } }
                    else if (pn < 8) { dst = qs + (size_t)row * 512 + (pn - 6) * 256 + cl; v0 = v0 * 0.125f; v1 = v1 * 0.125f; }
                    else { dst = kvs + (size_t)row * 256 + cl;
                        float* cp = nullptr;
                        if (row >= 16384) { const int sr = row - 16384; cp = (bj ? cvs : cks) + ((size_t)(sr >> 2) * 128 + 124 + (sr & 3)) * 128 + (cl & 127); }
                        else if (row >= 16384 - 128) { cp = (bj ? cvp : ckp) + (size_t)(row - (16384 - 128)) * 128 + (cl & 127); }
                        if (cp) { *(f32x4*)cp = v0; *(f32x4*)(cp + 4) = v1; }
                    }
                    u32x4 w; w.x = cvt_pk_bf16(v0[0], v0[1]); w.y = cvt_pk_bf16(v0[2], v0[3]); w.z = cvt_pk_bf16(v1[0], v1[1]); w.w = cvt_pk_bf16(v1[2], v1[3]);
                    *(u32x4*)dst = w;
                }
            }
    }
};
template <class Epi, class Sched, bool ALIGN_EPI = false, bool SP2 = false>
__device__ __forceinline__ void gemm_phase(PG8_LAS unsigned char* lds, const Gemm g, const Sched& S, const Epi& E) {
    const int tid = threadIdx.x, wid = __builtin_amdgcn_readfirstlane(tid >> 6), lane = tid & 63, wr = wid >> 2, wc = wid & 3, fr = lane & 15, fq = lane >> 4;
    const int K = g.K, nt = K / BK;
    unsigned voffA[2], voffB[2];
#pragma unroll
    for (int i = 0; i < 2; ++i) { int R, C; stage_rc(tid * 16 + i * 8192, R, C); const int Rb = Epi::PERM ? ((R & ~31) + perm32(R & 31)) : R;
        voffA[i] = (unsigned)(R * K + C) * 2u; voffB[i] = (unsigned)(Rb * K + C) * 2u; }
    const size_t kstep = (size_t)(BK * 2);
    const size_t hstep = (size_t)HALF * K * 2;
    const size_t tstep = 2 * hstep;
    const unsigned ldsw = (unsigned)wid * 1024u;
    const int aoff = lds_byte(wr * 64 + fr, fq * 8), boff = lds_byte(wc * 32 + fr, fq * 8);
#define PG8_SA(b, h) (((b) * 2 + (h)) * HTB)
#define PG8_SB(b, h) ((4 + (b) * 2 + (h)) * HTB)
#define PG8_STAGE(bufoff, gbase, voff) do { _Pragma("unroll") for (int _i = 0; _i < 2; ++_i) \
        __builtin_amdgcn_global_load_lds((const unsigned*)((const char*)(gbase) + (voff)[_i]), (PG8_LAS unsigned*)(lds + (bufoff) + ldsw + _i * 8192), 16, 0, 0); } while (0)
#define PG8_LDA(dst, b, h) do { _Pragma("unroll") for (int m = 0; m < 4; ++m) _Pragma("unroll") for (int k = 0; k < 2; ++k) dst[m][k] = *(const PG8_LAS bf16x8*)(lds + PG8_SA(b, h) + aoff + m * 2048 + k * 1024); } while (0)
#define PG8_LDB(dst, b, h) do { _Pragma("unroll") for (int n = 0; n < 2; ++n) _Pragma("unroll") for (int k = 0; k < 2; ++k) dst[n][k] = *(const PG8_LAS bf16x8*)(lds + PG8_SB(b, h) + boff + n * 2048 + k * 1024); } while (0)
#define PG8_MMA(ai, bj, At, Bt) do { __builtin_amdgcn_s_setprio(1); _Pragma("unroll") for (int m = 0; m < 4; ++m) _Pragma("unroll") for (int n = 0; n < 2; ++n) _Pragma("unroll") for (int k = 0; k < 2; ++k) \
        acc[ai][bj][m][n] = __builtin_amdgcn_mfma_f32_16x16x32_bf16(Bt[n][k], At[m][k], acc[ai][bj][m][n], 0, 0, 0); __builtin_amdgcn_s_setprio(0); } while (0)
#define PG8_WAIT_V(n) asm volatile("s_waitcnt vmcnt(" #n ")" ::: "memory")
#define PG8_WAIT_L(n) asm volatile("s_waitcnt lgkmcnt(" #n ")" ::: "memory")
#define PG8_BAR __builtin_amdgcn_s_barrier()
#define PG8_SCHED __builtin_amdgcn_sched_barrier(0)
    Unit cur, nxt; int ui = 0;
    if (!S.next(0, cur)) return;
    f32x4 acc[2][2][4][2];
#pragma unroll
    for (int a = 0; a < 2; ++a)
#pragma unroll
        for (int b = 0; b < 2; ++b)
#pragma unroll
            for (int m = 0; m < 4; ++m)
#pragma unroll
                for (int n = 0; n < 2; ++n) acc[a][b][m][n] = (f32x4){0.f, 0.f, 0.f, 0.f};
    bf16x8 At[4][2], B0[2][2], B1[2][2];
    const char* cA = (const char*)g.A + (size_t)cur.pm * tstep; const char* cB = (const char*)g.Bt + (size_t)cur.pn * tstep;
    S.a_ready(cur);
    if constexpr (SP2) {
        PG8_STAGE(PG8_SB(0, 0), cB, voffB); PG8_STAGE(PG8_SB(0, 1), cB + hstep, voffB); PG8_STAGE(PG8_SA(0, 0), cA, voffA); PG8_STAGE(PG8_SA(0, 1), cA + hstep, voffA);
        if (wr == 1) PG8_BAR;
        PG8_WAIT_V(2); PG8_BAR;
        PG8_STAGE(PG8_SB(1, 0), cB + kstep, voffB); PG8_STAGE(PG8_SA(1, 0), cA + kstep, voffA); PG8_STAGE(PG8_SB(1, 1), cB + hstep + kstep, voffB);
        PG8_WAIT_V(6); PG8_BAR;
    } else {
        PG8_STAGE(PG8_SB(0, 0), cB, voffB); PG8_STAGE(PG8_SA(0, 0), cA, voffA); PG8_STAGE(PG8_SB(0, 1), cB + hstep, voffB); PG8_STAGE(PG8_SA(0, 1), cA + hstep, voffA);
        if (wr == 1) PG8_BAR;
        PG8_WAIT_V(4); PG8_BAR;
        PG8_STAGE(PG8_SB(1, 0), cB + kstep, voffB); PG8_STAGE(PG8_SA(1, 0), cA + kstep, voffA); PG8_STAGE(PG8_SB(1, 1), cB + hstep + kstep, voffB);
        PG8_WAIT_V(6); PG8_BAR;
    }
    for (;;) {
        const bool has_next = S.next(ui + 1, nxt);
        const char* nA = has_next ? (const char*)g.A + (size_t)nxt.pm * tstep : cA; const char* nB = has_next ? (const char*)g.Bt + (size_t)nxt.pn * tstep : cB;
        for (int t = 0; t < nt; t += 2) {
            const bool last = (t == nt - 2);
            const char* a1 = cA + (size_t)(t + 1) * kstep;
            const char* a2 = last ? nA : cA + (size_t)(t + 2) * kstep; const char* b2 = last ? nB : cB + (size_t)(t + 2) * kstep;
            const char* a3 = a2 + kstep; const char* b3 = b2 + kstep;
            if (last && has_next) S.a_ready(nxt);
            if constexpr (SP2) {
            PG8_LDB(B0, 0, 0); PG8_LDB(B1, 0, 1); PG8_SCHED; PG8_LDA(At, 0, 0); PG8_STAGE(PG8_SA(1, 1), a1 + hstep, voffA);
            PG8_WAIT_V(8); PG8_WAIT_L(0); PG8_BAR; PG8_MMA(0, 0, At, B0); PG8_MMA(0, 1, At, B1); PG8_BAR; PG8_SCHED;
            PG8_LDA(At, 0, 1); PG8_STAGE(PG8_SB(0, 0), b2, voffB); PG8_STAGE(PG8_SB(0, 1), b2 + hstep, voffB); PG8_STAGE(PG8_SA(0, 0), a2, voffA);
            PG8_WAIT_V(8); PG8_WAIT_L(0); PG8_BAR; PG8_MMA(1, 0, At, B0); PG8_MMA(1, 1, At, B1); PG8_BAR; PG8_SCHED;
            PG8_LDB(B0, 1, 0); PG8_LDB(B1, 1, 1); PG8_SCHED; PG8_LDA(At, 1, 0); PG8_STAGE(PG8_SA(0, 1), a2 + hstep, voffA);
            PG8_WAIT_V(8); PG8_WAIT_L(0); PG8_BAR; PG8_MMA(0, 0, At, B0); PG8_MMA(0, 1, At, B1); PG8_BAR; PG8_SCHED;
            PG8_LDA(At, 1, 1); PG8_STAGE(PG8_SB(1, 0), b3, voffB); PG8_STAGE(PG8_SB(1, 1), b3 + hstep, voffB); PG8_STAGE(PG8_SA(1, 0), a3, voffA);
            PG8_WAIT_V(8); PG8_WAIT_L(0); PG8_BAR; PG8_MMA(1, 0, At, B0); PG8_MMA(1, 1, At, B1); PG8_BAR; PG8_SCHED;
            } else {
            PG8_LDB(B0, 0, 0); PG8_SCHED; PG8_LDA(At, 0, 0); PG8_STAGE(PG8_SA(1, 1), a1 + hstep, voffA);
            PG8_WAIT_L(8); PG8_BAR; PG8_WAIT_L(0); PG8_MMA(0, 0, At, B0); PG8_BAR; PG8_SCHED;
            PG8_LDB(B1, 0, 1); PG8_STAGE(PG8_SB(0, 0), b2, voffB);
            PG8_BAR; PG8_WAIT_L(0); PG8_MMA(0, 1, At, B1); PG8_BAR;
            PG8_LDA(At, 0, 1); PG8_STAGE(PG8_SA(0, 0), a2, voffA);
            PG8_BAR; PG8_WAIT_L(0); PG8_MMA(1, 0, At, B0); PG8_BAR; PG8_SCHED;
            PG8_STAGE(PG8_SB(0, 1), b2 + hstep, voffB);
            PG8_WAIT_V(6); PG8_BAR; PG8_MMA(1, 1, At, B1); PG8_BAR;
            PG8_LDB(B0, 1, 0); PG8_SCHED; PG8_LDA(At, 1, 0); PG8_STAGE(PG8_SA(0, 1), a2 + hstep, voffA);
            PG8_WAIT_L(8); PG8_BAR; PG8_WAIT_L(0); PG8_MMA(0, 0, At, B0); PG8_BAR; PG8_SCHED;
            PG8_LDB(B1, 1, 1); PG8_STAGE(PG8_SB(1, 0), b3, voffB);
            PG8_BAR; PG8_WAIT_L(0); PG8_MMA(0, 1, At, B1); PG8_BAR;
            PG8_LDA(At, 1, 1); PG8_STAGE(PG8_SA(1, 0), a3, voffA);
            PG8_BAR; PG8_WAIT_L(0); PG8_MMA(1, 0, At, B0); PG8_BAR; PG8_SCHED;
            PG8_STAGE(PG8_SB(1, 1), b3 + hstep, voffB);
            PG8_WAIT_V(6); PG8_BAR; PG8_MMA(1, 1, At, B1); PG8_BAR;
            }
        }
        if constexpr (ALIGN_EPI) { if (wr == 0) PG8_BAR; }
        if constexpr (!Epi::AFTER_DRAIN) { E(acc, cur, wr, wc, fr, fq); S.done(cur); }
        if (!has_next) break;
#pragma unroll
        for (int a = 0; a < 2; ++a)
#pragma unroll
            for (int b = 0; b < 2; ++b)
#pragma unroll
                for (int m = 0; m < 4; ++m)
#pragma unroll
                    for (int n = 0; n < 2; ++n) acc[a][b][m][n] = (f32x4){0.f, 0.f, 0.f, 0.f};
        cur = nxt; cA = nA; cB = nB; ++ui;
        if constexpr (ALIGN_EPI) { if (wr == 1) PG8_BAR; }
    }
    PG8_WAIT_V(0);
    if constexpr (!ALIGN_EPI) { if (wr == 0) PG8_BAR; }
    PG8_BAR;
    if constexpr (Epi::AFTER_DRAIN) { E.fused(acc, cur, wr, wc, fr, fq, lds, wid, lane); S.done(cur); }
#undef PG8_SA
#undef PG8_SB
#undef PG8_STAGE
#undef PG8_LDA
#undef PG8_LDB
#undef PG8_MMA
#undef PG8_WAIT_V
#undef PG8_WAIT_L
#undef PG8_BAR
#undef PG8_SCHED
}
}
#define GAS __attribute__((address_space(1)))
#define LAS __attribute__((address_space(3)))
typedef unsigned short bf16;
typedef unsigned v4u __attribute__((ext_vector_type(4)));
typedef float f32x4 __attribute__((ext_vector_type(4)));
typedef short bf16x8 __attribute__((ext_vector_type(8)));
typedef GAS unsigned gu32;
typedef GAS unsigned long long gu64;
#define RLX_AGENT __ATOMIC_RELAXED, __HIP_MEMORY_SCOPE_AGENT
#define LDS_WAIT() asm volatile("s_waitcnt lgkmcnt(0)" ::: "memory")
#define VM_WAIT() asm volatile("s_waitcnt vmcnt(0)" ::: "memory")
__device__ __forceinline__ unsigned long long rt() { return __builtin_amdgcn_s_memrealtime(); }
__device__ __forceinline__ unsigned f2bf(float f) { unsigned u = __builtin_bit_cast(unsigned, f); return (u + 0x7fffu + ((u >> 16) & 1u)) >> 16; }
__device__ __forceinline__ unsigned pk2(float lo, float hi) { return f2bf(lo) | (f2bf(hi) << 16); }

#define XB_TMO      128
#define XB_XCNT(j)  (256  + 64 * (j))
#define XB_XSUB(j)  (1280 + 64 * (j))
#define XB_XGEN(j)  (2304 + 64 * (j))
#define XB_TOP      3328
#define XB_TOPGEN   3392
#define XCD_BAR_WORDS 3456
#define XB_SPIN_CAP (1u << 18)

__device__ __forceinline__ unsigned xb_ld(unsigned* p)              { return __hip_atomic_load(p, __ATOMIC_RELAXED, __HIP_MEMORY_SCOPE_AGENT); }
__device__ __forceinline__ unsigned xb_add(unsigned* p, unsigned v) { return __hip_atomic_fetch_add(p, v, __ATOMIC_RELAXED, __HIP_MEMORY_SCOPE_AGENT); }
__device__ __forceinline__ unsigned xb_xcc_id() { return (unsigned)__builtin_amdgcn_s_getreg((3 << 11) | 20) & 0xFu; }
#define XB_SPIN(cond, bar) do { unsigned _sp = 0; while (cond) { __builtin_amdgcn_s_sleep(1); \
    if ((++_sp & 255u) == 0u) { if (xb_ld(&(bar)[XB_TMO])) break; if (_sp > XB_SPIN_CAP) { atomicAdd(&(bar)[XB_TMO], 1u); break; } } } } while (0)

struct XcdBarrier {
    unsigned* bar; unsigned x;
    volatile LAS unsigned* st;
};

__device__ __forceinline__ XcdBarrier xcd_barrier_post(unsigned* bar, volatile LAS unsigned* st) {
    XcdBarrier b; b.bar = bar; b.x = xb_xcc_id(); b.st = st;
    if (threadIdx.x == 0) (void)xb_add(&bar[XB_XCNT(b.x)], 1u);
    return b;
}
__device__ __forceinline__ void xcd_barrier_complete(unsigned* bar, unsigned x, unsigned& nloc, unsigned& nx) {
    const unsigned G = gridDim.x * gridDim.y * gridDim.z;
    unsigned sum, cnt, mine, sp = 0u;
    for (;;) {
        sum = 0u; cnt = 0u; mine = 0u;
#pragma unroll
        for (unsigned j = 0; j < 16; ++j) { const unsigned c = xb_ld(&bar[XB_XCNT(j)]); sum += c; cnt += (c > 0u) ? 1u : 0u; mine = (j == x) ? c : mine; }
        if (sum == G) break;
        __builtin_amdgcn_s_sleep(1);
        if ((++sp & 255u) == 0u) { if (xb_ld(&bar[XB_TMO])) break; if (sp > XB_SPIN_CAP) { atomicAdd(&bar[XB_TMO], 1u); break; } }
    }
    nloc = mine > 0u ? mine : 1u; nx = cnt > 0u ? cnt : 1u;
}

__device__ __forceinline__ void xcd_barrier(const XcdBarrier& b) {
    asm volatile("s_waitcnt vmcnt(0)" ::: "memory");
    __syncthreads();
    if (threadIdx.x == 0) {
        unsigned* bar = b.bar;
        __builtin_amdgcn_s_waitcnt(0);
        unsigned nloc = b.st[0], nx = b.st[1];
        if (nloc == 0u) { xcd_barrier_complete(bar, b.x, nloc, nx); b.st[0] = nloc; b.st[1] = nx; }
        const unsigned old = xb_add(&bar[XB_XSUB(b.x)], 1u);
        const unsigned gen = old / nloc;
        if (old + 1u == (gen + 1u) * nloc) {
            __builtin_amdgcn_fence(__ATOMIC_RELEASE, "agent");
            asm volatile("s_waitcnt vmcnt(0)" ::: "memory");
            const unsigned og = xb_add(&bar[XB_TOP], 1u);
            const unsigned tg = og / nx;
            if (og + 1u == (tg + 1u) * nx) xb_add(&bar[XB_TOPGEN], 1u);
            else XB_SPIN(xb_ld(&bar[XB_TOPGEN]) == tg, bar);
            __builtin_amdgcn_fence(__ATOMIC_ACQUIRE, "agent");
            xb_add(&bar[XB_XGEN(b.x)], 1u);
            asm volatile("s_waitcnt vmcnt(0)" ::: "memory");
        } else {
            XB_SPIN(xb_ld(&bar[XB_XGEN(b.x)]) == gen, bar);
            __builtin_amdgcn_fence(__ATOMIC_ACQUIRE, "agent");
            asm volatile("s_waitcnt vmcnt(0)" ::: "memory");
        }
    }
    __syncthreads();
}

constexpr size_t MiB = 1u << 20;
constexpr size_t WS_CTL = 0, CTL_ZERO_BYTES = 64 * 1024;
constexpr size_t SZ_WGU = (size_t)5632 * 1024 * 2, SZ_WD = (size_t)1024 * 2816 * 2, SZ_WIN = (size_t)NPROJ * 1024 * 2, SZ_WOUT = (size_t)1024 * 1024 * 2;
constexpr size_t WS_WGU1 = 1 * MiB, WS_WD1 = WS_WGU1 + SZ_WGU, WS_WGU2 = WS_WD1 + SZ_WD, WS_WD2 = WS_WGU2 + SZ_WGU, WS_WIN = WS_WD2 + SZ_WD, WS_WOUT = WS_WIN + SZ_WIN;
constexpr size_t SZ_ACT = (size_t)M * 1024 * 2;
constexpr size_t WS_XN = WS_WOUT + SZ_WOUT, WS_MIX = WS_XN + SZ_ACT, WS_SS = WS_MIX + SZ_ACT;
constexpr size_t SZ_SS = (size_t)M * 16 * 4, SZ_SSW = (size_t)M * 8 * 4, SZ_ALR = (size_t)M * 16 * 4, SZ_G = (size_t)256 * 4 * 64 * 4;
constexpr size_t WS_SSW = WS_SS + SZ_SS, WS_ALR = WS_SSW + SZ_SSW, WS_G = WS_ALR + SZ_ALR, WS_R = WS_G + SZ_G;
constexpr size_t SZ_R = (size_t)M * 2816 * 2;
constexpr size_t R_QG = 0, R_KG = R_QG + (size_t)M * 256 * 2, R_VG = R_KG + (size_t)M * 256 * 2, R_RG = R_VG + (size_t)M * 512 * 2, R_QS = R_RG + (size_t)M * 512 * 2,
                 R_KVS = R_QS + (size_t)M * 512 * 2, R_CUM = R_KVS + (size_t)M * 256 * 2, R_END = R_CUM + (size_t)SEQ * 256 * 4;
static_assert(R_END <= SZ_R, "projection overlay fits inside H");
constexpr size_t WS_DS = WS_R + SZ_R, SZ_DS = (size_t)256 * 4 * 64 * 128 * 4, WS_END = WS_DS + SZ_DS;
static_assert(WS_END <= 256 * MiB, "d_ws map");
constexpr size_t O_Y = 0, O_SP = (size_t)M * 1024, O_CKP = O_SP + 32768, O_CVP = O_CKP + 16384, O_SS = O_CVP + 16384, O_CKS = O_SS + (size_t)DECB * 32768, O_CVS = O_CKS + (size_t)DECB * 16384,
                 O_END = O_CVS + (size_t)DECB * 16384;
constexpr int RING_BYTES = 131072, MISC_OFF = RING_BYTES + 320, LDS_BYTES = 147456;
constexpr int NWAVES = 8, NTHR = 512;

struct Args {
    const float* in[22]; float* out; unsigned char* ws; int ph_lo, ph_hi;
};
struct Ptrs {
    const float *x_p, *x_s, *state0, *ck_in, *cv_in, *g_ffn1, *wg1, *wu1, *wd1, *g_mix, *w_in, *w_gate_up, *b_gate, *g_head, *g_swa, *sinks, *w_out, *g_ffn2, *wg2, *wu2, *wd2, *g_final;
    float* out;
    bf16 *wgu1, *wd1t, *wgu2, *wd2t, *wint, *woutt, *xn, *mix, *hbuf, *qg, *kg, *vg, *rg, *qs, *kvs;
    float *ss, *ssw, *alr, *g, *cum, *ds;
};

__device__ __forceinline__ float bflo(unsigned w) { return __uint_as_float(w << 16); }
__device__ __forceinline__ float bfhi(unsigned w) { return __uint_as_float(w & 0xffff0000u); }
__device__ __forceinline__ float bf1(bf16 b) { return __uint_as_float((unsigned)b << 16); }
__device__ __forceinline__ float wave_sum(float v) {
#pragma unroll
    for (int o = 1; o < 64; o <<= 1) v += __shfl_xor(v, o);
    return v;
}
__device__ __forceinline__ float logsig(float x) { return fminf(x, 0.f) - log1pf(__expf(-fabsf(x))); }
__device__ __forceinline__ bf16x8 frag(const LAS bf16* base, int row0, int ld, int k0, int fr, int fq) { return *(const LAS bf16x8*)(base + (row0 + fr) * ld + k0 + 8 * fq); }
#define MFMA16(a, b, c) __builtin_amdgcn_mfma_f32_16x16x32_bf16((a), (b), (c), 0, 0, 0)

__device__ __forceinline__ int dest_row(int kind, int n) {
    if (kind == 0) return n;
    if (kind == 1) return 256 * (n >> 7) + (n & 127);
    if (kind == 2) return 256 * (n >> 7) + 128 + (n & 127);
    return n < 1536 ? n : (n < 1552 ? 2304 + (n - 1536) : n - 16);
}
__device__ __forceinline__ void p0_transpose_item(const float* W, int K, int N, bf16* WT, int kind, LAS float* scr, int item, int lane) {
    const int nblk = (N + 31) / 32, kb = item / nblk, nb = item % nblk, k0 = 64 * kb, n0 = 32 * nb;
    const int nl = n0 + (lane & 31); const bool ok = nl < N;
#pragma unroll 8
    for (int i = 0; i < 32; ++i) { const int kk = 2 * i + (lane >> 5); scr[kk * 33 + (lane & 31)] = ok ? W[(size_t)(k0 + kk) * N + nl] : 0.f; }
    LDS_WAIT(); asm volatile("" ::: "memory");
    const int c = lane & 7;
#pragma unroll
    for (int j = 0; j < 4; ++j) { const int n = (lane >> 3) + 8 * j; const LAS float* s = scr + (8 * c) * 33 + n;
        v4u o; o.x = pk2(s[0 * 33], s[1 * 33]); o.y = pk2(s[2 * 33], s[3 * 33]); o.z = pk2(s[4 * 33], s[5 * 33]); o.w = pk2(s[6 * 33], s[7 * 33]);
        if (n0 + n < N) *(GAS v4u*)(WT + (size_t)dest_row(kind, n0 + n) * K + k0 + 8 * c) = o; }
    LDS_WAIT(); asm volatile("" ::: "memory");
}
__device__ __forceinline__ void p0_prologue(const Ptrs& P, LAS unsigned char* lds, int tid, int wave, int lane, int vcu, int G) {
    LAS float* scr = (LAS float*)(lds + wave * 16384);
    const int gw = vcu * NWAVES + wave, NGW = G * NWAVES;
    constexpr int I_GU = (1024 / 64) * (2816 / 32), I_D = (2816 / 64) * (1024 / 32), I_IN = (1024 / 64) * ((DIN + 31) / 32), I_O = (1024 / 64) * (1024 / 32);
    constexpr int NITEMS = 4 * I_GU + 2 * I_D + I_IN + I_O;
    for (int it = gw; it < NITEMS; it += NGW) {
        int r = it;
        if (r < I_GU) { p0_transpose_item(P.wg1, 1024, 2816, P.wgu1, 1, scr, r, lane); continue; } r -= I_GU;
        if (r < I_GU) { p0_transpose_item(P.wu1, 1024, 2816, P.wgu1, 2, scr, r, lane); continue; } r -= I_GU;
        if (r < I_D)  { p0_transpose_item(P.wd1, 2816, 1024, P.wd1t, 0, scr, r, lane); continue; } r -= I_D;
        if (r < I_GU) { p0_transpose_item(P.wg2, 1024, 2816, P.wgu2, 1, scr, r, lane); continue; } r -= I_GU;
        if (r < I_GU) { p0_transpose_item(P.wu2, 1024, 2816, P.wgu2, 2, scr, r, lane); continue; } r -= I_GU;
        if (r < I_D)  { p0_transpose_item(P.wd2, 2816, 1024, P.wd2t, 0, scr, r, lane); continue; } r -= I_D;
        if (r < I_IN) { p0_transpose_item(P.w_in, 1024, DIN, P.wint, 3, scr, r, lane); continue; } r -= I_IN;
        p0_transpose_item(P.w_out, 1024, 1024, P.woutt, 0, scr, r, lane);
    }
    for (int m = gw; m < M; m += NGW) {
        const float* xrow = (m < SEQ) ? P.x_p + (size_t)m * D : P.x_s + (size_t)(m - SEQ) * D;
        const GAS f32x4* xr = (const GAS f32x4*)xrow + lane;
        f32x4 v[4]; float s = 0.f;
#pragma unroll
        for (int j = 0; j < 4; ++j) { v[j] = xr[64 * j]; s += (v[j].x * v[j].x + v[j].y * v[j].y) + (v[j].z * v[j].z + v[j].w * v[j].w); }
        const float rs = rsqrtf(wave_sum(s) * (1.f / D) + EPS);
        GAS unsigned long long* o8 = (GAS unsigned long long*)(P.xn + (size_t)m * D) + lane;
#pragma unroll
        for (int j = 0; j < 4; ++j) { const f32x4 gg = *((const GAS f32x4*)P.g_ffn1 + lane + 64 * j);
            o8[64 * j] = (unsigned long long)pk2(v[j].x * rs * gg.x, v[j].y * rs * gg.y) | ((unsigned long long)pk2(v[j].z * rs * gg.z, v[j].w * rs * gg.w) << 32); }
    }
    {
        const int gt = vcu * NTHR + tid, NGT = G * NTHR;
        constexpr int PER_B = 124 * 128 / 4;
        for (int i = gt; i < 2 * DECB * PER_B; i += NGT) {
            const int which = i / (DECB * PER_B), r = i % (DECB * PER_B), b = r / PER_B, o = r % PER_B;
            const float* src = (which ? P.cv_in : P.ck_in) + (size_t)b * 16384 + 512 + 4 * o;
            float* dst = P.out + (which ? O_CVS : O_CKS) + (size_t)b * 16384 + 4 * o;
            *(f32x4*)dst = *(const f32x4*)src;
        }
    }
}

__device__ __forceinline__ void gla_local_unit(const Ptrs& P, LAS unsigned char* lds, int c, int h, int tid, int wave, int lane) {
    LAS float* alrS = (LAS float*)(lds);
    LAS float* wguS = (LAS float*)(lds + 4096);
    LAS float* cumS = (LAS float*)(lds + 8192);
    LAS float* segS = (LAS float*)(lds + 24832);
    LAS bf16* khT = (LAS bf16*)(lds + 26880);
    LAS bf16* vT = (LAS bf16*)(lds + 36096);
    const int t0 = c * 64, fr = lane & 15, fq = lane >> 4;
    if (tid < 256) { const int t = tid >> 2, q = (tid & 3) * 4; *(LAS f32x4*)(alrS + t * 16 + q) = *(const f32x4*)(P.alr + (size_t)(t0 + t) * 16 + q); }
    else { const int i = (tid - 256) * 4, r = i >> 6, d = i & 63; *(LAS f32x4*)(wguS + r * 64 + d) = *(const f32x4*)(P.w_gate_up + r * 256 + 64 * h + d); }
    __syncthreads();
    { const int t = tid >> 3, d0 = (tid & 7) * 8; float x[8];
#pragma unroll
      for (int e = 0; e < 8; ++e) x[e] = P.b_gate[64 * h + d0 + e];
#pragma unroll
      for (int r = 0; r < 16; ++r) { const float a = alrS[t * 16 + r];
#pragma unroll
          for (int e = 0; e < 8; ++e) x[e] += a * wguS[r * 64 + d0 + e]; }
#pragma unroll
      for (int e = 0; e < 8; ++e) cumS[t * 65 + d0 + e] = logsig(x[e]) * (1.0f / 16.0f); }
    __syncthreads();
    { const int d = tid & 63, s = tid >> 6; float run = 0.f;
#pragma unroll
      for (int i = 0; i < 8; ++i) { run += cumS[(8 * s + i) * 65 + d]; cumS[(8 * s + i) * 65 + d] = run; }
      segS[s * 64 + d] = run; }
    __syncthreads();
    { const int d = tid & 63, s = tid >> 6; float off = 0.f;
      for (int s2 = 0; s2 < s; ++s2) off += segS[s2 * 64 + d];
#pragma unroll
      for (int i = 0; i < 8; ++i) { const float v = cumS[(8 * s + i) * 65 + d] + off; cumS[(8 * s + i) * 65 + d] = v; P.cum[(size_t)(t0 + 8 * s + i) * 256 + 64 * h + d] = v; } }
    __syncthreads();
    { const int j = tid >> 3, dc = tid & 7;
      const v4u kk = *(const v4u*)(P.kg + (size_t)(t0 + j) * 256 + 64 * h + 8 * dc);
#pragma unroll
      for (int e = 0; e < 8; ++e) { const int d = 8 * dc + e; const unsigned w = kk[e >> 1]; const float kv = (e & 1) ? bfhi(w) : bflo(w);
          khT[d * 72 + j] = (bf16)f2bf(kv * __expf(cumS[63 * 65 + d] - cumS[j * 65 + d])); }
#pragma unroll
      for (int i = 0; i < 2; ++i) { const int q = tid + 512 * i, jj = q >> 4, cc = q & 15;
          const v4u vv = *(const v4u*)(P.vg + (size_t)(t0 + jj) * 512 + 128 * h + 8 * cc);
#pragma unroll
          for (int e = 0; e < 8; ++e) { const unsigned w = vv[e >> 1]; vT[(8 * cc + e) * 72 + jj] = (bf16)((e & 1) ? (w >> 16) : (w & 0xffffu)); } }
      if (tid < 64) P.g[(size_t)(c * 4 + h) * 64 + tid] = __expf(cumS[63 * 65 + tid]); }
    __syncthreads();
    { const int d0 = (wave & 3) * 16;
#pragma unroll
      for (int q = 0; q < 4; ++q) { const int dv0 = ((wave >> 2) * 4 + q) * 16; f32x4 acc = (f32x4){0.f, 0.f, 0.f, 0.f};
#pragma unroll
          for (int kk = 0; kk < 2; ++kk) acc = MFMA16(frag(vT, dv0, 72, 32 * kk, fr, fq), frag(khT, d0, 72, 32 * kk, fr, fq), acc);
          *(f32x4*)(P.ds + ((size_t)(c * 4 + h) * 64 + d0 + fr) * 128 + dv0 + 4 * fq) = acc; } }
    __syncthreads();
}

__device__ __forceinline__ void gla_sample_unit(const Ptrs& P, LAS unsigned char* lds, int b, int h, int tid, int wave, int lane) {
    LAS float* cumS = (LAS float*)(lds);
    LAS float* qd = (LAS float*)(lds + 1024);
    LAS float* kd = (LAS float*)(lds + 2048);
    LAS float* ke = (LAS float*)(lds + 3072);
    LAS float* vS = (LAS float*)(lds + 4096);
    LAS float* attS = (LAS float*)(lds + 6144);
    LAS float* part = (LAS float*)(lds + 8192);
    const int r0 = SEQ + 4 * b;
    if (tid < 256) { const int t = tid >> 6, d = tid & 63; float x = P.b_gate[64 * h + d];
#pragma unroll
        for (int r = 0; r < 16; ++r) x += P.alr[(size_t)(r0 + t) * 16 + r] * P.w_gate_up[r * 256 + 64 * h + d];
        cumS[t * 64 + d] = logsig(x) * (1.0f / 16.0f); }
    { const int t = tid >> 7, dv = tid & 127; vS[t * 128 + dv] = bf1(P.vg[(size_t)(r0 + t) * 512 + 128 * h + dv]); }
    __syncthreads();
    if (tid < 64) { const int d = tid; float c0 = cumS[d], c1 = c0 + cumS[64 + d], c2 = c1 + cumS[128 + d], c3 = c2 + cumS[192 + d];
        cumS[d] = c0; cumS[64 + d] = c1; cumS[128 + d] = c2; cumS[192 + d] = c3; }
    __syncthreads();
    if (tid < 256) { const int t = tid >> 6, d = tid & 63; const float cu = cumS[t * 64 + d], c3 = cumS[192 + d];
        const float q = bf1(P.qg[(size_t)(r0 + t) * 256 + 64 * h + d]), k = bf1(P.kg[(size_t)(r0 + t) * 256 + 64 * h + d]);
        qd[t * 64 + d] = q * __expf(cu); kd[t * 64 + d] = k * __expf(c3 - cu); ke[t * 64 + d] = k * __expf(-cu); }
    __syncthreads();
    { const int pr = tid >> 5, l32 = tid & 31, i = pr >> 2, j = pr & 3;
      float s = qd[i * 64 + l32] * ke[j * 64 + l32] + qd[i * 64 + l32 + 32] * ke[j * 64 + l32 + 32];
#pragma unroll
      for (int o = 1; o < 32; o <<= 1) s += __shfl_xor(s, o);
      if (l32 == 0) attS[i * 4 + j] = (j <= i) ? s : 0.f; }
    __syncthreads();
    { const int dv = tid & 127, dg = tid >> 7; float po[4] = {0.f, 0.f, 0.f, 0.f};
      const size_t sbase = ((size_t)(b * 4 + h) * 64) * 128 + dv;
      const float v0 = vS[dv], v1 = vS[128 + dv], v2 = vS[256 + dv], v3 = vS[384 + dv];
#pragma unroll 4
      for (int dd = 0; dd < 16; ++dd) { const int d = 16 * dg + dd; const float s0 = P.state0[sbase + (size_t)d * 128];
          const float sn = s0 * __expf(cumS[192 + d]) + ((kd[d] * v0 + kd[64 + d] * v1) + (kd[128 + d] * v2 + kd[192 + d] * v3));
          P.out[O_SS + sbase + (size_t)d * 128] = sn;
          po[0] += qd[d] * s0; po[1] += qd[64 + d] * s0; po[2] += qd[128 + d] * s0; po[3] += qd[192 + d] * s0; }
#pragma unroll
      for (int t = 0; t < 4; ++t) part[(dg * 4 + t) * 128 + dv] = po[t]; }
    __syncthreads();
    { const int i = tid >> 7, dv = tid & 127;
      float o = (part[(0 * 4 + i) * 128 + dv] + part[(1 * 4 + i) * 128 + dv]) + (part[(2 * 4 + i) * 128 + dv] + part[(3 * 4 + i) * 128 + dv]);
#pragma unroll
      for (int j = 0; j < 4; ++j) o += attS[i * 4 + j] * vS[j * 128 + dv];
      float sq = wave_sum(o * o);
      if (lane == 0) cumS[wave] = sq;
      __syncthreads();
      const float tot = cumS[2 * i] + cumS[2 * i + 1];
      const float rs = rsqrtf(tot * (1.0f / 128.0f) + EPS);
      const float val = o * rs * P.g_head[128 * h + dv] * bf1(P.rg[(size_t)(r0 + i) * 512 + 128 * h + dv]);
      P.mix[(size_t)(r0 + i) * 1024 + 128 * h + dv] = (bf16)f2bf(val); }
    __syncthreads();
}

__device__ __forceinline__ void swa_sample_unit(const Ptrs& P, LAS unsigned char* lds, int b, int tid, int wave, int lane) {
    LAS float* qS = (LAS float*)(lds);
    LAS float* pS = (LAS float*)(lds + 8192);
    LAS float* oP = (LAS float*)(lds + 8192 + 17408);
    LAS float* oS = (LAS float*)(lds + 8192 + 17408 + 32768);
    const int r0 = SEQ + 4 * b;
    { const int t = tid >> 7, c4 = (tid & 127) * 4;
      const unsigned long long w = *(const unsigned long long*)(P.qs + (size_t)(r0 + t) * 512 + c4);
      qS[t * 512 + c4] = bflo((unsigned)w); qS[t * 512 + c4 + 1] = bfhi((unsigned)w); qS[t * 512 + c4 + 2] = bflo((unsigned)(w >> 32)); qS[t * 512 + c4 + 3] = bfhi((unsigned)(w >> 32)); }
    __syncthreads();
    if (tid < 264) {
        const int j = tid >> 1, kvh = tid & 1;
        const float* kp = (j < 128) ? P.ck_in + ((size_t)b * 128 + j) * 128 + 64 * kvh : P.out + O_CKS + ((size_t)b * 128 + 124 + (j - 128)) * 128 + 64 * kvh;
        float s[16];
#pragma unroll
        for (int i = 0; i < 16; ++i) s[i] = 0.f;
#pragma unroll 4
        for (int d4 = 0; d4 < 16; ++d4) { const f32x4 kv = *(const f32x4*)(kp + 4 * d4);
#pragma unroll
            for (int hl = 0; hl < 4; ++hl)
#pragma unroll
                for (int t = 0; t < 4; ++t) { const LAS float* qq = qS + t * 512 + 64 * (4 * kvh + hl) + 4 * d4;
                    s[hl * 4 + t] += (qq[0] * kv.x + qq[1] * kv.y) + (qq[2] * kv.z + qq[3] * kv.w); } }
#pragma unroll
        for (int hl = 0; hl < 4; ++hl)
#pragma unroll
            for (int t = 0; t < 4; ++t) { const bool valid = (j <= 128 + t) && (j >= t + 1); pS[((4 * kvh + hl) * 4 + t) * 136 + j] = valid ? s[hl * 4 + t] : -INFINITY; }
    }
    __syncthreads();
    {
#pragma unroll
        for (int rr = 0; rr < 4; ++rr) { const int row = 4 * wave + rr, hh = row >> 2; const float sink = P.sinks[hh];
            float v0 = pS[row * 136 + lane], v1 = pS[row * 136 + 64 + lane], v2 = (lane < 4) ? pS[row * 136 + 128 + lane] : -INFINITY;
            float m = fmaxf(fmaxf(v0, v1), v2);
#pragma unroll
            for (int o = 1; o < 64; o <<= 1) m = fmaxf(m, __shfl_xor(m, o));
            m = fmaxf(m, sink);
            const float e0 = __expf(v0 - m), e1 = __expf(v1 - m), e2 = (lane < 4) ? __expf(v2 - m) : 0.f;
            const float den = wave_sum(e0 + e1 + e2) + __expf(sink - m), inv = 1.0f / den;
            pS[row * 136 + lane] = e0 * inv; pS[row * 136 + 64 + lane] = e1 * inv; if (lane < 4) pS[row * 136 + 128 + lane] = e2 * inv; }
    }
    __syncthreads();
    {
        const int part = tid >> 7, kvh = (tid >> 6) & 1, d = tid & 63; float o[16];
#pragma unroll
        for (int i = 0; i < 16; ++i) o[i] = 0.f;
        for (int jj = 0; jj < 33; ++jj) { const int j = part * 33 + jj;
            const float* vp = (j < 128) ? P.cv_in + ((size_t)b * 128 + j) * 128 + 64 * kvh + d : P.out + O_CVS + ((size_t)b * 128 + 124 + (j - 128)) * 128 + 64 * kvh + d;
            const float vv = *vp;
#pragma unroll
            for (int hl = 0; hl < 4; ++hl)
#pragma unroll
                for (int t = 0; t < 4; ++t) o[hl * 4 + t] += pS[((4 * kvh + hl) * 4 + t) * 136 + j] * vv; }
#pragma unroll
        for (int hl = 0; hl < 4; ++hl)
#pragma unroll
            for (int t = 0; t < 4; ++t) oP[(part * 4 + t) * 512 + 64 * (4 * kvh + hl) + d] = o[hl * 4 + t];
    }
    __syncthreads();
    { const int t = tid >> 7, c4 = (tid & 127) * 4;
#pragma unroll
      for (int e = 0; e < 4; ++e) oS[t * 512 + c4 + e] = (oP[(0 * 4 + t) * 512 + c4 + e] + oP[(1 * 4 + t) * 512 + c4 + e]) + (oP[(2 * 4 + t) * 512 + c4 + e] + oP[(3 * 4 + t) * 512 + c4 + e]); }
    __syncthreads();
    if (wave < 4) { const int t = wave; float v[8]; float sq = 0.f;
#pragma unroll
        for (int e = 0; e < 8; ++e) { v[e] = oS[t * 512 + lane + 64 * e]; sq += v[e] * v[e]; }
        const float rs = rsqrtf(wave_sum(sq) * (1.0f / 512.0f) + EPS);
#pragma unroll
        for (int e = 0; e < 8; ++e) P.mix[(size_t)(r0 + t) * 1024 + 512 + lane + 64 * e] = (bf16)f2bf(v[e] * rs * P.g_swa[lane + 64 * e]); }
    __syncthreads();
}

__device__ __forceinline__ void gla_scan(const Ptrs& P, int sblk, int tid) {
    const int e = sblk * NTHR + tid;
    const int h = e >> 13, d = (e >> 7) & 63;
    float S = 0.f;
    float* dsp = P.ds + (size_t)h * 8192 + (e & 8191);
    const float* gp = P.g + (size_t)h * 64 + d;
    for (int c0 = 0; c0 < 256; c0 += 16) {
        float dsv[16], gv[16];
#pragma unroll
        for (int i = 0; i < 16; ++i) { dsv[i] = dsp[(size_t)(c0 + i) * 32768]; gv[i] = gp[(size_t)(c0 + i) * 256]; }
#pragma unroll
        for (int i = 0; i < 16; ++i) { dsp[(size_t)(c0 + i) * 32768] = S; S = S * gv[i] + dsv[i]; }
    }
    P.out[O_SP + e] = S;
}

__device__ __forceinline__ void swa_prompt_unit(const Ptrs& P, LAS unsigned char* lds, int qb, int g, int tid, int wave, int lane) {
    LAS bf16* Ks = (LAS bf16*)(lds);
    LAS bf16* VsT = (LAS bf16*)(lds + 23040);
    LAS bf16* Qs = (LAS bf16*)(lds + 44544);
    LAS bf16* Ps = (LAS bf16*)(lds + 62976);
    const int q0 = qb * 32, kbase = q0 - 128, fr = lane & 15, fq = lane >> 4;
    for (int q = tid; q < 1280; q += NTHR) { const int j = q >> 3, ch = q & 7, tok = kbase + j;
        v4u kk = (v4u){0u, 0u, 0u, 0u}, vv = (v4u){0u, 0u, 0u, 0u};
        if (tok >= 0) { const bf16* p = P.kvs + (size_t)tok * 256 + 64 * g + 8 * ch; kk = *(const v4u*)p; vv = *(const v4u*)(p + 128); }
        *(LAS v4u*)(Ks + j * 72 + 8 * ch) = kk;
#pragma unroll
        for (int e = 0; e < 8; ++e) { const unsigned w = vv[e >> 1]; VsT[(8 * ch + e) * 168 + j] = (bf16)((e & 1) ? (w >> 16) : (w & 0xffffu)); } }
    for (int q = tid; q < 1024; q += NTHR) { const int r = q >> 3, ch = q & 7, hl = r >> 5, ql = r & 31;
        *(LAS v4u*)(Qs + r * 72 + 8 * ch) = *(const v4u*)(P.qs + (size_t)(q0 + ql) * 512 + 64 * (4 * g + hl) + 8 * ch); }
    __syncthreads();
    const int r0 = 16 * wave, head = 4 * g + (wave >> 1), ql0 = 16 * (wave & 1);
    const int qpos = q0 + ql0 + fr; const float sink = P.sinks[head];
    f32x4 s[10];
#pragma unroll
    for (int t = 0; t < 10; ++t) s[t] = (f32x4){0.f, 0.f, 0.f, 0.f};
#pragma unroll
    for (int kk = 0; kk < 2; ++kk) { const bf16x8 bq = frag(Qs, r0, 72, 32 * kk, fr, fq);
#pragma unroll
        for (int t = 0; t < 10; ++t) s[t] = MFMA16(frag(Ks, 16 * t, 72, 32 * kk, fr, fq), bq, s[t]); }
    float m = -INFINITY;
#pragma unroll
    for (int t = 0; t < 10; ++t)
#pragma unroll
        for (int r = 0; r < 4; ++r) { const int kpos = kbase + 16 * t + 4 * fq + r; const bool valid = (kpos >= 0) && (kpos <= qpos) && (qpos - kpos < 128);
            s[t][r] = valid ? s[t][r] : -INFINITY; m = fmaxf(m, s[t][r]); }
    m = fmaxf(m, __shfl_xor(m, 16)); m = fmaxf(m, __shfl_xor(m, 32)); m = fmaxf(m, sink);
    float sum = 0.f;
#pragma unroll
    for (int t = 0; t < 10; ++t)
#pragma unroll
        for (int r = 0; r < 4; ++r) { const float p = __expf(s[t][r] - m); s[t][r] = p; sum += p; }
    sum += __shfl_xor(sum, 16); sum += __shfl_xor(sum, 32);
    const float inv = 1.0f / (sum + __expf(sink - m));
#pragma unroll
    for (int t = 0; t < 10; ++t) { unsigned long long w = (unsigned long long)pk2(s[t][0] * inv, s[t][1] * inv) | ((unsigned long long)pk2(s[t][2] * inv, s[t][3] * inv) << 32);
        *(LAS unsigned long long*)(Ps + (r0 + fr) * 168 + 16 * t + 4 * fq) = w; }
    __syncthreads();
    f32x4 o[4];
#pragma unroll
    for (int dt = 0; dt < 4; ++dt) o[dt] = (f32x4){0.f, 0.f, 0.f, 0.f};
#pragma unroll
    for (int ks = 0; ks < 5; ++ks) { const bf16x8 bp = frag(Ps, r0, 168, 32 * ks, fr, fq);
#pragma unroll
        for (int dt = 0; dt < 4; ++dt) o[dt] = MFMA16(frag(VsT, 16 * dt, 168, 32 * ks, fr, fq), bp, o[dt]); }
    float sq = 0.f;
#pragma unroll
    for (int dt = 0; dt < 4; ++dt) sq += (o[dt][0] * o[dt][0] + o[dt][1] * o[dt][1]) + (o[dt][2] * o[dt][2] + o[dt][3] * o[dt][3]);
    sq += __shfl_xor(sq, 16); sq += __shfl_xor(sq, 32);
    if (fq == 0) P.ssw[(size_t)qpos * 8 + head] = sq;
#pragma unroll
    for (int dt = 0; dt < 4; ++dt) { const unsigned long long w = (unsigned long long)pk2(o[dt][0], o[dt][1]) | ((unsigned long long)pk2(o[dt][2], o[dt][3]) << 32);
        *(unsigned long long*)(P.mix + (size_t)qpos * 1024 + 512 + 64 * head + 16 * dt + 4 * fq) = w; }
    __syncthreads();
}

__device__ __forceinline__ void gla_out_unit(const Ptrs& P, LAS unsigned char* lds, int c, int h, int tid, int wave, int lane) {
    LAS bf16* qT = (LAS bf16*)(lds);
    LAS bf16* kT = (LAS bf16*)(lds + 9216);
    LAS bf16* vT = (LAS bf16*)(lds + 18432);
    LAS bf16* sT = (LAS bf16*)(lds + 36864);
    LAS bf16* aS = (LAS bf16*)(lds + 55296);
    LAS float* oS = (LAS float*)(lds + 64512);
    const int t0 = c * 64, fr = lane & 15, fq = lane >> 4;
    { const int j = tid >> 3, dc = tid & 7;
      const v4u qq = *(const v4u*)(P.qg + (size_t)(t0 + j) * 256 + 64 * h + 8 * dc), kk = *(const v4u*)(P.kg + (size_t)(t0 + j) * 256 + 64 * h + 8 * dc);
      const float* cp = P.cum + (size_t)(t0 + j) * 256 + 64 * h + 8 * dc; const f32x4 c0 = *(const f32x4*)cp, c1 = *(const f32x4*)(cp + 4);
      float cu[8] = {c0[0], c0[1], c0[2], c0[3], c1[0], c1[1], c1[2], c1[3]}; v4u qo, ko;
#pragma unroll
      for (int e2 = 0; e2 < 4; ++e2) { const float ea = __expf(cu[2 * e2]), eb = __expf(cu[2 * e2 + 1]);
          qo[e2] = pk2(bflo(qq[e2]) * ea, bfhi(qq[e2]) * eb); ko[e2] = pk2(bflo(kk[e2]) / ea, bfhi(kk[e2]) / eb); }
      *(LAS v4u*)(qT + j * 72 + 8 * dc) = qo; *(LAS v4u*)(kT + j * 72 + 8 * dc) = ko;
#pragma unroll
      for (int i = 0; i < 2; ++i) { const int q = tid + 512 * i, jj = q >> 4, cc = q & 15;
          const v4u vv = *(const v4u*)(P.vg + (size_t)(t0 + jj) * 512 + 128 * h + 8 * cc);
#pragma unroll
          for (int e = 0; e < 8; ++e) { const unsigned w = vv[e >> 1]; vT[(8 * cc + e) * 72 + jj] = (bf16)((e & 1) ? (w >> 16) : (w & 0xffffu)); } }
#pragma unroll
      for (int i = 0; i < 4; ++i) { const int q = tid + 512 * i, d = q >> 5, dv4 = (q & 31) * 4;
          const f32x4 sv = *(const f32x4*)(P.ds + ((size_t)(c * 4 + h) * 64 + d) * 128 + dv4);
#pragma unroll
          for (int e = 0; e < 4; ++e) sT[(dv4 + e) * 72 + d] = (bf16)f2bf(sv[e]); } }
    __syncthreads();
    { const int i0 = (wave >> 1) * 16;
#pragma unroll
      for (int q = 0; q < 2; ++q) { const int j0 = ((wave & 1) * 2 + q) * 16; f32x4 acc = (f32x4){0.f, 0.f, 0.f, 0.f};
#pragma unroll
          for (int kk = 0; kk < 2; ++kk) acc = MFMA16(frag(kT, j0, 72, 32 * kk, fr, fq), frag(qT, i0, 72, 32 * kk, fr, fq), acc);
          const int i = i0 + fr, jb = j0 + 4 * fq;
          const unsigned long long w = (unsigned long long)pk2(jb <= i ? acc[0] : 0.f, jb + 1 <= i ? acc[1] : 0.f) | ((unsigned long long)pk2(jb + 2 <= i ? acc[2] : 0.f, jb + 3 <= i ? acc[3] : 0.f) << 32);
          *(LAS unsigned long long*)(aS + i * 72 + jb) = w; } }
    __syncthreads();
    { const int i0 = (wave & 3) * 16;
#pragma unroll
      for (int q = 0; q < 4; ++q) { const int dv0 = ((wave >> 2) * 4 + q) * 16; f32x4 acc = (f32x4){0.f, 0.f, 0.f, 0.f};
#pragma unroll
          for (int kk = 0; kk < 2; ++kk) { acc = MFMA16(frag(vT, dv0, 72, 32 * kk, fr, fq), frag(aS, i0, 72, 32 * kk, fr, fq), acc);
                                           acc = MFMA16(frag(sT, dv0, 72, 32 * kk, fr, fq), frag(qT, i0, 72, 32 * kk, fr, fq), acc); }
          *(LAS f32x4*)(oS + (i0 + fr) * 132 + dv0 + 4 * fq) = acc; } }
    __syncthreads();
    { const int i = tid >> 3, seg = tid & 7, tok = t0 + i, col = 128 * h + 16 * seg;
      f32x4 ov[4]; float sq = 0.f;
#pragma unroll
      for (int e = 0; e < 4; ++e) { ov[e] = *(const LAS f32x4*)(oS + i * 132 + 16 * seg + 4 * e); sq += (ov[e][0] * ov[e][0] + ov[e][1] * ov[e][1]) + (ov[e][2] * ov[e][2] + ov[e][3] * ov[e][3]); }
      sq += __shfl_xor(sq, 1); sq += __shfl_xor(sq, 2); sq += __shfl_xor(sq, 4);
      const float rs = rsqrtf(sq * (1.0f / 128.0f) + EPS);
      const v4u r0 = *(const v4u*)(P.rg + (size_t)tok * 512 + col), r1 = *(const v4u*)(P.rg + (size_t)tok * 512 + col + 8);
      v4u w0, w1;
#pragma unroll
      for (int e2 = 0; e2 < 4; ++e2) { const int cc = col + 2 * e2;
          w0[e2] = pk2(ov[e2 >> 1][(2 * e2) & 3] * rs * P.g_head[cc] * bflo(r0[e2]), ov[e2 >> 1][(2 * e2 + 1) & 3] * rs * P.g_head[cc + 1] * bfhi(r0[e2]));
          w1[e2] = pk2(ov[2 + (e2 >> 1)][(2 * e2) & 3] * rs * P.g_head[cc + 8] * bflo(r1[e2]), ov[2 + (e2 >> 1)][(2 * e2 + 1) & 3] * rs * P.g_head[cc + 9] * bfhi(r1[e2])); }
      *(v4u*)(P.mix + (size_t)tok * 1024 + col) = w0; *(v4u*)(P.mix + (size_t)tok * 1024 + col + 8) = w1;
      const f32x4 sa = *(const f32x4*)(P.ssw + (size_t)tok * 8), sb = *(const f32x4*)(P.ssw + (size_t)tok * 8 + 4);
      const float rs2 = rsqrtf((((sa[0] + sa[1]) + (sa[2] + sa[3])) + ((sb[0] + sb[1]) + (sb[2] + sb[3]))) * (1.0f / 512.0f) + EPS);
      bf16* mp = P.mix + (size_t)tok * 1024 + 512 + col; const v4u a0 = *(const v4u*)mp, a1 = *(const v4u*)(mp + 8); v4u b0, b1;
#pragma unroll
      for (int e2 = 0; e2 < 4; ++e2) { const int cc = col + 2 * e2;
          b0[e2] = pk2(bflo(a0[e2]) * rs2 * P.g_swa[cc], bfhi(a0[e2]) * rs2 * P.g_swa[cc + 1]);
          b1[e2] = pk2(bflo(a1[e2]) * rs2 * P.g_swa[cc + 8], bfhi(a1[e2]) * rs2 * P.g_swa[cc + 9]); }
      *(v4u*)mp = b0; *(v4u*)(mp + 8) = b1; }
    __syncthreads();
}

__device__ __forceinline__ void final_norm(const Ptrs& P, int wave, int lane, int vcu, int G) {
    const int gw = vcu * NWAVES + wave, NGW = G * NWAVES;
    for (int m = gw; m < M; m += NGW) {
        const float rs = pg8::row_rs16(P.ss, m);
        GAS f32x4* xr = (GAS f32x4*)(P.out + (size_t)m * D) + lane;
#pragma unroll
        for (int j = 0; j < 4; ++j) { const f32x4 gg = *((const GAS f32x4*)P.g_final + lane + 64 * j); f32x4 v = xr[64 * j]; v = v * rs * gg; xr[64 * j] = v; }
    }
}

#ifndef MK_N_LAUNCHES
#define MK_N_LAUNCHES 1
#endif
constexpr int N_PHASES = 11;
__global__ void __launch_bounds__(NTHR, 2) hymba_fwd(Args args) {
    extern __shared__ __attribute__((aligned(16))) unsigned char lds_raw[];
    LAS unsigned char* lds = (LAS unsigned char*)lds_raw;
    volatile LAS unsigned* MISC = (volatile LAS unsigned*)(lds + MISC_OFF);
    const int tid = threadIdx.x, lane = tid & 63, wave = __builtin_amdgcn_readfirstlane(tid >> 6);
    const int G = gridDim.x, bx = blockIdx.x, vcu = (G % 8 == 0) ? (bx % 8) * (G / 8) + bx / 8 : bx;
    unsigned char* ws = args.ws;
    Ptrs P;
    P.x_p = args.in[0]; P.x_s = args.in[1]; P.state0 = args.in[2]; P.ck_in = args.in[3]; P.cv_in = args.in[4]; P.g_ffn1 = args.in[5]; P.wg1 = args.in[6]; P.wu1 = args.in[7]; P.wd1 = args.in[8];
    P.g_mix = args.in[9]; P.w_in = args.in[10]; P.w_gate_up = args.in[11]; P.b_gate = args.in[12]; P.g_head = args.in[13]; P.g_swa = args.in[14]; P.sinks = args.in[15]; P.w_out = args.in[16];
    P.g_ffn2 = args.in[17]; P.wg2 = args.in[18]; P.wu2 = args.in[19]; P.wd2 = args.in[20]; P.g_final = args.in[21];
    P.out = args.out;
    P.wgu1 = (bf16*)(ws + WS_WGU1); P.wd1t = (bf16*)(ws + WS_WD1); P.wgu2 = (bf16*)(ws + WS_WGU2); P.wd2t = (bf16*)(ws + WS_WD2); P.wint = (bf16*)(ws + WS_WIN); P.woutt = (bf16*)(ws + WS_WOUT);
    P.xn = (bf16*)(ws + WS_XN); P.mix = (bf16*)(ws + WS_MIX); P.hbuf = (bf16*)(ws + WS_R);
    P.qg = (bf16*)(ws + WS_R + R_QG); P.kg = (bf16*)(ws + WS_R + R_KG); P.vg = (bf16*)(ws + WS_R + R_VG); P.rg = (bf16*)(ws + WS_R + R_RG); P.qs = (bf16*)(ws + WS_R + R_QS); P.kvs = (bf16*)(ws + WS_R + R_KVS);
    P.cum = (float*)(ws + WS_R + R_CUM);
    P.ss = (float*)(ws + WS_SS); P.ssw = (float*)(ws + WS_SSW); P.alr = (float*)(ws + WS_ALR); P.g = (float*)(ws + WS_G); P.ds = (float*)(ws + WS_DS);

    for (int u = tid; u < (LDS_BYTES - RING_BYTES) / 4; u += NTHR) ((LAS unsigned*)(lds + RING_BYTES))[u] = 0u;
    __syncthreads();
    const int lo = args.ph_lo, hi = args.ph_hi;
    XcdBarrier bar; bar.bar = (unsigned*)(ws + WS_CTL); bar.x = 0; bar.st = nullptr;
    if (hi - lo > 1) bar = xcd_barrier_post((unsigned*)(ws + WS_CTL), MISC + 8);
#define IN(k) (lo <= (k) && (k) < hi)
#define SEAM(k) do { if (IN(k) && IN((k) + 1)) xcd_barrier(bar); } while (0)

    if (IN(0)) p0_prologue(P, lds, tid, wave, lane, vcu, G);
    SEAM(0);
    if (IN(1)) { pg8::Gemm g{P.xn, P.wgu1, M, 5632, 1024}; pg8::StaticOrder S; S.init(M, 5632, G, bx); pg8::EpiGU E{P.hbuf, nullptr};
        pg8::gemm_phase<pg8::EpiGU, pg8::StaticOrder, true, true>(lds, g, S, E); }
    SEAM(1);
    if (IN(2)) { pg8::Gemm g{P.hbuf, P.wd1t, M, 1024, 2816}; pg8::StaticOrder S; S.init(M, 1024, G, bx); pg8::EpiRes E{P.x_p, P.x_s, P.out, P.xn, P.g_mix, P.ss, 0.5f};
        pg8::gemm_phase<pg8::EpiRes, pg8::StaticOrder, true, true>(lds, g, S, E); }
    SEAM(2);
    if (IN(3)) { pg8::Gemm g{P.xn, P.wint, M, NPROJ, 1024}; pg8::StaticOrder S; S.init(M, NPROJ, G, bx);
        pg8::EpiProj E{P.ss, P.qg, P.kg, P.vg, P.rg, P.qs, P.kvs, P.alr, P.out + O_CKP, P.out + O_CVP, P.out + O_CKS, P.out + O_CVS};
        pg8::gemm_phase<pg8::EpiProj, pg8::StaticOrder, true, true>(lds, g, S, E); }
    SEAM(3);
    if (IN(4)) {
        for (int u = bx; u < 1024 + 512 + 128; u += G) {
            if (u < 1024) gla_local_unit(P, lds, u >> 2, u & 3, tid, wave, lane);
            else if (u < 1536) gla_sample_unit(P, lds, (u - 1024) >> 2, (u - 1024) & 3, tid, wave, lane);
            else swa_sample_unit(P, lds, u - 1536, tid, wave, lane);
        }
    }
    SEAM(4);
    if (IN(5)) {
        const int nscan = (G > 128) ? 64 : 0;
        if (bx < nscan) gla_scan(P, bx, tid);
        else {
            if (nscan == 0) for (int sb = bx; sb < 64; sb += G) gla_scan(P, sb, tid);
            for (int u = bx - nscan; u < 1024; u += G - nscan) swa_prompt_unit(P, lds, u >> 1, u & 1, tid, wave, lane);
        }
    }
    SEAM(5);
    if (IN(6)) { for (int u = bx; u < 1024; u += G) gla_out_unit(P, lds, u >> 2, u & 3, tid, wave, lane); }
    SEAM(6);
    if (IN(7)) { pg8::Gemm g{P.mix, P.woutt, M, 1024, 1024}; pg8::StaticOrder S; S.init(M, 1024, G, bx); pg8::EpiRes E{P.out, P.out + (size_t)SEQ * 1024, P.out, P.xn, P.g_ffn2, P.ss, 1.0f};
        pg8::gemm_phase<pg8::EpiRes, pg8::StaticOrder, true, true>(lds, g, S, E); }
    SEAM(7);
    if (IN(8)) { pg8::Gemm g{P.xn, P.wgu2, M, 5632, 1024}; pg8::StaticOrder S; S.init(M, 5632, G, bx); pg8::EpiGU E{P.hbuf, P.ss};
        pg8::gemm_phase<pg8::EpiGU, pg8::StaticOrder, true, true>(lds, g, S, E); }
    SEAM(8);
    if (IN(9)) { pg8::Gemm g{P.hbuf, P.wd2t, M, 1024, 2816}; pg8::StaticOrder S; S.init(M, 1024, G, bx); pg8::EpiRes E{P.out, P.out + (size_t)SEQ * 1024, P.out, nullptr, nullptr, P.ss, 0.5f};
        pg8::gemm_phase<pg8::EpiRes, pg8::StaticOrder, true, true>(lds, g, S, E); }
    SEAM(9);
    if (IN(10)) final_norm(P, wave, lane, vcu, G);
#undef IN
#undef SEAM
}

extern "C" void kernel_launch(void* const* d_in, const int* in_sizes, int n_in, void* d_out, int out_size, void* d_ws, size_t ws_size, hipStream_t stream) {
    static int grid = 0;
    if (grid == 0) {
        if (n_in != 22 || (size_t)out_size != O_END || ws_size < WS_END) { fprintf(stderr, "kernel_launch: unexpected shapes (n_in %d, out %d, ws %zu); nothing launched\n", n_in, out_size, ws_size); grid = -1; return; }
        int dev = 0, cus = 0, per_cu = 0;
        if (hipGetDevice(&dev) != hipSuccess || hipDeviceGetAttribute(&cus, hipDeviceAttributeMultiprocessorCount, dev) != hipSuccess) { grid = -1; return; }
        if (hipFuncSetAttribute((const void*)hymba_fwd, hipFuncAttributeMaxDynamicSharedMemorySize, LDS_BYTES) != hipSuccess) { fprintf(stderr, "kernel_launch: hipFuncSetAttribute failed\n"); grid = -1; return; }
        if (hipOccupancyMaxActiveBlocksPerMultiprocessor(&per_cu, (const void*)hymba_fwd, NTHR, LDS_BYTES) != hipSuccess || per_cu < 1) { fprintf(stderr, "kernel_launch: occupancy query says %d blocks per CU\n", per_cu); (void)hipGetLastError(); grid = -1; return; }
        grid = cus;
    }
    if (grid < 0) return;
    if (hipMemsetAsync((char*)d_ws + WS_CTL, 0, CTL_ZERO_BYTES, stream) != hipSuccess) return;
    Args a{};
    for (int i = 0; i < 22; ++i) a.in[i] = (const float*)d_in[i];
    a.out = (float*)d_out; a.ws = (unsigned char*)d_ws;
#if MK_N_LAUNCHES == 1
    a.ph_lo = 0; a.ph_hi = N_PHASES;
    void* kargs[] = {&a};
    hipError_t e = hipLaunchCooperativeKernel((const void*)hymba_fwd, dim3(grid), dim3(NTHR), kargs, LDS_BYTES, stream);
    if (e != hipSuccess) fprintf(stderr, "kernel_launch: cooperative launch failed: %s (grid %d)\n", hipGetErrorString(e), grid);
#else
    for (int p = 0; p < N_PHASES; ++p) { a.ph_lo = p; a.ph_hi = p + 1; hipLaunchKernelGGL(hymba_fwd, dim3(grid), dim3(NTHR), LDS_BYTES, stream, a); }
#endif
}
```

```cpp
#include <hip/hip_runtime.h>
#include <hip/hip_cooperative_groups.h>
#include <cstdio>
#include <cstdint>
namespace cg = cooperative_groups;

constexpr int D = 1024, SEQ = 16384, NSAMP = 512, M = SEQ + NSAMP, FF = 2816, DIN = 2320, NPROJ = 2560;
constexpr int DECB = 128, DECT = 4;
constexpr float EPS = 1e-6f;
namespace pg8 {
#define PG8_LAS __attribute__((address_space(3)))
typedef unsigned short bf16_t;
typedef short bf16x8 __attribute__((ext_vector_type(8)));
typedef float f32x4 __attribute__((ext_vector_type(4)));
typedef unsigned u32x4 __attribute__((ext_vector_type(4)));
constexpr int BM = 256, BK = 64, HALF = 128, HTB = HALF * BK * 2  , STAGE_BYTES = 8 * HTB, NXCD = 8, WGM = 8;

__host__ __device__ __forceinline__ int lds_byte(int r, int c) { const int st = (r >> 4) * 2 + (c >> 5), rr = r & 15, cc = c & 31, ob = rr * 64 + cc * 2; return st * 1024 + (ob ^ (((ob >> 9) & 1) << 5)); }
__host__ __device__ __forceinline__ void stage_rc(int b, int& R, int& C) { const int st = b / 1024, sb = b % 1024, swz = sb ^ (((sb >> 9) & 1) << 5); R = (st >> 1) * 16 + swz / 64; C = (st & 1) * 32 + (swz % 64) / 2; }
__host__ __device__ __forceinline__ int perm32(int rho) { const int n = rho >> 4, i = rho & 15; return 8 * (i >> 2) + 4 * n + (i & 3); }

struct Unit { int pm, pn; };
struct Gemm { const bf16_t* A; const bf16_t* Bt; int M, N, K, ld; };

struct StaticOrder {
    int nM, nN, nwg, G, c;
    __host__ __device__ void init(int M, int N, int G_, int c_) { nM = M / BM; nN = N / BM; nwg = nM * nN; G = G_; c = c_; }
    __host__ __device__ bool next(int i, Unit& u) const {
        const long L = (long)i * G + c; if (L >= nwg) return false;
        int wgid = (int)L; { const int q = nwg / NXCD, r = nwg % NXCD, xcd = wgid % NXCD, off = wgid / NXCD; wgid = (xcd < r ? xcd * (q + 1) : r * (q + 1) + (xcd - r) * q) + off; }
        const int nig = WGM * nN, gid = wgid / nig, fm = gid * WGM, gsz = (nM - fm) < WGM ? (nM - fm) : WGM;
        u.pm = fm + ((wgid % nig) % gsz); u.pn = (wgid % nig) / gsz; return true;
    }
    __device__ __forceinline__ void a_ready(const Unit&) const {}
    __device__ __forceinline__ void done(const Unit&) const {}
};

__device__ __forceinline__ unsigned cvt_pk_bf16(float lo, float hi) { unsigned r; asm volatile("v_cvt_pk_bf16_f32 %0, %1, %2" : "=v"(r) : "v"(lo), "v"(hi)); return r; }
typedef float f32x2 __attribute__((ext_vector_type(2)));
__device__ __forceinline__ float row_rs16(const float* ss, int row) {
    const f32x4* p = (const f32x4*)(ss + (size_t)row * 16);
    const f32x4 t = (p[0] + p[1]) + (p[2] + p[3]);
    return rsqrtf(((t[0] + t[1]) + (t[2] + t[3])) * (1.0f / 1024.0f) + 1e-6f);
}
__device__ __forceinline__ float silu_f(float g) { return g * __builtin_amdgcn_rcpf(1.0f + __builtin_amdgcn_exp2f(-1.4426950408889634f * g)); }

struct EpiGU {
    static constexpr bool PERM = true, AFTER_DRAIN = false;
    bf16_t* H; const float* ss;
    __device__ __forceinline__ void operator()(const f32x4 (&acc)[2][2][4][2], const Unit& u, int wr, int wc, int fr, int fq) const {
        const int row0 = u.pm * BM + wr * 64 + fr;
        const int col0 = u.pn * 128 + wc * 32 + 8 * fq;
#pragma unroll
        for (int ai = 0; ai < 2; ++ai)
#pragma unroll
            for (int m = 0; m < 4; ++m) {
                const int row = row0 + ai * HALF + m * 16;
                float rs = 1.0f;
                if (ss) rs = row_rs16(ss, row);
                float h[8];
#pragma unroll
                for (int n = 0; n < 2; ++n)
#pragma unroll
                    for (int e = 0; e < 4; ++e) { const float g = acc[ai][0][m][n][e] * rs, up = acc[ai][1][m][n][e] * rs; h[4 * n + e] = silu_f(g) * up; }
                u32x4 w; w.x = cvt_pk_bf16(h[0], h[1]); w.y = cvt_pk_bf16(h[2], h[3]); w.z = cvt_pk_bf16(h[4], h[5]); w.w = cvt_pk_bf16(h[6], h[7]);
                *(u32x4*)(H + (size_t)row * 2816 + col0) = w;
            }
    }
};

struct EpiRes {
    static constexpr bool PERM = true, AFTER_DRAIN = false;
    const float* xp; const float* xs; float* out; bf16_t* xn; const float* gain; float* ss; float scale;
    __device__ __forceinline__ void operator()(const f32x4 (&acc)[2][2][4][2], const Unit& u, int wr, int wc, int fr, int fq) const {
        const int row0 = u.pm * BM + wr * 64 + fr;
        const int col0 = u.pn * BM + wc * 32 + 8 * fq;
        f32x4 gv[2][2];
#pragma unroll
        for (int bj = 0; bj < 2; ++bj)
#pragma unroll
            for (int n = 0; n < 2; ++n) gv[bj][n] = xn ? *(const f32x4*)(gain + col0 + bj * HALF + 4 * n) : (f32x4){1.f, 1.f, 1.f, 1.f};
#pragma unroll
        for (int ai = 0; ai < 2; ++ai)
#pragma unroll
            for (int m = 0; m < 4; ++m) {
                const int row = row0 + ai * HALF + m * 16;
                const float* rp = (row < 16384 ? xp + (size_t)row * 1024 : xs + (size_t)(row - 16384) * 1024) + col0;
                float* op = out + (size_t)row * 1024 + col0;
                float sq = 0.f;
#pragma unroll
                for (int bj = 0; bj < 2; ++bj) {
                    const f32x4 r0 = *(const f32x4*)(rp + bj * HALF), r1 = *(const f32x4*)(rp + bj * HALF + 4);
                    const f32x4 v0 = r0 + acc[ai][bj][m][0] * scale, v1 = r1 + acc[ai][bj][m][1] * scale;
                    *(f32x4*)(op + bj * HALF) = v0; *(f32x4*)(op + bj * HALF + 4) = v1;
                    sq += (v0[0] * v0[0] + v0[1] * v0[1]) + (v0[2] * v0[2] + v0[3] * v0[3]);
                    sq += (v1[0] * v1[0] + v1[1] * v1[1]) + (v1[2] * v1[2] + v1[3] * v1[3]);
                    if (xn) { const f32x4 a = v0 * gv[bj][0], b = v1 * gv[bj][1];
                        u32x4 w; w.x = cvt_pk_bf16(a[0], a[1]); w.y = cvt_pk_bf16(a[2], a[3]); w.z = cvt_pk_bf16(b[0], b[1]); w.w = cvt_pk_bf16(b[2], b[3]);
                        *(u32x4*)(xn + (size_t)row * 1024 + col0 + bj * HALF) = w; }
                }
                sq += __shfl_xor(sq, 16); sq += __shfl_xor(sq, 32);
                if (fq == 0) ss[(size_t)row * 16 + u.pn * 4 + wc] = sq;
            }
    }
};

struct EpiProj {
    static constexpr bool PERM = true, AFTER_DRAIN = false;
    const float* ss; bf16_t *qg, *kg, *vg, *rg, *qs, *kvs; float* alr; float *ckp, *cvp, *cks, *cvs;
    __device__ __forceinline__ void operator()(const f32x4 (&acc)[2][2][4][2], const Unit& u, int wr, int wc, int fr, int fq) const {
        const int row0 = u.pm * BM + wr * 64 + fr;
        const int pn = u.pn;
#pragma unroll
        for (int ai = 0; ai < 2; ++ai)
#pragma unroll
            for (int m = 0; m < 4; ++m) {
                const int row = row0 + ai * HALF + m * 16;
                const float rs = row_rs16(ss, row);
#pragma unroll
                for (int bj = 0; bj < 2; ++bj) {
                    const int cl = bj * HALF + wc * 32 + 8 * fq;
                    f32x4 v0 = acc[ai][bj][m][0] * rs, v1 = acc[ai][bj][m][1] * rs;
                    if (pn == 9) {
                        if (cl < 16) { float* p = alr + (size_t)row * 16 + cl; *(f32x4*)p = v0; *(f32x4*)(p + 4) = v1; }
                        continue;
                    }
                    bf16_t* dst;
                    if (pn == 0) { dst = qg + (size_t)row * 256 + cl; v0 = v0 * 0.125f; v1 = v1 * 0.125f; }
                    else if (pn == 1) { dst = kg + (size_t)row * 256 + cl; }
                    else if (pn < 4) { dst = vg + (size_t)row * 512 + (pn - 2) * 256 + cl; }
                    else if (pn < 6) { dst = rg + (size_t)row * 512 + (pn - 4) * 256 + cl;
#pragma unroll
                        for (int e = 0; e < 4; ++e) { v0[e] = silu_f(v0[e]); v1[e] = silu_f(v1[e]); } }
                    else if (pn < 8) { dst = qs + (size_t)row * 512 + (pn - 6) * 256 + cl; v0 = v0 * 0.125f; v1 = v1 * 0.125f; }
                    else { dst = kvs + (size_t)row * 256 + cl;
                        float* cp = nullptr;
                        if (row >= 16384) { const int sr = row - 16384; cp = (bj ? cvs : cks) + ((size_t)(sr >> 2) * 128 + 124 + (sr & 3)) * 128 + (cl & 127); }
                        else if (row >= 16384 - 128) { cp = (bj ? cvp : ckp) + (size_t)(row - (16384 - 128)) * 128 + (cl & 127); }
                        if (cp) { *(f32x4*)cp = v0; *(f32x4*)(cp + 4) = v1; }
                    }
                    u32x4 w; w.x = cvt_pk_bf16(v0[0], v0[1]); w.y = cvt_pk_bf16(v0[2], v0[3]); w.z = cvt_pk_bf16(v1[0], v1[1]); w.w = cvt_pk_bf16(v1[2], v1[3]);
                    *(u32x4*)dst = w;
                }
            }
    }
};

struct EpiPartial {
    static constexpr bool PERM = true, AFTER_DRAIN = false;
    float* slab;
    __device__ __forceinline__ void operator()(const f32x4 (&acc)[2][2][4][2], const Unit& u, int wr, int wc, int fr, int fq) const {
        const int row0 = (u.pm - 64) * BM + wr * 64 + fr;
        const int col0 = u.pn * BM + wc * 32 + 8 * fq;
#pragma unroll
        for (int ai = 0; ai < 2; ++ai)
#pragma unroll
            for (int m = 0; m < 4; ++m) { float* rp = slab + (size_t)(row0 + ai * HALF + m * 16) * 1024 + col0;
#pragma unroll
                for (int bj = 0; bj < 2; ++bj) { *(f32x4*)(rp + bj * HALF) = acc[ai][bj][m][0]; *(f32x4*)(rp + bj * HALF + 4) = acc[ai][bj][m][1]; } }
    }
};
struct SubOrder {
    StaticOrder S; int pm0; bool on;
    __device__ __forceinline__ void init(int nMp, int N, int b0, int nb, int pm0_, int bx) { on = (bx >= b0) && (bx < b0 + nb); S.init(nMp * BM, N, nb, on ? bx - b0 : 0); pm0 = pm0_; }
    __device__ __forceinline__ bool next(int i, Unit& u) const { if (!on) return false; if (!S.next(i, u)) return false; u.pm += pm0; return true; }
    __device__ __forceinline__ void a_ready(const Unit&) const {}
    __device__ __forceinline__ void done(const Unit&) const {}
};
struct OneUnit {
    Unit u0; bool on;
    __device__ __forceinline__ bool next(int i, Unit& u) const { if (!on || i != 0) return false; u = u0; return true; }
    __device__ __forceinline__ void a_ready(const Unit&) const {}
    __device__ __forceinline__ void done(const Unit&) const {}
};
template <class Epi, class Sched, bool ALIGN_EPI = false, bool SP2 = false>
__device__ __forceinline__ void gemm_phase(PG8_LAS unsigned char* lds, const Gemm g, const Sched& S, const Epi& E) {
    const int tid = threadIdx.x, wid = __builtin_amdgcn_readfirstlane(tid >> 6), lane = tid & 63, wr = wid >> 2, wc = wid & 3, fr = lane & 15, fq = lane >> 4;
    const int K = g.ld, nt = g.K / BK;
    unsigned voffA[2], voffB[2];
#pragma unroll
    for (int i = 0; i < 2; ++i) { int R, C; stage_rc(tid * 16 + i * 8192, R, C); const int Rb = Epi::PERM ? ((R & ~31) + perm32(R & 31)) : R;
        voffA[i] = (unsigned)(R * K + C) * 2u; voffB[i] = (unsigned)(Rb * K + C) * 2u; }
    const size_t kstep = (size_t)(BK * 2);
    const size_t hstep = (size_t)HALF * K * 2;
    const size_t tstep = 2 * hstep;
    const unsigned ldsw = (unsigned)wid * 1024u;
    const int aoff = lds_byte(wr * 64 + fr, fq * 8), boff = lds_byte(wc * 32 + fr, fq * 8);
#define PG8_SA(b, h) (((b) * 2 + (h)) * HTB)
#define PG8_SB(b, h) ((4 + (b) * 2 + (h)) * HTB)
#define PG8_STAGE(bufoff, gbase, voff) do { _Pragma("unroll") for (int _i = 0; _i < 2; ++_i) \
        __builtin_amdgcn_global_load_lds((const unsigned*)((const char*)(gbase) + (voff)[_i]), (PG8_LAS unsigned*)(lds + (bufoff) + ldsw + _i * 8192), 16, 0, 0); } while (0)
#define PG8_LDA(dst, b, h) do { _Pragma("unroll") for (int m = 0; m < 4; ++m) _Pragma("unroll") for (int k = 0; k < 2; ++k) dst[m][k] = *(const PG8_LAS bf16x8*)(lds + PG8_SA(b, h) + aoff + m * 2048 + k * 1024); } while (0)
#define PG8_LDB(dst, b, h) do { _Pragma("unroll") for (int n = 0; n < 2; ++n) _Pragma("unroll") for (int k = 0; k < 2; ++k) dst[n][k] = *(const PG8_LAS bf16x8*)(lds + PG8_SB(b, h) + boff + n * 2048 + k * 1024); } while (0)
#define PG8_MMA(ai, bj, At, Bt) do { __builtin_amdgcn_s_setprio(1); _Pragma("unroll") for (int m = 0; m < 4; ++m) _Pragma("unroll") for (int n = 0; n < 2; ++n) _Pragma("unroll") for (int k = 0; k < 2; ++k) \
        acc[ai][bj][m][n] = __builtin_amdgcn_mfma_f32_16x16x32_bf16(Bt[n][k], At[m][k], acc[ai][bj][m][n], 0, 0, 0); __builtin_amdgcn_s_setprio(0); } while (0)
#define PG8_WAIT_V(n) asm volatile("s_waitcnt vmcnt(" #n ")" ::: "memory")
#define PG8_WAIT_L(n) asm volatile("s_waitcnt lgkmcnt(" #n ")" ::: "memory")
#define PG8_BAR __builtin_amdgcn_s_barrier()
#define PG8_SCHED __builtin_amdgcn_sched_barrier(0)
    Unit cur, nxt; int ui = 0;
    if (!S.next(0, cur)) return;
    f32x4 acc[2][2][4][2];
#pragma unroll
    for (int a = 0; a < 2; ++a)
#pragma unroll
        for (int b = 0; b < 2; ++b)
#pragma unroll
            for (int m = 0; m < 4; ++m)
#pragma unroll
                for (int n = 0; n < 2; ++n) acc[a][b][m][n] = (f32x4){0.f, 0.f, 0.f, 0.f};
    bf16x8 At[4][2], B0[2][2], B1[2][2];
    const char* cA = (const char*)g.A + (size_t)cur.pm * tstep; const char* cB = (const char*)g.Bt + (size_t)cur.pn * tstep;
    S.a_ready(cur);
    if constexpr (SP2) {
        PG8_STAGE(PG8_SB(0, 0), cB, voffB); PG8_STAGE(PG8_SB(0, 1), cB + hstep, voffB); PG8_STAGE(PG8_SA(0, 0), cA, voffA); PG8_STAGE(PG8_SA(0, 1), cA + hstep, voffA);
        if (wr == 1) PG8_BAR;
        PG8_WAIT_V(2); PG8_BAR;
        PG8_STAGE(PG8_SB(1, 0), cB + kstep, voffB); PG8_STAGE(PG8_SA(1, 0), cA + kstep, voffA); PG8_STAGE(PG8_SB(1, 1), cB + hstep + kstep, voffB);
        PG8_WAIT_V(6); PG8_BAR;
    } else {
        PG8_STAGE(PG8_SB(0, 0), cB, voffB); PG8_STAGE(PG8_SA(0, 0), cA, voffA); PG8_STAGE(PG8_SB(0, 1), cB + hstep, voffB); PG8_STAGE(PG8_SA(0, 1), cA + hstep, voffA);
        if (wr == 1) PG8_BAR;
        PG8_WAIT_V(4); PG8_BAR;
        PG8_STAGE(PG8_SB(1, 0), cB + kstep, voffB); PG8_STAGE(PG8_SA(1, 0), cA + kstep, voffA); PG8_STAGE(PG8_SB(1, 1), cB + hstep + kstep, voffB);
        PG8_WAIT_V(6); PG8_BAR;
    }
    for (;;) {
        const bool has_next = S.next(ui + 1, nxt);
        const char* nA = has_next ? (const char*)g.A + (size_t)nxt.pm * tstep : cA; const char* nB = has_next ? (const char*)g.Bt + (size_t)nxt.pn * tstep : cB;
        for (int t = 0; t < nt; t += 2) {
            const bool last = (t == nt - 2);
            const char* a1 = cA + (size_t)(t + 1) * kstep;
            const char* a2 = last ? nA : cA + (size_t)(t + 2) * kstep; const char* b2 = last ? nB : cB + (size_t)(t + 2) * kstep;
            const char* a3 = a2 + kstep; const char* b3 = b2 + kstep;
            if (last && has_next) S.a_ready(nxt);
            if constexpr (SP2) {
            PG8_LDB(B0, 0, 0); PG8_LDB(B1, 0, 1); PG8_SCHED; PG8_LDA(At, 0, 0); PG8_STAGE(PG8_SA(1, 1), a1 + hstep, voffA);
            PG8_WAIT_V(8); PG8_WAIT_L(0); PG8_BAR; PG8_MMA(0, 0, At, B0); PG8_MMA(0, 1, At, B1); PG8_BAR; PG8_SCHED;
            PG8_LDA(At, 0, 1); PG8_STAGE(PG8_SB(0, 0), b2, voffB); PG8_STAGE(PG8_SB(0, 1), b2 + hstep, voffB); PG8_STAGE(PG8_SA(0, 0), a2, voffA);
            PG8_WAIT_V(8); PG8_WAIT_L(0); PG8_BAR; PG8_MMA(1, 0, At, B0); PG8_MMA(1, 1, At, B1); PG8_BAR; PG8_SCHED;
            PG8_LDB(B0, 1, 0); PG8_LDB(B1, 1, 1); PG8_SCHED; PG8_LDA(At, 1, 0); PG8_STAGE(PG8_SA(0, 1), a2 + hstep, voffA);
            PG8_WAIT_V(8); PG8_WAIT_L(0); PG8_BAR; PG8_MMA(0, 0, At, B0); PG8_MMA(0, 1, At, B1); PG8_BAR; PG8_SCHED;
            PG8_LDA(At, 1, 1); PG8_STAGE(PG8_SB(1, 0), b3, voffB); PG8_STAGE(PG8_SB(1, 1), b3 + hstep, voffB); PG8_STAGE(PG8_SA(1, 0), a3, voffA);
            PG8_WAIT_V(8); PG8_WAIT_L(0); PG8_BAR; PG8_MMA(1, 0, At, B0); PG8_MMA(1, 1, At, B1); PG8_BAR; PG8_SCHED;
            } else {
            PG8_LDB(B0, 0, 0); PG8_SCHED; PG8_LDA(At, 0, 0); PG8_STAGE(PG8_SA(1, 1), a1 + hstep, voffA);
            PG8_WAIT_L(8); PG8_BAR; PG8_WAIT_L(0); PG8_MMA(0, 0, At, B0); PG8_BAR; PG8_SCHED;
            PG8_LDB(B1, 0, 1); PG8_STAGE(PG8_SB(0, 0), b2, voffB);
            PG8_BAR; PG8_WAIT_L(0); PG8_MMA(0, 1, At, B1); PG8_BAR;
            PG8_LDA(At, 0, 1); PG8_STAGE(PG8_SA(0, 0), a2, voffA);
            PG8_BAR; PG8_WAIT_L(0); PG8_MMA(1, 0, At, B0); PG8_BAR; PG8_SCHED;
            PG8_STAGE(PG8_SB(0, 1), b2 + hstep, voffB);
            PG8_WAIT_V(6); PG8_BAR; PG8_MMA(1, 1, At, B1); PG8_BAR;
            PG8_LDB(B0, 1, 0); PG8_SCHED; PG8_LDA(At, 1, 0); PG8_STAGE(PG8_SA(0, 1), a2 + hstep, voffA);
            PG8_WAIT_L(8); PG8_BAR; PG8_WAIT_L(0); PG8_MMA(0, 0, At, B0); PG8_BAR; PG8_SCHED;
            PG8_LDB(B1, 1, 1); PG8_STAGE(PG8_SB(1, 0), b3, voffB);
            PG8_BAR; PG8_WAIT_L(0); PG8_MMA(0, 1, At, B1); PG8_BAR;
            PG8_LDA(At, 1, 1); PG8_STAGE(PG8_SA(1, 0), a3, voffA);
            PG8_BAR; PG8_WAIT_L(0); PG8_MMA(1, 0, At, B0); PG8_BAR; PG8_SCHED;
            PG8_STAGE(PG8_SB(1, 1), b3 + hstep, voffB);
            PG8_WAIT_V(6); PG8_BAR; PG8_MMA(1, 1, At, B1); PG8_BAR;
            }
        }
        if constexpr (ALIGN_EPI) { if (wr == 0) PG8_BAR; }
        if constexpr (!Epi::AFTER_DRAIN) { E(acc, cur, wr, wc, fr, fq); S.done(cur); }
        if (!has_next) break;
#pragma unroll
        for (int a = 0; a < 2; ++a)
#pragma unroll
            for (int b = 0; b < 2; ++b)
#pragma unroll
                for (int m = 0; m < 4; ++m)
#pragma unroll
                    for (int n = 0; n < 2; ++n) acc[a][b][m][n] = (f32x4){0.f, 0.f, 0.f, 0.f};
        cur = nxt; cA = nA; cB = nB; ++ui;
        if constexpr (ALIGN_EPI) { if (wr == 1) PG8_BAR; }
    }
    PG8_WAIT_V(0);
    if constexpr (!ALIGN_EPI) { if (wr == 0) PG8_BAR; }
    PG8_BAR;
    if constexpr (Epi::AFTER_DRAIN) { E.fused(acc, cur, wr, wc, fr, fq, lds, wid, lane); S.done(cur); }
#undef PG8_SA
#undef PG8_SB
#undef PG8_STAGE
#undef PG8_LDA
#undef PG8_LDB
#undef PG8_MMA
#undef PG8_WAIT_V
#undef PG8_WAIT_L
#undef PG8_BAR
#undef PG8_SCHED
}
}
#define GAS __attribute__((address_space(1)))
#define LAS __attribute__((address_space(3)))
typedef unsigned short bf16;
typedef unsigned v4u __attribute__((ext_vector_type(4)));
typedef float f32x4 __attribute__((ext_vector_type(4)));
typedef short bf16x8 __attribute__((ext_vector_type(8)));
typedef GAS unsigned gu32;
typedef GAS unsigned long long gu64;
#define RLX_AGENT __ATOMIC_RELAXED, __HIP_MEMORY_SCOPE_AGENT
#define LDS_WAIT() asm volatile("s_waitcnt lgkmcnt(0)" ::: "memory")
#define VM_WAIT() asm volatile("s_waitcnt vmcnt(0)" ::: "memory")
__device__ __forceinline__ unsigned long long rt() { return __builtin_amdgcn_s_memrealtime(); }
__device__ __forceinline__ unsigned f2bf(float f) { unsigned u = __builtin_bit_cast(unsigned, f); return (u + 0x7fffu + ((u >> 16) & 1u)) >> 16; }
__device__ __forceinline__ unsigned pk2(float lo, float hi) { return f2bf(lo) | (f2bf(hi) << 16); }

#define XB_TMO      128
#define XB_XCNT(j)  (256  + 64 * (j))
#define XB_XSUB(j)  (1280 + 64 * (j))
#define XB_XGEN(j)  (2304 + 64 * (j))
#define XB_TOP      3328
#define XB_TOPGEN   3392
#define XCD_BAR_WORDS 3456
#define XB_SPIN_CAP (1u << 18)

__device__ __forceinline__ unsigned xb_ld(unsigned* p)              { return __hip_atomic_load(p, __ATOMIC_RELAXED, __HIP_MEMORY_SCOPE_AGENT); }
__device__ __forceinline__ unsigned xb_add(unsigned* p, unsigned v) { return __hip_atomic_fetch_add(p, v, __ATOMIC_RELAXED, __HIP_MEMORY_SCOPE_AGENT); }
__device__ __forceinline__ unsigned xb_xcc_id() { return (unsigned)__builtin_amdgcn_s_getreg((3 << 11) | 20) & 0xFu; }
#define XB_SPIN(cond, bar) do { unsigned _sp = 0; while (cond) { __builtin_amdgcn_s_sleep(1); \
    if ((++_sp & 255u) == 0u) { if (xb_ld(&(bar)[XB_TMO])) break; if (_sp > XB_SPIN_CAP) { atomicAdd(&(bar)[XB_TMO], 1u); break; } } } } while (0)

struct XcdBarrier {
    unsigned* bar; unsigned x;
    volatile LAS unsigned* st;
};

__device__ __forceinline__ XcdBarrier xcd_barrier_post(unsigned* bar, volatile LAS unsigned* st) {
    XcdBarrier b; b.bar = bar; b.x = xb_xcc_id(); b.st = st;
    if (threadIdx.x == 0) (void)xb_add(&bar[XB_XCNT(b.x)], 1u);
    return b;
}
__device__ __forceinline__ void xcd_barrier_complete(unsigned* bar, unsigned x, unsigned& nloc, unsigned& nx) {
    const unsigned G = gridDim.x * gridDim.y * gridDim.z;
    unsigned sum, cnt, mine, sp = 0u;
    for (;;) {
        sum = 0u; cnt = 0u; mine = 0u;
#pragma unroll
        for (unsigned j = 0; j < 16; ++j) { const unsigned c = xb_ld(&bar[XB_XCNT(j)]); sum += c; cnt += (c > 0u) ? 1u : 0u; mine = (j == x) ? c : mine; }
        if (sum == G) break;
        __builtin_amdgcn_s_sleep(1);
        if ((++sp & 255u) == 0u) { if (xb_ld(&bar[XB_TMO])) break; if (sp > XB_SPIN_CAP) { atomicAdd(&bar[XB_TMO], 1u); break; } }
    }
    nloc = mine > 0u ? mine : 1u; nx = cnt > 0u ? cnt : 1u;
}

__device__ __forceinline__ void xcd_barrier(const XcdBarrier& b) {
    asm volatile("s_waitcnt vmcnt(0)" ::: "memory");
    __syncthreads();
    if (threadIdx.x == 0) {
        unsigned* bar = b.bar;
        __builtin_amdgcn_s_waitcnt(0);
        unsigned nloc = b.st[0], nx = b.st[1];
        if (nloc == 0u) { xcd_barrier_complete(bar, b.x, nloc, nx); b.st[0] = nloc; b.st[1] = nx; }
        const unsigned old = xb_add(&bar[XB_XSUB(b.x)], 1u);
        const unsigned gen = old / nloc;
        if (old + 1u == (gen + 1u) * nloc) {
            __builtin_amdgcn_fence(__ATOMIC_RELEASE, "agent");
            asm volatile("s_waitcnt vmcnt(0)" ::: "memory");
            const unsigned og = xb_add(&bar[XB_TOP], 1u);
            const unsigned tg = og / nx;
            if (og + 1u == (tg + 1u) * nx) xb_add(&bar[XB_TOPGEN], 1u);
            else XB_SPIN(xb_ld(&bar[XB_TOPGEN]) == tg, bar);
            __builtin_amdgcn_fence(__ATOMIC_ACQUIRE, "agent");
            xb_add(&bar[XB_XGEN(b.x)], 1u);
            asm volatile("s_waitcnt vmcnt(0)" ::: "memory");
        } else {
            XB_SPIN(xb_ld(&bar[XB_XGEN(b.x)]) == gen, bar);
            __builtin_amdgcn_fence(__ATOMIC_ACQUIRE, "agent");
            asm volatile("s_waitcnt vmcnt(0)" ::: "memory");
        }
    }
    __syncthreads();
}

constexpr size_t MiB = 1u << 20;
constexpr size_t WS_CTL = 0, CTL_ZERO_BYTES = 64 * 1024;
constexpr size_t SZ_WGU = (size_t)5632 * 1024 * 2, SZ_WD = (size_t)1024 * 2816 * 2, SZ_WIN = (size_t)NPROJ * 1024 * 2, SZ_WOUT = (size_t)1024 * 1024 * 2;
constexpr size_t WS_WGU1 = 1 * MiB, WS_WD1 = WS_WGU1 + SZ_WGU, WS_WGU2 = WS_WD1 + SZ_WD, WS_WD2 = WS_WGU2 + SZ_WGU, WS_WIN = WS_WD2 + SZ_WD, WS_WOUT = WS_WIN + SZ_WIN;
constexpr size_t SZ_ACT = (size_t)M * 1024 * 2;
constexpr size_t WS_XN = WS_WOUT + SZ_WOUT, WS_MIX = WS_XN + SZ_ACT, WS_SS = WS_MIX + SZ_ACT;
constexpr size_t SZ_SS = (size_t)M * 16 * 4, SZ_SSW = (size_t)M * 8 * 4, SZ_ALR = (size_t)M * 16 * 4, SZ_G = (size_t)256 * 4 * 64 * 4;
constexpr size_t WS_SSW = WS_SS + SZ_SS, WS_ALR = WS_SSW + SZ_SSW, WS_G = WS_ALR + SZ_ALR, WS_R = WS_G + SZ_G;
constexpr size_t SZ_R = (size_t)M * 2816 * 2;
constexpr size_t R_QG = 0, R_KG = R_QG + (size_t)M * 256 * 2, R_VG = R_KG + (size_t)M * 256 * 2, R_RG = R_VG + (size_t)M * 512 * 2, R_QS = R_RG + (size_t)M * 512 * 2,
                 R_KVS = R_QS + (size_t)M * 512 * 2, R_CUM = R_KVS + (size_t)M * 256 * 2, R_END = R_CUM + (size_t)SEQ * 256 * 4;
static_assert(R_END <= SZ_R, "projection overlay fits inside H");
constexpr size_t WS_DS = WS_R + SZ_R, SZ_DS = (size_t)256 * 4 * 64 * 128 * 4, WS_END = WS_DS + SZ_DS;
static_assert(WS_END <= 256 * MiB, "d_ws map");
constexpr size_t O_Y = 0, O_SP = (size_t)M * 1024, O_CKP = O_SP + 32768, O_CVP = O_CKP + 16384, O_SS = O_CVP + 16384, O_CKS = O_SS + (size_t)DECB * 32768, O_CVS = O_CKS + (size_t)DECB * 16384,
                 O_END = O_CVS + (size_t)DECB * 16384;
constexpr int RING_BYTES = 131072, MISC_OFF = RING_BYTES + 320, LDS_BYTES = 147456;
constexpr int NWAVES = 8, NTHR = 512;

struct Args {
    const float* in[22]; float* out; unsigned char* ws; int ph_lo, ph_hi, bar_region, pad;
};
struct Ptrs {
    const float *x_p, *x_s, *state0, *ck_in, *cv_in, *g_ffn1, *wg1, *wu1, *wd1, *g_mix, *w_in, *w_gate_up, *b_gate, *g_head, *g_swa, *sinks, *w_out, *g_ffn2, *wg2, *wu2, *wd2, *g_final;
    float* out;
    bf16 *wgu1, *wd1t, *wgu2, *wd2t, *wint, *woutt, *xn, *mix, *hbuf, *qg, *kg, *vg, *rg, *qs, *kvs;
    float *ss, *ssw, *alr, *g, *cum, *ds;
};

__device__ __forceinline__ float bflo(unsigned w) { return __uint_as_float(w << 16); }
__device__ __forceinline__ float bfhi(unsigned w) { return __uint_as_float(w & 0xffff0000u); }
__device__ __forceinline__ float bf1(bf16 b) { return __uint_as_float((unsigned)b << 16); }
__device__ __forceinline__ float wave_sum(float v) {
#pragma unroll
    for (int o = 1; o < 64; o <<= 1) v += __shfl_xor(v, o);
    return v;
}
__device__ __forceinline__ float logsig(float x) { return fminf(x, 0.f) - log1pf(__expf(-fabsf(x))); }
__device__ __forceinline__ bf16x8 frag(const LAS bf16* base, int row0, int ld, int k0, int fr, int fq) { return *(const LAS bf16x8*)(base + (row0 + fr) * ld + k0 + 8 * fq); }
#define MFMA16(a, b, c) __builtin_amdgcn_mfma_f32_16x16x32_bf16((a), (b), (c), 0, 0, 0)

__device__ __forceinline__ int dest_row(int kind, int n) {
    if (kind == 0) return n;
    if (kind == 1) return 256 * (n >> 7) + (n & 127);
    if (kind == 2) return 256 * (n >> 7) + 128 + (n & 127);
    return n < 1536 ? n : (n < 1552 ? 2304 + (n - 1536) : n - 16);
}
__device__ __forceinline__ void p0_transpose_item(const float* W, int K, int N, bf16* WT, int kind, LAS float* scr, int item, int lane) {
    const int nblk = (N + 31) / 32, kb = item / nblk, nb = item % nblk, k0 = 64 * kb, n0 = 32 * nb;
    const int kr = lane >> 3, n4 = (lane & 7) * 4; const bool ok = n0 + n4 < N;
    f32x4 v[8];
#pragma unroll
    for (int i = 0; i < 8; ++i) v[i] = ok ? *(const GAS f32x4*)(W + (size_t)(k0 + 8 * i + kr) * N + n0 + n4) : (f32x4){0.f, 0.f, 0.f, 0.f};
#pragma unroll
    for (int i = 0; i < 8; ++i) { LAS float* d = scr + (8 * i + kr) * 33 + n4; d[0] = v[i].x; d[1] = v[i].y; d[2] = v[i].z; d[3] = v[i].w; }
    LDS_WAIT(); asm volatile("" ::: "memory");
    const int c = lane & 7;
#pragma unroll
    for (int j = 0; j < 4; ++j) { const int n = (lane >> 3) + 8 * j; const LAS float* s = scr + (8 * c) * 33 + n;
        v4u o; o.x = pk2(s[0 * 33], s[1 * 33]); o.y = pk2(s[2 * 33], s[3 * 33]); o.z = pk2(s[4 * 33], s[5 * 33]); o.w = pk2(s[6 * 33], s[7 * 33]);
        if (n0 + n < N) *(GAS v4u*)(WT + (size_t)dest_row(kind, n0 + n) * K + k0 + 8 * c) = o; }
    LDS_WAIT(); asm volatile("" ::: "memory");
}
__device__ __forceinline__ void p0_prologue(const Ptrs& P, LAS unsigned char* lds, int tid, int wave, int lane, int vcu, int G) {
    LAS float* scr = (LAS float*)(lds + wave * 16384);
    const int gw = vcu * NWAVES + wave, NGW = G * NWAVES;
    constexpr int I_GU = (1024 / 64) * (2816 / 32), I_D = (2816 / 64) * (1024 / 32), I_IN = (1024 / 64) * ((DIN + 31) / 32), I_O = (1024 / 64) * (1024 / 32);
    constexpr int NITEMS = 4 * I_GU + 2 * I_D + I_IN + I_O;
    for (int it = gw; it < NITEMS; it += NGW) {
        int r = it;
        if (r < I_GU) { p0_transpose_item(P.wg1, 1024, 2816, P.wgu1, 1, scr, r, lane); continue; } r -= I_GU;
        if (r < I_GU) { p0_transpose_item(P.wu1, 1024, 2816, P.wgu1, 2, scr, r, lane); continue; } r -= I_GU;
        if (r < I_D)  { p0_transpose_item(P.wd1, 2816, 1024, P.wd1t, 0, scr, r, lane); continue; } r -= I_D;
        if (r < I_GU) { p0_transpose_item(P.wg2, 1024, 2816, P.wgu2, 1, scr, r, lane); continue; } r -= I_GU;
        if (r < I_GU) { p0_transpose_item(P.wu2, 1024, 2816, P.wgu2, 2, scr, r, lane); continue; } r -= I_GU;
        if (r < I_D)  { p0_transpose_item(P.wd2, 2816, 1024, P.wd2t, 0, scr, r, lane); continue; } r -= I_D;
        if (r < I_IN) { p0_transpose_item(P.w_in, 1024, DIN, P.wint, 3, scr, r, lane); continue; } r -= I_IN;
        p0_transpose_item(P.w_out, 1024, 1024, P.woutt, 0, scr, r, lane);
    }
    for (int m0 = gw; m0 < M; m0 += 2 * NGW) {
        const int m1 = m0 + NGW; const bool has1 = m1 < M; const int m1c = has1 ? m1 : m0;
        const float* xrow0 = (m0 < SEQ) ? P.x_p + (size_t)m0 * D : P.x_s + (size_t)(m0 - SEQ) * D;
        const float* xrow1 = (m1c < SEQ) ? P.x_p + (size_t)m1c * D : P.x_s + (size_t)(m1c - SEQ) * D;
        const GAS f32x4* xr0 = (const GAS f32x4*)xrow0 + lane; const GAS f32x4* xr1 = (const GAS f32x4*)xrow1 + lane;
        f32x4 v[4], w[4]; float s0 = 0.f, s1 = 0.f;
#pragma unroll
        for (int j = 0; j < 4; ++j) { v[j] = xr0[64 * j]; w[j] = xr1[64 * j]; }
#pragma unroll
        for (int j = 0; j < 4; ++j) { s0 += (v[j].x * v[j].x + v[j].y * v[j].y) + (v[j].z * v[j].z + v[j].w * v[j].w); s1 += (w[j].x * w[j].x + w[j].y * w[j].y) + (w[j].z * w[j].z + w[j].w * w[j].w); }
        const float rs0 = rsqrtf(wave_sum(s0) * (1.f / D) + EPS), rs1 = rsqrtf(wave_sum(s1) * (1.f / D) + EPS);
        GAS unsigned long long* o0 = (GAS unsigned long long*)(P.xn + (size_t)m0 * D) + lane;
        GAS unsigned long long* o1 = (GAS unsigned long long*)(P.xn + (size_t)m1c * D) + lane;
#pragma unroll
        for (int j = 0; j < 4; ++j) { const f32x4 gg = *((const GAS f32x4*)P.g_ffn1 + lane + 64 * j);
            o0[64 * j] = (unsigned long long)pk2(v[j].x * rs0 * gg.x, v[j].y * rs0 * gg.y) | ((unsigned long long)pk2(v[j].z * rs0 * gg.z, v[j].w * rs0 * gg.w) << 32);
            if (has1) o1[64 * j] = (unsigned long long)pk2(w[j].x * rs1 * gg.x, w[j].y * rs1 * gg.y) | ((unsigned long long)pk2(w[j].z * rs1 * gg.z, w[j].w * rs1 * gg.w) << 32); }
    }
    {
        const int gt = vcu * NTHR + tid, NGT = G * NTHR;
        constexpr int PER_B = 124 * 128 / 4;
#pragma unroll 4
        for (int i = gt; i < 2 * DECB * PER_B; i += NGT) {
            const int which = i / (DECB * PER_B), r = i % (DECB * PER_B), b = r / PER_B, o = r % PER_B;
            const float* src = (which ? P.cv_in : P.ck_in) + (size_t)b * 16384 + 512 + 4 * o;
            float* dst = P.out + (which ? O_CVS : O_CKS) + (size_t)b * 16384 + 4 * o;
            *(f32x4*)dst = *(const f32x4*)src;
        }
    }
}

#define BAR_LDS() do { asm volatile("s_waitcnt lgkmcnt(0)" ::: "memory"); __builtin_amdgcn_s_barrier(); asm volatile("" ::: "memory"); } while (0)

struct GlRegs { f32x4 a; v4u kk; v4u vv[2]; float w[16]; float bg; };
__device__ __forceinline__ void gla_local_load(const Ptrs& P, int c, int h, int tid, GlRegs& R) {
    const int t0 = c * 64;
    { const int t = (tid & 255) >> 2, q = (tid & 3) * 4; R.a = *(const f32x4*)(P.alr + (size_t)(t0 + t) * 16 + q); }
    { const int j = tid >> 3, dc = tid & 7; R.kk = *(const v4u*)(P.kg + (size_t)(t0 + j) * 256 + 64 * h + 8 * dc); }
#pragma unroll
    for (int i = 0; i < 2; ++i) { const int q = tid + 512 * i, jj = q >> 4, cc = q & 15; R.vv[i] = *(const v4u*)(P.vg + (size_t)(t0 + jj) * 512 + 128 * h + 8 * cc); }
    const int d = tid & 63;
#pragma unroll
    for (int r = 0; r < 16; ++r) R.w[r] = P.w_gate_up[r * 256 + 64 * h + d];
    R.bg = P.b_gate[64 * h + d];
}
__device__ __forceinline__ void gla_local_unit(const Ptrs& P, LAS unsigned char* lds, int c, int h, int tid, int wave, int lane, const GlRegs& R) {
    LAS float* alrS = (LAS float*)(lds);
    LAS bf16* kS = (LAS bf16*)(lds + 4096);
    LAS float* segS = (LAS float*)(lds + 13312);
    LAS bf16* khT = (LAS bf16*)(lds + 15360);
    LAS bf16* vT = (LAS bf16*)(lds + 24576);
    const int t0 = c * 64, fr = lane & 15, fq = lane >> 4;
    if (tid < 256) { const int t = tid >> 2, q = (tid & 3) * 4; *(LAS f32x4*)(alrS + t * 16 + q) = R.a; }
    { const int j = tid >> 3, dc = tid & 7; *(LAS v4u*)(kS + j * 72 + 8 * dc) = R.kk; }
#pragma unroll
    for (int i = 0; i < 2; ++i) { const int q = tid + 512 * i, jj = q >> 4, cc = q & 15;
#pragma unroll
        for (int e = 0; e < 8; ++e) { const unsigned w = R.vv[i][e >> 1]; vT[(8 * cc + e) * 72 + jj] = (bf16)((e & 1) ? (w >> 16) : (w & 0xffffu)); } }
    BAR_LDS();
    const int d = tid & 63, seg = wave;
    float cum[8]; float run = 0.f;
#pragma unroll
    for (int i = 0; i < 8; ++i) { const LAS f32x4* ap = (const LAS f32x4*)(alrS + (8 * seg + i) * 16); float x = R.bg;
#pragma unroll
        for (int r4 = 0; r4 < 4; ++r4) { const f32x4 a = ap[r4]; x += (a[0] * R.w[4 * r4] + a[1] * R.w[4 * r4 + 1]) + (a[2] * R.w[4 * r4 + 2] + a[3] * R.w[4 * r4 + 3]); }
        run += logsig(x) * (1.0f / 16.0f); cum[i] = run; }
    segS[seg * 64 + d] = run;
    BAR_LDS();
    { float off = 0.f, last = 0.f;
#pragma unroll
      for (int s2 = 0; s2 < 8; ++s2) { const float v = segS[s2 * 64 + d]; last += v; off += (s2 < seg) ? v : 0.f; }
      unsigned pk[4];
#pragma unroll
      for (int i = 0; i < 8; i += 2) { const float ca = cum[i] + off, cb = cum[i + 1] + off;
          P.cum[(size_t)(t0 + 8 * seg + i) * 256 + 64 * h + d] = ca; P.cum[(size_t)(t0 + 8 * seg + i + 1) * 256 + 64 * h + d] = cb;
          pk[i >> 1] = pk2(bf1(kS[(8 * seg + i) * 72 + d]) * __expf(last - ca), bf1(kS[(8 * seg + i + 1) * 72 + d]) * __expf(last - cb)); }
      *(LAS v4u*)(khT + d * 72 + 8 * seg) = (v4u){pk[0], pk[1], pk[2], pk[3]};
      if (seg == 0) P.g[(size_t)(c * 4 + h) * 64 + d] = __expf(last); }
    BAR_LDS();
    { const int d0 = (wave & 3) * 16;
#pragma unroll
      for (int q = 0; q < 4; ++q) { const int dv0 = ((wave >> 2) * 4 + q) * 16; f32x4 acc = (f32x4){0.f, 0.f, 0.f, 0.f};
#pragma unroll
          for (int kk = 0; kk < 2; ++kk) acc = MFMA16(frag(vT, dv0, 72, 32 * kk, fr, fq), frag(khT, d0, 72, 32 * kk, fr, fq), acc);
          *(f32x4*)(P.ds + ((size_t)(c * 4 + h) * 64 + d0 + fr) * 128 + dv0 + 4 * fq) = acc; } }
}
__device__ __forceinline__ void gla_local_loop(const Ptrs& P, LAS unsigned char* lds, int first, int stride, int tid, int wave, int lane) {
    int u = first; if (u >= 1024) return;
    GlRegs R; gla_local_load(P, u >> 2, u & 3, tid, R);
    for (;;) {
        GlRegs C = R; const int un = u + stride; const bool more = un < 1024;
        if (more) gla_local_load(P, un >> 2, un & 3, tid, R);
        gla_local_unit(P, lds, u >> 2, u & 3, tid, wave, lane, C);
        BAR_LDS();
        if (!more) break; u = un;
    }
}

__device__ __forceinline__ void gla_sample_unit(const Ptrs& P, LAS unsigned char* lds, int b, int tid, int wave, int lane) {
    LAS float* cumS = (LAS float*)(lds);
    LAS float* qd = (LAS float*)(lds + 4096);
    LAS float* kd = (LAS float*)(lds + 8192);
    LAS float* ke = (LAS float*)(lds + 12288);
    LAS float* vS = (LAS float*)(lds + 16384);
    LAS float* attS = (LAS float*)(lds + 24576);
    LAS float* red = (LAS float*)(lds + 24832);
    LAS float* e3S = (LAS float*)(lds + 25088);
    LAS float* part = (LAS float*)(lds + 26112);
    const int r0 = SEQ + 4 * b;
#pragma unroll
    for (int i = 0; i < 2; ++i) { const int item = tid + 512 * i, t = item >> 8, col = item & 255; float x = P.b_gate[col];
#pragma unroll
        for (int r = 0; r < 16; ++r) x += P.alr[(size_t)(r0 + t) * 16 + r] * P.w_gate_up[r * 256 + col];
        cumS[t * 256 + col] = logsig(x) * (1.0f / 16.0f); }
    { const int t = tid >> 7, c4 = (tid & 127) * 4; const unsigned long long w = *(const unsigned long long*)(P.vg + (size_t)(r0 + t) * 512 + c4);
      vS[t * 512 + c4] = bflo((unsigned)w); vS[t * 512 + c4 + 1] = bfhi((unsigned)w); vS[t * 512 + c4 + 2] = bflo((unsigned)(w >> 32)); vS[t * 512 + c4 + 3] = bfhi((unsigned)(w >> 32)); }
    __syncthreads();
    if (tid < 256) { const int d = tid; const float c0 = cumS[d], c1 = c0 + cumS[256 + d], c2 = c1 + cumS[512 + d], c3 = c2 + cumS[768 + d];
        cumS[256 + d] = c1; cumS[512 + d] = c2; cumS[768 + d] = c3; e3S[d] = __expf(c3); }
    __syncthreads();
#pragma unroll
    for (int i = 0; i < 2; ++i) { const int item = tid + 512 * i, t = item >> 8, col = item & 255; const float cu = cumS[t * 256 + col], c3 = cumS[768 + col];
        const float q = bf1(P.qg[(size_t)(r0 + t) * 256 + col]), k = bf1(P.kg[(size_t)(r0 + t) * 256 + col]);
        qd[t * 256 + col] = q * __expf(cu); kd[t * 256 + col] = k * __expf(c3 - cu); ke[t * 256 + col] = k * __expf(-cu); }
    __syncthreads();
    { const int pr = tid >> 3, l8 = tid & 7, h = pr >> 4, i = (pr >> 2) & 3, j = pr & 3; float s = 0.f;
#pragma unroll
      for (int m = 0; m < 8; ++m) { const int col = 64 * h + l8 + 8 * m; s += qd[i * 256 + col] * ke[j * 256 + col]; }
      s += __shfl_xor(s, 1); s += __shfl_xor(s, 2); s += __shfl_xor(s, 4);
      if (l8 == 0) attS[pr] = (j <= i) ? s : 0.f; }
    __syncthreads();
    { const int dv = tid & 127, dg = tid >> 7;
      float s0r[4][16];
#pragma unroll
      for (int h = 0; h < 4; ++h)
#pragma unroll
          for (int dd = 0; dd < 16; ++dd) s0r[h][dd] = P.state0[((size_t)(b * 4 + h) * 64 + 16 * dg + dd) * 128 + dv];
#pragma unroll
      for (int h = 0; h < 4; ++h) { float po[4] = {0.f, 0.f, 0.f, 0.f};
          const float v0 = vS[128 * h + dv], v1 = vS[512 + 128 * h + dv], v2 = vS[1024 + 128 * h + dv], v3 = vS[1536 + 128 * h + dv];
#pragma unroll
          for (int dd = 0; dd < 16; ++dd) { const int col = 64 * h + 16 * dg + dd; const float s0 = s0r[h][dd];
              const float sn = s0 * e3S[col] + ((kd[col] * v0 + kd[256 + col] * v1) + (kd[512 + col] * v2 + kd[768 + col] * v3));
              P.out[O_SS + ((size_t)(b * 4 + h) * 64 + 16 * dg + dd) * 128 + dv] = sn;
              po[0] += qd[col] * s0; po[1] += qd[256 + col] * s0; po[2] += qd[512 + col] * s0; po[3] += qd[768 + col] * s0; }
#pragma unroll
          for (int t = 0; t < 4; ++t) part[(dg * 4 + t) * 512 + 128 * h + dv] = po[t]; } }
    __syncthreads();
    { const int i = tid >> 7, dv = tid & 127; float o[4];
#pragma unroll
      for (int h = 0; h < 4; ++h) { const int c = 128 * h + dv;
          float a = (part[(0 * 4 + i) * 512 + c] + part[(1 * 4 + i) * 512 + c]) + (part[(2 * 4 + i) * 512 + c] + part[(3 * 4 + i) * 512 + c]);
#pragma unroll
          for (int j = 0; j < 4; ++j) a += attS[h * 16 + i * 4 + j] * vS[j * 512 + c];
          o[h] = a; const float sq = wave_sum(a * a); if (lane == 0) red[wave * 4 + h] = sq; }
      __syncthreads();
#pragma unroll
      for (int h = 0; h < 4; ++h) { const int c = 128 * h + dv; const float tot = red[(2 * i) * 4 + h] + red[(2 * i + 1) * 4 + h];
          const float rs = rsqrtf(tot * (1.0f / 128.0f) + EPS);
          P.mix[(size_t)(r0 + i) * 1024 + c] = (bf16)f2bf(o[h] * rs * P.g_head[c] * bf1(P.rg[(size_t)(r0 + i) * 512 + c])); } }
    __syncthreads();
}

__device__ __forceinline__ void swa_sample_unit(const Ptrs& P, LAS unsigned char* lds, int b, int tid, int wave, int lane) {
    LAS float* qS = (LAS float*)(lds);
    LAS float* pS = (LAS float*)(lds + 8192);
    LAS float* oP = (LAS float*)(lds + 8192 + 17408);
    LAS float* oS = (LAS float*)(lds + 8192 + 17408 + 32768);
    const int r0 = SEQ + 4 * b;
    { const int t = tid >> 7, c4 = (tid & 127) * 4;
      const unsigned long long w = *(const unsigned long long*)(P.qs + (size_t)(r0 + t) * 512 + c4);
      qS[t * 512 + c4] = bflo((unsigned)w); qS[t * 512 + c4 + 1] = bfhi((unsigned)w); qS[t * 512 + c4 + 2] = bflo((unsigned)(w >> 32)); qS[t * 512 + c4 + 3] = bfhi((unsigned)(w >> 32)); }
    __syncthreads();
    if (tid < 264) {
        const int j = tid >> 1, kvh = tid & 1;
        const float* kp = (j < 128) ? P.ck_in + ((size_t)b * 128 + j) * 128 + 64 * kvh : P.out + O_CKS + ((size_t)b * 128 + 124 + (j - 128)) * 128 + 64 * kvh;
        float s[16];
#pragma unroll
        for (int i = 0; i < 16; ++i) s[i] = 0.f;
        f32x4 kreg[16];
#pragma unroll
        for (int d4 = 0; d4 < 16; ++d4) kreg[d4] = *(const f32x4*)(kp + 4 * d4);
#pragma unroll
        for (int d4 = 0; d4 < 16; ++d4) { const f32x4 kv = kreg[d4];
#pragma unroll
            for (int hl = 0; hl < 4; ++hl)
#pragma unroll
                for (int t = 0; t < 4; ++t) { const LAS float* qq = qS + t * 512 + 64 * (4 * kvh + hl) + 4 * d4;
                    s[hl * 4 + t] += (qq[0] * kv.x + qq[1] * kv.y) + (qq[2] * kv.z + qq[3] * kv.w); } }
#pragma unroll
        for (int hl = 0; hl < 4; ++hl)
#pragma unroll
            for (int t = 0; t < 4; ++t) { const bool valid = (j <= 128 + t) && (j >= t + 1); pS[((4 * kvh + hl) * 4 + t) * 136 + j] = valid ? s[hl * 4 + t] : -INFINITY; }
    }
    __syncthreads();
    {
#pragma unroll
        for (int rr = 0; rr < 4; ++rr) { const int row = 4 * wave + rr, hh = row >> 2; const float sink = P.sinks[hh];
            float v0 = pS[row * 136 + lane], v1 = pS[row * 136 + 64 + lane], v2 = (lane < 4) ? pS[row * 136 + 128 + lane] : -INFINITY;
            float m = fmaxf(fmaxf(v0, v1), v2);
#pragma unroll
            for (int o = 1; o < 64; o <<= 1) m = fmaxf(m, __shfl_xor(m, o));
            m = fmaxf(m, sink);
            const float e0 = __expf(v0 - m), e1 = __expf(v1 - m), e2 = (lane < 4) ? __expf(v2 - m) : 0.f;
            const float den = wave_sum(e0 + e1 + e2) + __expf(sink - m), inv = 1.0f / den;
            pS[row * 136 + lane] = e0 * inv; pS[row * 136 + 64 + lane] = e1 * inv; if (lane < 4) pS[row * 136 + 128 + lane] = e2 * inv; }
    }
    __syncthreads();
    {
        const int part = tid >> 7, kvh = (tid >> 6) & 1, d = tid & 63; float o[16];
#pragma unroll
        for (int i = 0; i < 16; ++i) o[i] = 0.f;
        float vreg[33];
#pragma unroll
        for (int jj = 0; jj < 33; ++jj) { const int j = part * 33 + jj;
            const float* vp = (j < 128) ? P.cv_in + ((size_t)b * 128 + j) * 128 + 64 * kvh + d : P.out + O_CVS + ((size_t)b * 128 + 124 + (j - 128)) * 128 + 64 * kvh + d;
            vreg[jj] = *vp; }
#pragma unroll
        for (int jj = 0; jj < 33; ++jj) { const int j = part * 33 + jj;
            const float vv = vreg[jj];
#pragma unroll
            for (int hl = 0; hl < 4; ++hl)
#pragma unroll
                for (int t = 0; t < 4; ++t) o[hl * 4 + t] += pS[((4 * kvh + hl) * 4 + t) * 136 + j] * vv; }
#pragma unroll
        for (int hl = 0; hl < 4; ++hl)
#pragma unroll
            for (int t = 0; t < 4; ++t) oP[(part * 4 + t) * 512 + 64 * (4 * kvh + hl) + d] = o[hl * 4 + t];
    }
    __syncthreads();
    { const int t = tid >> 7, c4 = (tid & 127) * 4;
#pragma unroll
      for (int e = 0; e < 4; ++e) oS[t * 512 + c4 + e] = (oP[(0 * 4 + t) * 512 + c4 + e] + oP[(1 * 4 + t) * 512 + c4 + e]) + (oP[(2 * 4 + t) * 512 + c4 + e] + oP[(3 * 4 + t) * 512 + c4 + e]); }
    __syncthreads();
    if (wave < 4) { const int t = wave; float v[8]; float sq = 0.f;
#pragma unroll
        for (int e = 0; e < 8; ++e) { v[e] = oS[t * 512 + lane + 64 * e]; sq += v[e] * v[e]; }
        const float rs = rsqrtf(wave_sum(sq) * (1.0f / 512.0f) + EPS);
#pragma unroll
        for (int e = 0; e < 8; ++e) P.mix[(size_t)(r0 + t) * 1024 + 512 + lane + 64 * e] = (bf16)f2bf(v[e] * rs * P.g_swa[lane + 64 * e]); }
    __syncthreads();
}

__device__ __forceinline__ void gla_scan2(const Ptrs& P, LAS unsigned char* lds, int blk, int tid) {
    LAS float* As = (LAS float*)lds;
    LAS float* Ps = (LAS float*)(lds + 2048);
    const int seg = tid >> 6, el = tid & 63, e = blk * 64 + el, h = e >> 13, d = (e >> 7) & 63;
    float* dsp = P.ds + e + (size_t)(seg * 32) * 32768;
    const float* gp = P.g + h * 64 + d + (size_t)(seg * 32) * 256;
    float dsv[32], gv[32];
#pragma unroll
    for (int i = 0; i < 32; ++i) { dsv[i] = dsp[(size_t)i * 32768]; gv[i] = gp[(size_t)i * 256]; }
    float A = 0.f, Pm = 1.f;
#pragma unroll
    for (int i = 0; i < 32; ++i) { A = A * gv[i] + dsv[i]; Pm *= gv[i]; }
    As[seg * 64 + el] = A; Ps[seg * 64 + el] = Pm;
    __syncthreads();
    float S = 0.f;
    for (int s2 = 0; s2 < seg; ++s2) S = S * Ps[s2 * 64 + el] + As[s2 * 64 + el];
#pragma unroll
    for (int i = 0; i < 32; ++i) { dsp[(size_t)i * 32768] = S; S = S * gv[i] + dsv[i]; }
    if (seg == 7) P.out[O_SP + e] = S;
    __syncthreads();
}

struct SwRegs { v4u kk[3], vv[3], qq[2]; };
__device__ __forceinline__ void swa_prompt_load(const Ptrs& P, int qb, int g, int tid, SwRegs& R) {
    const int q0 = qb * 32, kbase = q0 - 128;
#pragma unroll
    for (int i = 0; i < 3; ++i) { const int q = tid + 512 * i, j = q >> 3, ch = q & 7, tok = kbase + j;
        R.kk[i] = (v4u){0u, 0u, 0u, 0u}; R.vv[i] = (v4u){0u, 0u, 0u, 0u};
        if (q < 1280 && tok >= 0) { const bf16* p = P.kvs + (size_t)tok * 256 + 64 * g + 8 * ch; R.kk[i] = *(const v4u*)p; R.vv[i] = *(const v4u*)(p + 128); } }
#pragma unroll
    for (int i = 0; i < 2; ++i) { const int q = tid + 512 * i, r = q >> 3, ch = q & 7, hl = r >> 5, ql = r & 31;
        R.qq[i] = *(const v4u*)(P.qs + (size_t)(q0 + ql) * 512 + 64 * (4 * g + hl) + 8 * ch); }
}
__device__ __forceinline__ void swa_prompt_unit(const Ptrs& P, LAS unsigned char* lds, int qb, int g, int tid, int wave, int lane, const SwRegs& R) {
    LAS bf16* Ks = (LAS bf16*)(lds);
    LAS bf16* VsT = (LAS bf16*)(lds + 23040);
    LAS bf16* Qs = (LAS bf16*)(lds + 44544);
    LAS bf16* Ps = (LAS bf16*)(lds + 62976);
    const int q0 = qb * 32, kbase = q0 - 128, fr = lane & 15, fq = lane >> 4;
#pragma unroll
    for (int i = 0; i < 3; ++i) { const int q = tid + 512 * i, j = q >> 3, ch = q & 7;
        if (q < 1280) { *(LAS v4u*)(Ks + j * 72 + 8 * ch) = R.kk[i];
#pragma unroll
            for (int e = 0; e < 8; ++e) { const unsigned w = R.vv[i][e >> 1]; VsT[(8 * ch + e) * 168 + j] = (bf16)((e & 1) ? (w >> 16) : (w & 0xffffu)); } } }
#pragma unroll
    for (int i = 0; i < 2; ++i) { const int q = tid + 512 * i, r = q >> 3, ch = q & 7; *(LAS v4u*)(Qs + r * 72 + 8 * ch) = R.qq[i]; }
    BAR_LDS();
    const int r0 = 16 * wave, head = 4 * g + (wave >> 1), ql0 = 16 * (wave & 1);
    const int qpos = q0 + ql0 + fr; const float sink = P.sinks[head];
    f32x4 s[10];
#pragma unroll
    for (int t = 0; t < 10; ++t) s[t] = (f32x4){0.f, 0.f, 0.f, 0.f};
#pragma unroll
    for (int kk = 0; kk < 2; ++kk) { const bf16x8 bq = frag(Qs, r0, 72, 32 * kk, fr, fq);
#pragma unroll
        for (int t = 0; t < 10; ++t) s[t] = MFMA16(frag(Ks, 16 * t, 72, 32 * kk, fr, fq), bq, s[t]); }
    float m = -INFINITY;
#pragma unroll
    for (int t = 0; t < 10; ++t)
#pragma unroll
        for (int r = 0; r < 4; ++r) { const int kpos = kbase + 16 * t + 4 * fq + r; const bool valid = (kpos >= 0) && (kpos <= qpos) && (qpos - kpos < 128);
            s[t][r] = valid ? s[t][r] : -INFINITY; m = fmaxf(m, s[t][r]); }
    m = fmaxf(m, __shfl_xor(m, 16)); m = fmaxf(m, __shfl_xor(m, 32)); m = fmaxf(m, sink);
    float sum = 0.f;
#pragma unroll
    for (int t = 0; t < 10; ++t)
#pragma unroll
        for (int r = 0; r < 4; ++r) { const float p = __expf(s[t][r] - m); s[t][r] = p; sum += p; }
    sum += __shfl_xor(sum, 16); sum += __shfl_xor(sum, 32);
    const float inv = 1.0f / (sum + __expf(sink - m));
#pragma unroll
    for (int t = 0; t < 10; ++t) { unsigned long long w = (unsigned long long)pk2(s[t][0] * inv, s[t][1] * inv) | ((unsigned long long)pk2(s[t][2] * inv, s[t][3] * inv) << 32);
        *(LAS unsigned long long*)(Ps + (r0 + fr) * 168 + 16 * t + 4 * fq) = w; }
    asm volatile("s_waitcnt lgkmcnt(0)" ::: "memory");
    f32x4 o[4];
#pragma unroll
    for (int dt = 0; dt < 4; ++dt) o[dt] = (f32x4){0.f, 0.f, 0.f, 0.f};
#pragma unroll
    for (int ks = 0; ks < 5; ++ks) { const bf16x8 bp = frag(Ps, r0, 168, 32 * ks, fr, fq);
#pragma unroll
        for (int dt = 0; dt < 4; ++dt) o[dt] = MFMA16(frag(VsT, 16 * dt, 168, 32 * ks, fr, fq), bp, o[dt]); }
    float sq = 0.f;
#pragma unroll
    for (int dt = 0; dt < 4; ++dt) sq += (o[dt][0] * o[dt][0] + o[dt][1] * o[dt][1]) + (o[dt][2] * o[dt][2] + o[dt][3] * o[dt][3]);
    sq += __shfl_xor(sq, 16); sq += __shfl_xor(sq, 32);
    if (fq == 0) P.ssw[(size_t)qpos * 8 + head] = sq;
#pragma unroll
    for (int dt = 0; dt < 4; ++dt) { const unsigned long long w = (unsigned long long)pk2(o[dt][0], o[dt][1]) | ((unsigned long long)pk2(o[dt][2], o[dt][3]) << 32);
        *(unsigned long long*)(P.mix + (size_t)qpos * 1024 + 512 + 64 * head + 16 * dt + 4 * fq) = w; }
}
__device__ __forceinline__ void swa_prompt_loop(const Ptrs& P, LAS unsigned char* lds, int first, int stride, int tid, int wave, int lane) {
    int u = first; if (u >= 1024) return;
    SwRegs R; swa_prompt_load(P, u >> 1, u & 1, tid, R);
    for (;;) {
        SwRegs C = R; const int un = u + stride; const bool more = un < 1024;
        if (more) swa_prompt_load(P, un >> 1, un & 1, tid, R);
        swa_prompt_unit(P, lds, u >> 1, u & 1, tid, wave, lane, C);
        BAR_LDS();
        if (!more) break; u = un;
    }
}

struct GoRegs { v4u qq, kk; f32x4 c0, c1; v4u vv[2]; f32x4 sv[4]; };
struct GoEpi { v4u r0, r1, a0, a1; f32x4 sa, sb; };
__device__ __forceinline__ void gla_out_load(const Ptrs& P, int c, int h, int tid, GoRegs& R) {
    const int t0 = c * 64, j = tid >> 3, dc = tid & 7;
    R.qq = *(const v4u*)(P.qg + (size_t)(t0 + j) * 256 + 64 * h + 8 * dc); R.kk = *(const v4u*)(P.kg + (size_t)(t0 + j) * 256 + 64 * h + 8 * dc);
    const float* cp = P.cum + (size_t)(t0 + j) * 256 + 64 * h + 8 * dc; R.c0 = *(const f32x4*)cp; R.c1 = *(const f32x4*)(cp + 4);
#pragma unroll
    for (int i = 0; i < 2; ++i) { const int q = tid + 512 * i, jj = q >> 4, cc = q & 15; R.vv[i] = *(const v4u*)(P.vg + (size_t)(t0 + jj) * 512 + 128 * h + 8 * cc); }
#pragma unroll
    for (int i = 0; i < 4; ++i) { const int q = tid + 512 * i, d = q >> 5, dv4 = (q & 31) * 4; R.sv[i] = *(const f32x4*)(P.ds + ((size_t)(c * 4 + h) * 64 + d) * 128 + dv4); }
}
__device__ __forceinline__ void gla_out_load_epi(const Ptrs& P, int c, int h, int tid, GoEpi& E) {
    const int i = tid >> 3, seg = tid & 7, tok = c * 64 + i, col = 128 * h + 16 * seg;
    E.r0 = *(const v4u*)(P.rg + (size_t)tok * 512 + col); E.r1 = *(const v4u*)(P.rg + (size_t)tok * 512 + col + 8);
    const bf16* mp = P.mix + (size_t)tok * 1024 + 512 + col; E.a0 = *(const v4u*)mp; E.a1 = *(const v4u*)(mp + 8);
    E.sa = *(const f32x4*)(P.ssw + (size_t)tok * 8); E.sb = *(const f32x4*)(P.ssw + (size_t)tok * 8 + 4);
}
__device__ __forceinline__ void gla_out_unit(const Ptrs& P, LAS unsigned char* lds, int c, int h, int tid, int wave, int lane, const GoRegs& R, const GoEpi& E) {
    LAS bf16* qT = (LAS bf16*)(lds);
    LAS bf16* kT = (LAS bf16*)(lds + 9216);
    LAS bf16* vT = (LAS bf16*)(lds + 18432);
    LAS bf16* sT = (LAS bf16*)(lds + 36864);
    LAS bf16* aS = (LAS bf16*)(lds + 55296);
    LAS float* oS = (LAS float*)(lds + 64512);
    const int t0 = c * 64, fr = lane & 15, fq = lane >> 4;
    { const int j = tid >> 3, dc = tid & 7;
      float cu[8] = {R.c0[0], R.c0[1], R.c0[2], R.c0[3], R.c1[0], R.c1[1], R.c1[2], R.c1[3]}; v4u qo, ko;
#pragma unroll
      for (int e2 = 0; e2 < 4; ++e2) { const float ea = __expf(cu[2 * e2]), eb = __expf(cu[2 * e2 + 1]);
          qo[e2] = pk2(bflo(R.qq[e2]) * ea, bfhi(R.qq[e2]) * eb); ko[e2] = pk2(bflo(R.kk[e2]) / ea, bfhi(R.kk[e2]) / eb); }
      *(LAS v4u*)(qT + j * 72 + 8 * dc) = qo; *(LAS v4u*)(kT + j * 72 + 8 * dc) = ko;
#pragma unroll
      for (int i = 0; i < 2; ++i) { const int q = tid + 512 * i, jj = q >> 4, cc = q & 15;
#pragma unroll
          for (int e = 0; e < 8; ++e) { const unsigned w = R.vv[i][e >> 1]; vT[(8 * cc + e) * 72 + jj] = (bf16)((e & 1) ? (w >> 16) : (w & 0xffffu)); } }
#pragma unroll
      for (int i = 0; i < 4; ++i) { const int q = tid + 512 * i, d = q >> 5, dv4 = (q & 31) * 4;
#pragma unroll
          for (int e = 0; e < 4; ++e) sT[(dv4 + e) * 72 + d] = (bf16)f2bf(R.sv[i][e]); } }
    BAR_LDS();
    { const int i0 = (wave >> 1) * 16;
#pragma unroll
      for (int q = 0; q < 2; ++q) { const int j0 = ((wave & 1) * 2 + q) * 16; f32x4 acc = (f32x4){0.f, 0.f, 0.f, 0.f};
#pragma unroll
          for (int kk = 0; kk < 2; ++kk) acc = MFMA16(frag(kT, j0, 72, 32 * kk, fr, fq), frag(qT, i0, 72, 32 * kk, fr, fq), acc);
          const int i = i0 + fr, jb = j0 + 4 * fq;
          const unsigned long long w = (unsigned long long)pk2(jb <= i ? acc[0] : 0.f, jb + 1 <= i ? acc[1] : 0.f) | ((unsigned long long)pk2(jb + 2 <= i ? acc[2] : 0.f, jb + 3 <= i ? acc[3] : 0.f) << 32);
          *(LAS unsigned long long*)(aS + i * 72 + jb) = w; } }
    BAR_LDS();
    { const int i0 = (wave & 3) * 16;
#pragma unroll
      for (int q = 0; q < 4; ++q) { const int dv0 = ((wave >> 2) * 4 + q) * 16; f32x4 acc = (f32x4){0.f, 0.f, 0.f, 0.f};
#pragma unroll
          for (int kk = 0; kk < 2; ++kk) { acc = MFMA16(frag(vT, dv0, 72, 32 * kk, fr, fq), frag(aS, i0, 72, 32 * kk, fr, fq), acc);
                                           acc = MFMA16(frag(sT, dv0, 72, 32 * kk, fr, fq), frag(qT, i0, 72, 32 * kk, fr, fq), acc); }
          *(LAS f32x4*)(oS + (i0 + fr) * 132 + dv0 + 4 * fq) = acc; } }
    BAR_LDS();
    { const int i = tid >> 3, seg = tid & 7, tok = t0 + i, col = 128 * h + 16 * seg;
      f32x4 ov[4]; float sq = 0.f;
#pragma unroll
      for (int e = 0; e < 4; ++e) { ov[e] = *(const LAS f32x4*)(oS + i * 132 + 16 * seg + 4 * e); sq += (ov[e][0] * ov[e][0] + ov[e][1] * ov[e][1]) + (ov[e][2] * ov[e][2] + ov[e][3] * ov[e][3]); }
      sq += __shfl_xor(sq, 1); sq += __shfl_xor(sq, 2); sq += __shfl_xor(sq, 4);
      const float rs = rsqrtf(sq * (1.0f / 128.0f) + EPS);
      v4u w0, w1;
#pragma unroll
      for (int e2 = 0; e2 < 4; ++e2) { const int cc = col + 2 * e2;
          w0[e2] = pk2(ov[e2 >> 1][(2 * e2) & 3] * rs * P.g_head[cc] * bflo(E.r0[e2]), ov[e2 >> 1][(2 * e2 + 1) & 3] * rs * P.g_head[cc + 1] * bfhi(E.r0[e2]));
          w1[e2] = pk2(ov[2 + (e2 >> 1)][(2 * e2) & 3] * rs * P.g_head[cc + 8] * bflo(E.r1[e2]), ov[2 + (e2 >> 1)][(2 * e2 + 1) & 3] * rs * P.g_head[cc + 9] * bfhi(E.r1[e2])); }
      *(v4u*)(P.mix + (size_t)tok * 1024 + col) = w0; *(v4u*)(P.mix + (size_t)tok * 1024 + col + 8) = w1;
      const float rs2 = rsqrtf((((E.sa[0] + E.sa[1]) + (E.sa[2] + E.sa[3])) + ((E.sb[0] + E.sb[1]) + (E.sb[2] + E.sb[3]))) * (1.0f / 512.0f) + EPS);
      bf16* mp = P.mix + (size_t)tok * 1024 + 512 + col; v4u b0, b1;
#pragma unroll
      for (int e2 = 0; e2 < 4; ++e2) { const int cc = col + 2 * e2;
          b0[e2] = pk2(bflo(E.a0[e2]) * rs2 * P.g_swa[cc], bfhi(E.a0[e2]) * rs2 * P.g_swa[cc + 1]);
          b1[e2] = pk2(bflo(E.a1[e2]) * rs2 * P.g_swa[cc + 8], bfhi(E.a1[e2]) * rs2 * P.g_swa[cc + 9]); }
      *(v4u*)mp = b0; *(v4u*)(mp + 8) = b1; }
}
__device__ __forceinline__ void gla_out_loop(const Ptrs& P, LAS unsigned char* lds, int first, int stride, int tid, int wave, int lane) {
    int u = first; if (u >= 1024) return;
    GoRegs R; GoEpi E; gla_out_load(P, u >> 2, u & 3, tid, R); gla_out_load_epi(P, u >> 2, u & 3, tid, E);
    for (;;) {
        GoRegs C = R; const int un = u + stride; const bool more = un < 1024;
        if (more) gla_out_load(P, un >> 2, un & 3, tid, R);
        gla_out_unit(P, lds, u >> 2, u & 3, tid, wave, lane, C, E);
        if (more) gla_out_load_epi(P, un >> 2, un & 3, tid, E);
        BAR_LDS();
        if (!more) break; u = un;
    }
}

__device__ __forceinline__ void final_norm_prompt(const Ptrs& P, int wave, int lane, int bidx, int nb) {
    const int gw = bidx * NWAVES + wave, NGW = nb * NWAVES;
    f32x4 gg[4];
#pragma unroll
    for (int j = 0; j < 4; ++j) gg[j] = *((const GAS f32x4*)P.g_final + lane + 64 * j);
    for (int m0 = gw; m0 < SEQ; m0 += 4 * NGW) {
        f32x4 v[4][4]; float rs[4]; int mm[4];
#pragma unroll
        for (int r = 0; r < 4; ++r) { const int m = m0 + r * NGW; mm[r] = m < SEQ ? m : m0;
            const GAS f32x4* xr = (const GAS f32x4*)(P.out + (size_t)mm[r] * D) + lane;
#pragma unroll
            for (int j = 0; j < 4; ++j) v[r][j] = xr[64 * j]; }
#pragma unroll
        for (int r = 0; r < 4; ++r) rs[r] = pg8::row_rs16(P.ss, mm[r]);
#pragma unroll
        for (int r = 0; r < 4; ++r) { if (r > 0 && m0 + r * NGW >= SEQ) continue;
            GAS f32x4* xw = (GAS f32x4*)(P.out + (size_t)mm[r] * D) + lane;
#pragma unroll
            for (int j = 0; j < 4; ++j) xw[64 * j] = v[r][j] * rs[r] * gg[j]; }
    }
}
__device__ __forceinline__ void final_sample(const Ptrs& P, const float* slabs, int wave, int lane, int vcu, int G) {
    const int gw = vcu * NWAVES + wave, NGW = G * NWAVES;
    for (int r = gw; r < NSAMP; r += NGW) {
        GAS f32x4* xr = (GAS f32x4*)(P.out + (size_t)(SEQ + r) * D) + lane;
        f32x4 v[4]; float s = 0.f;
#pragma unroll
        for (int j = 0; j < 4; ++j) { const GAS f32x4* sp = (const GAS f32x4*)(slabs + (size_t)r * D) + lane + 64 * j;
            const f32x4 a = (sp[0] + sp[(size_t)NSAMP * D / 4]) + (sp[(size_t)2 * NSAMP * D / 4] + sp[(size_t)3 * NSAMP * D / 4]);
            v[j] = xr[64 * j] + a * 0.5f; s += (v[j].x * v[j].x + v[j].y * v[j].y) + (v[j].z * v[j].z + v[j].w * v[j].w); }
        const float rs = rsqrtf(wave_sum(s) * (1.f / D) + EPS);
#pragma unroll
        for (int j = 0; j < 4; ++j) { const f32x4 gg = *((const GAS f32x4*)P.g_final + lane + 64 * j); xr[64 * j] = v[j] * rs * gg; }
    }
}

#ifndef PROBE_REP_HI
#define PROBE_REP_HI (-1)
#endif
#ifndef MK_N_LAUNCHES
#define MK_N_LAUNCHES 1
#endif
constexpr int N_PHASES = 12;
__global__ void __launch_bounds__(NTHR, 2) hymba_fwd(Args args) {
    extern __shared__ __attribute__((aligned(16))) unsigned char lds_raw[];
    LAS unsigned char* lds = (LAS unsigned char*)lds_raw;
    volatile LAS unsigned* MISC = (volatile LAS unsigned*)(lds + MISC_OFF);
    const int tid = threadIdx.x, lane = tid & 63, wave = __builtin_amdgcn_readfirstlane(tid >> 6);
    const int G = gridDim.x, bx = blockIdx.x, vcu = (G % 8 == 0) ? (bx % 8) * (G / 8) + bx / 8 : bx;
    unsigned char* ws = args.ws;
    Ptrs P;
    P.x_p = args.in[0]; P.x_s = args.in[1]; P.state0 = args.in[2]; P.ck_in = args.in[3]; P.cv_in = args.in[4]; P.g_ffn1 = args.in[5]; P.wg1 = args.in[6]; P.wu1 = args.in[7]; P.wd1 = args.in[8];
    P.g_mix = args.in[9]; P.w_in = args.in[10]; P.w_gate_up = args.in[11]; P.b_gate = args.in[12]; P.g_head = args.in[13]; P.g_swa = args.in[14]; P.sinks = args.in[15]; P.w_out = args.in[16];
    P.g_ffn2 = args.in[17]; P.wg2 = args.in[18]; P.wu2 = args.in[19]; P.wd2 = args.in[20]; P.g_final = args.in[21];
    P.out = args.out;
    P.wgu1 = (bf16*)(ws + WS_WGU1); P.wd1t = (bf16*)(ws + WS_WD1); P.wgu2 = (bf16*)(ws + WS_WGU2); P.wd2t = (bf16*)(ws + WS_WD2); P.wint = (bf16*)(ws + WS_WIN); P.woutt = (bf16*)(ws + WS_WOUT);
    P.xn = (bf16*)(ws + WS_XN); P.mix = (bf16*)(ws + WS_MIX); P.hbuf = (bf16*)(ws + WS_R);
    P.qg = (bf16*)(ws + WS_R + R_QG); P.kg = (bf16*)(ws + WS_R + R_KG); P.vg = (bf16*)(ws + WS_R + R_VG); P.rg = (bf16*)(ws + WS_R + R_RG); P.qs = (bf16*)(ws + WS_R + R_QS); P.kvs = (bf16*)(ws + WS_R + R_KVS);
    P.cum = (float*)(ws + WS_R + R_CUM);
    P.ss = (float*)(ws + WS_SS); P.ssw = (float*)(ws + WS_SSW); P.alr = (float*)(ws + WS_ALR); P.g = (float*)(ws + WS_G); P.ds = (float*)(ws + WS_DS);

    for (int u = tid; u < (LDS_BYTES - RING_BYTES) / 4; u += NTHR) ((LAS unsigned*)(lds + RING_BYTES))[u] = 0u;
    __syncthreads();
    const int lo = args.ph_lo, hi = args.ph_hi;
    unsigned* barw = (unsigned*)(ws + WS_CTL) + args.bar_region * XCD_BAR_WORDS;
    XcdBarrier bar; bar.bar = barw; bar.x = 0; bar.st = nullptr;
    if (hi - lo > 1) bar = xcd_barrier_post(barw, MISC + 8);
#define IN(k) (lo <= (k) && (k) < hi)
#define SEAM(k) do { if (IN(k) && IN((k) + 1)) xcd_barrier(bar); } while (0)

    if (IN(0)) p0_prologue(P, lds, tid, wave, lane, vcu, G);
    SEAM(0);
    if (IN(1)) { pg8::Gemm g{P.xn, P.wgu1, M, 5632, 1024, 1024}; pg8::StaticOrder S; S.init(M, 5632, G, bx); pg8::EpiGU E{P.hbuf, nullptr};
        pg8::gemm_phase<pg8::EpiGU, pg8::StaticOrder, true, true>(lds, g, S, E); }
    SEAM(1);
    if (IN(2)) { pg8::Gemm g{P.hbuf, P.wd1t, M, 1024, 2816, 2816}; pg8::SubOrder S; S.init(64, 1024, 0, G, 0, bx); pg8::EpiRes E{P.x_p, P.x_s, P.out, P.xn, P.g_mix, P.ss, 0.5f};
        pg8::gemm_phase<pg8::EpiRes, pg8::SubOrder, true, true>(lds, g, S, E); }
    SEAM(2);
    if (IN(3)) {
        if (bx < G - 8) { pg8::Gemm g{P.xn, P.wint, M, NPROJ, 1024, 1024}; pg8::SubOrder S; S.init(64, NPROJ, 0, G - 8, 0, bx);
            pg8::EpiProj E{P.ss, P.qg, P.kg, P.vg, P.rg, P.qs, P.kvs, P.alr, P.out + O_CKP, P.out + O_CVP, P.out + O_CKS, P.out + O_CVS};
            pg8::gemm_phase<pg8::EpiProj, pg8::SubOrder, true, true>(lds, g, S, E); }
        else { pg8::Gemm g{P.hbuf, P.wd1t, M, 1024, 2816, 2816}; pg8::SubOrder S; S.init(2, 1024, G - 8, 8, 64, bx); pg8::EpiRes E{P.x_p, P.x_s, P.out, P.xn, P.g_mix, P.ss, 0.5f};
            pg8::gemm_phase<pg8::EpiRes, pg8::SubOrder, true, true>(lds, g, S, E); }
    }
    SEAM(3);
    if (IN(4)) {
        if (bx < G - 20) { gla_local_loop(P, lds, bx, G - 20, tid, wave, lane); swa_prompt_loop(P, lds, bx, G - 20, tid, wave, lane); }
        else { pg8::Gemm g{P.xn, P.wint, M, NPROJ, 1024, 1024}; pg8::SubOrder S; S.init(2, NPROJ, G - 20, 20, 64, bx);
            pg8::EpiProj E{P.ss, P.qg, P.kg, P.vg, P.rg, P.qs, P.kvs, P.alr, P.out + O_CKP, P.out + O_CVP, P.out + O_CKS, P.out + O_CVS};
            pg8::gemm_phase<pg8::EpiProj, pg8::SubOrder, true, true>(lds, g, S, E); }
    }
    SEAM(4);
    if (IN(5)) {
        for (int sb = bx; sb < 512; sb += G) gla_scan2(P, lds, sb, tid);
        for (int u = bx; u < 128; u += G) swa_sample_unit(P, lds, u, tid, wave, lane);
        for (int u = bx; u < 256; u += G) if (u >= 128) gla_sample_unit(P, lds, u - 128, tid, wave, lane);
    }
    SEAM(5);
    if (IN(6)) {
        if (bx < G - 8) gla_out_loop(P, lds, bx, G - 8, tid, wave, lane);
        else { pg8::Gemm g{P.mix, P.woutt, M, 1024, 1024, 1024}; pg8::SubOrder S; S.init(2, 1024, G - 8, 8, 64, bx); pg8::EpiRes E{P.out, P.out + (size_t)SEQ * 1024, P.out, P.xn, P.g_ffn2, P.ss, 1.0f};
            pg8::gemm_phase<pg8::EpiRes, pg8::SubOrder, true, true>(lds, g, S, E); }
    }
    SEAM(6);
    if (IN(7)) { pg8::Gemm g{P.mix, P.woutt, M, 1024, 1024, 1024}; pg8::SubOrder S; S.init(64, 1024, 0, G, 0, bx); pg8::EpiRes E{P.out, P.out + (size_t)SEQ * 1024, P.out, P.xn, P.g_ffn2, P.ss, 1.0f};
        pg8::gemm_phase<pg8::EpiRes, pg8::SubOrder, true, true>(lds, g, S, E); }
    SEAM(7);
    if (IN(8)) { pg8::Gemm g{P.xn, P.wgu2, M, 5632, 1024, 1024}; pg8::StaticOrder S; S.init(M, 5632, G, bx); pg8::EpiGU E{P.hbuf, P.ss};
        pg8::gemm_phase<pg8::EpiGU, pg8::StaticOrder, true, true>(lds, g, S, E); }
    SEAM(8);
    if (IN(9)) { pg8::Gemm g{P.hbuf, P.wd2t, M, 1024, 2816, 2816}; pg8::SubOrder S; S.init(64, 1024, 0, G, 0, bx); pg8::EpiRes E{P.out, P.out + (size_t)SEQ * 1024, P.out, nullptr, nullptr, P.ss, 0.5f};
        pg8::gemm_phase<pg8::EpiRes, pg8::SubOrder, true, true>(lds, g, S, E); }
    SEAM(9);
    if (IN(10)) {
        if (bx < G - 32) final_norm_prompt(P, wave, lane, bx, G - 32);
        else { const int j = bx - (G - 32), ks = j >> 3, tile = j & 7;
            const int koff = ks < 2 ? 768 * ks : 1536 + 640 * (ks - 2), klen = ks < 2 ? 768 : 640;
            pg8::Gemm g{P.hbuf + koff, P.wd2t + koff, M, 1024, klen, 2816}; pg8::OneUnit S; S.u0.pm = 64 + (tile & 1); S.u0.pn = tile >> 1; S.on = true;
            pg8::EpiPartial E{P.ds + (size_t)ks * NSAMP * 1024};
            pg8::gemm_phase<pg8::EpiPartial, pg8::OneUnit, true, true>(lds, g, S, E); }
    }
    SEAM(10);
    if (IN(11)) final_sample(P, P.ds, wave, lane, vcu, G);
#undef IN
#undef SEAM
}

extern "C" void kernel_launch(void* const* d_in, const int* in_sizes, int n_in, void* d_out, int out_size, void* d_ws, size_t ws_size, hipStream_t stream) {
    static int grid = 0;
    if (grid == 0) {
        if (n_in != 22 || (size_t)out_size != O_END || ws_size < WS_END) { fprintf(stderr, "kernel_launch: unexpected shapes (n_in %d, out %d, ws %zu); nothing launched\n", n_in, out_size, ws_size); grid = -1; return; }
        int dev = 0, cus = 0, per_cu = 0;
        if (hipGetDevice(&dev) != hipSuccess || hipDeviceGetAttribute(&cus, hipDeviceAttributeMultiprocessorCount, dev) != hipSuccess) { grid = -1; return; }
        if (hipFuncSetAttribute((const void*)hymba_fwd, hipFuncAttributeMaxDynamicSharedMemorySize, LDS_BYTES) != hipSuccess) { fprintf(stderr, "kernel_launch: hipFuncSetAttribute failed\n"); grid = -1; return; }
        if (hipOccupancyMaxActiveBlocksPerMultiprocessor(&per_cu, (const void*)hymba_fwd, NTHR, LDS_BYTES) != hipSuccess || per_cu < 1) { fprintf(stderr, "kernel_launch: occupancy query says %d blocks per CU\n", per_cu); (void)hipGetLastError(); grid = -1; return; }
        grid = cus;
    }
    if (grid < 0) return;
    if (hipMemsetAsync((char*)d_ws + WS_CTL, 0, CTL_ZERO_BYTES, stream) != hipSuccess) return;
    Args a{};
    for (int i = 0; i < 22; ++i) a.in[i] = (const float*)d_in[i];
    a.out = (float*)d_out; a.ws = (unsigned char*)d_ws;
#if MK_N_LAUNCHES == 1
    void* kargs[] = {&a};
#if PROBE_REP_HI >= 0
    a.ph_lo = 0; a.ph_hi = PROBE_REP_HI + 1; a.bar_region = 1;
    (void)hipLaunchCooperativeKernel((const void*)hymba_fwd, dim3(grid), dim3(NTHR), kargs, LDS_BYTES, stream);
#endif
    a.ph_lo = 0; a.ph_hi = N_PHASES; a.bar_region = 0;
    hipError_t e = hipLaunchCooperativeKernel((const void*)hymba_fwd, dim3(grid), dim3(NTHR), kargs, LDS_BYTES, stream);
    if (e != hipSuccess) fprintf(stderr, "kernel_launch: cooperative launch failed: %s (grid %d)\n", hipGetErrorString(e), grid);
#else
    for (int p = 0; p < N_PHASES; ++p) { a.ph_lo = p; a.ph_hi = p + 1; hipLaunchKernelGGL(hymba_fwd, dim3(grid), dim3(NTHR), LDS_BYTES, stream, a); }
#endif
}
```

```cpp
#include <hip/hip_runtime.h>
#include <hip/hip_cooperative_groups.h>
#include <cstdio>
#include <cstdint>
namespace cg = cooperative_groups;

constexpr int D = 1024, SEQ = 16384, NSAMP = 512, M = SEQ + NSAMP, FF = 2816, DIN = 2320, NPROJ = 2560;
constexpr int DECB = 128, DECT = 4;
constexpr float EPS = 1e-6f;
namespace pg8 {
#define PG8_LAS __attribute__((address_space(3)))
typedef unsigned short bf16_t;
typedef short bf16x8 __attribute__((ext_vector_type(8)));
typedef float f32x4 __attribute__((ext_vector_type(4)));
typedef unsigned u32x4 __attribute__((ext_vector_type(4)));
constexpr int BM = 256, BK = 64, HALF = 128, HTB = HALF * BK * 2  , STAGE_BYTES = 8 * HTB, NXCD = 8, WGM = 8;

__host__ __device__ __forceinline__ int lds_byte(int r, int c) { const int st = (r >> 4) * 2 + (c >> 5), rr = r & 15, cc = c & 31, ob = rr * 64 + cc * 2; return st * 1024 + (ob ^ (((ob >> 9) & 1) << 5)); }
__host__ __device__ __forceinline__ void stage_rc(int b, int& R, int& C) { const int st = b / 1024, sb = b % 1024, swz = sb ^ (((sb >> 9) & 1) << 5); R = (st >> 1) * 16 + swz / 64; C = (st & 1) * 32 + (swz % 64) / 2; }
__host__ __device__ __forceinline__ int perm32(int rho) { const int n = rho >> 4, i = rho & 15; return 8 * (i >> 2) + 4 * n + (i & 3); }

struct Unit { int pm, pn; };
struct Gemm { const bf16_t* A; const bf16_t* Bt; int M, N, K, ld; };

struct StaticOrder {
    int nM, nN, nwg, G, c;
    __host__ __device__ void init(int M, int N, int G_, int c_) { nM = M / BM; nN = N / BM; nwg = nM * nN; G = G_; c = c_; }
    __host__ __device__ bool next(int i, Unit& u) const {
        const long L = (long)i * G + c; if (L >= nwg) return false;
        int wgid = (int)L; { const int q = nwg / NXCD, r = nwg % NXCD, xcd = wgid % NXCD, off = wgid / NXCD; wgid = (xcd < r ? xcd * (q + 1) : r * (q + 1) + (xcd - r) * q) + off; }
        const int nig = WGM * nN, gid = wgid / nig, fm = gid * WGM, gsz = (nM - fm) < WGM ? (nM - fm) : WGM;
        u.pm = fm + ((wgid % nig) % gsz); u.pn = (wgid % nig) / gsz; return true;
    }
    __device__ __forceinline__ void a_ready(const Unit&) const {}
    __device__ __forceinline__ void done(const Unit&) const {}
};

__device__ __forceinline__ unsigned cvt_pk_bf16(float lo, float hi) { unsigned r; asm volatile("v_cvt_pk_bf16_f32 %0, %1, %2" : "=v"(r) : "v"(lo), "v"(hi)); return r; }
typedef float f32x2 __attribute__((ext_vector_type(2)));
__device__ __forceinline__ float row_rs16(const float* ss, int row) {
    const f32x4* p = (const f32x4*)(ss + (size_t)row * 16);
    const f32x4 t = (p[0] + p[1]) + (p[2] + p[3]);
    return rsqrtf(((t[0] + t[1]) + (t[2] + t[3])) * (1.0f / 1024.0f) + 1e-6f);
}
__device__ __forceinline__ float silu_f(float g) { return g * __builtin_amdgcn_rcpf(1.0f + __builtin_amdgcn_exp2f(-1.4426950408889634f * g)); }

struct EpiGU {
    static constexpr bool PERM = true, AFTER_DRAIN = false;
    bf16_t* H; const float* ss;
    __device__ __forceinline__ void operator()(const f32x4 (&acc)[2][2][4][2], const Unit& u, int wr, int wc, int fr, int fq) const {
        const int row0 = u.pm * BM + wr * 64 + fr;
        const int col0 = u.pn * 128 + wc * 32 + 8 * fq;
#pragma unroll
        for (int ai = 0; ai < 2; ++ai)
#pragma unroll
            for (int m = 0; m < 4; ++m) {
                const int row = row0 + ai * HALF + m * 16;
                float rs = 1.0f;
                if (ss) rs = row_rs16(ss, row);
                float h[8];
#pragma unroll
                for (int n = 0; n < 2; ++n)
#pragma unroll
                    for (int e = 0; e < 4; ++e) { const float g = acc[ai][0][m][n][e] * rs, up = acc[ai][1][m][n][e] * rs; h[4 * n + e] = silu_f(g) * up; }
                u32x4 w; w.x = cvt_pk_bf16(h[0], h[1]); w.y = cvt_pk_bf16(h[2], h[3]); w.z = cvt_pk_bf16(h[4], h[5]); w.w = cvt_pk_bf16(h[6], h[7]);
                *(u32x4*)(H + (size_t)row * 2816 + col0) = w;
            }
    }
};

struct EpiRes {
    static constexpr bool PERM = true, AFTER_DRAIN = false;
    const float* xp; const float* xs; float* out; bf16_t* xn; const float* gain; float* ss; float scale;
    __device__ __forceinline__ void operator()(const f32x4 (&acc)[2][2][4][2], const Unit& u, int wr, int wc, int fr, int fq) const {
        const int row0 = u.pm * BM + wr * 64 + fr;
        const int col0 = u.pn * BM + wc * 32 + 8 * fq;
        f32x4 gv[2][2];
#pragma unroll
        for (int bj = 0; bj < 2; ++bj)
#pragma unroll
            for (int n = 0; n < 2; ++n) gv[bj][n] = xn ? *(const f32x4*)(gain + col0 + bj * HALF + 4 * n) : (f32x4){1.f, 1.f, 1.f, 1.f};
#pragma unroll
        for (int ai = 0; ai < 2; ++ai)
#pragma unroll
            for (int m = 0; m < 4; ++m) {
                const int row = row0 + ai * HALF + m * 16;
                const float* rp = (row < 16384 ? xp + (size_t)row * 1024 : xs + (size_t)(row - 16384) * 1024) + col0;
                float* op = out + (size_t)row * 1024 + col0;
                float sq = 0.f;
#pragma unroll
                for (int bj = 0; bj < 2; ++bj) {
                    const f32x4 r0 = *(const f32x4*)(rp + bj * HALF), r1 = *(const f32x4*)(rp + bj * HALF + 4);
                    const f32x4 v0 = r0 + acc[ai][bj][m][0] * scale, v1 = r1 + acc[ai][bj][m][1] * scale;
                    *(f32x4*)(op + bj * HALF) = v0; *(f32x4*)(op + bj * HALF + 4) = v1;
                    sq += (v0[0] * v0[0] + v0[1] * v0[1]) + (v0[2] * v0[2] + v0[3] * v0[3]);
                    sq += (v1[0] * v1[0] + v1[1] * v1[1]) + (v1[2] * v1[2] + v1[3] * v1[3]);
                    if (xn) { const f32x4 a = v0 * gv[bj][0], b = v1 * gv[bj][1];
                        u32x4 w; w.x = cvt_pk_bf16(a[0], a[1]); w.y = cvt_pk_bf16(a[2], a[3]); w.z = cvt_pk_bf16(b[0], b[1]); w.w = cvt_pk_bf16(b[2], b[3]);
                        *(u32x4*)(xn + (size_t)row * 1024 + col0 + bj * HALF) = w; }
                }
                sq += __shfl_xor(sq, 16); sq += __shfl_xor(sq, 32);
                if (fq == 0) ss[(size_t)row * 16 + u.pn * 4 + wc] = sq;
            }
    }
};

struct EpiProj {
    static constexpr bool PERM = true, AFTER_DRAIN = false;
    const float* ss; bf16_t *qg, *kg, *vg, *rg, *qs, *kvs; float* alr; float *ckp, *cvp, *cks, *cvs;
    __device__ __forceinline__ void operator()(const f32x4 (&acc)[2][2][4][2], const Unit& u, int wr, int wc, int fr, int fq) const {
        const int row0 = u.pm * BM + wr * 64 + fr;
        const int pn = u.pn;
#pragma unroll
        for (int ai = 0; ai < 2; ++ai)
#pragma unroll
            for (int m = 0; m < 4; ++m) {
                const int row = row0 + ai * HALF + m * 16;
                const float rs = row_rs16(ss, row);
#pragma unroll
                for (int bj = 0; bj < 2; ++bj) {
                    const int cl = bj * HALF + wc * 32 + 8 * fq;
                    f32x4 v0 = acc[ai][bj][m][0] * rs, v1 = acc[ai][bj][m][1] * rs;
                    if (pn == 9) {
                        if (cl < 16) { float* p = alr + (size_t)row * 16 + cl; *(f32x4*)p = v0; *(f32x4*)(p + 4) = v1; }
                        continue;
                    }
                    bf16_t* dst;
                    if (pn == 0) { dst = qg + (size_t)row * 256 + cl; v0 = v0 * 0.125f; v1 = v1 * 0.125f; }
                    else if (pn == 1) { dst = kg + (size_t)row * 256 + cl; }
                    else if (pn < 4) { dst = vg + (size_t)row * 512 + (pn - 2) * 256 + cl; }
                    else if (pn < 6) { dst = rg + (size_t)row * 512 + (pn - 4) * 256 + cl;
#pragma unroll
                        for (int e = 0; e < 4; ++e) { v0[e] = silu_f(v0[e]); v1[e] = silu_f(v1[e]); } }
                    else if (pn < 8) { dst = qs + (size_t)row * 512 + (pn - 6) * 256 + cl; v0 = v0 * 0.125f; v1 = v1 * 0.125f; }
                    else { dst = kvs + (size_t)row * 256 + cl;
                        float* cp = nullptr;
                        if (row >= 16384) { const int sr = row - 16384; cp = (bj ? cvs : cks) + ((size_t)(sr >> 2) * 128 + 124 + (sr & 3)) * 128 + (cl & 127); }
                        else if (row >= 16384 - 128) { cp = (bj ? cvp : ckp) + (size_t)(row - (16384 - 128)) * 128 + (cl & 127); }
                        if (cp) { *(f32x4*)cp = v0; *(f32x4*)(cp + 4) = v1; }
                    }
                    u32x4 w; w.x = cvt_pk_bf16(v0[0], v0[1]); w.y = cvt_pk_bf16(v0[2], v0[3]); w.z = cvt_pk_bf16(v1[0], v1[1]); w.w = cvt_pk_bf16(v1[2], v1[3]);
                    *(u32x4*)dst = w;
                }
            }
    }
};

struct EpiPartial {
    static constexpr bool PERM = true, AFTER_DRAIN = false;
    float* slab;
    __device__ __forceinline__ void operator()(const f32x4 (&acc)[2][2][4][2], const Unit& u, int wr, int wc, int fr, int fq) const {
        const int row0 = (u.pm - 64) * BM + wr * 64 + fr;
        const int col0 = u.pn * BM + wc * 32 + 8 * fq;
#pragma unroll
        for (int ai = 0; ai < 2; ++ai)
#pragma unroll
            for (int m = 0; m < 4; ++m) { float* rp = slab + (size_t)(row0 + ai * HALF + m * 16) * 1024 + col0;
#pragma unroll
                for (int bj = 0; bj < 2; ++bj) { *(f32x4*)(rp + bj * HALF) = acc[ai][bj][m][0]; *(f32x4*)(rp + bj * HALF + 4) = acc[ai][bj][m][1]; } }
    }
};
struct SubOrder {
    StaticOrder S; int pm0; bool on;
    __device__ __forceinline__ void init(int nMp, int N, int b0, int nb, int pm0_, int bx) { on = (bx >= b0) && (bx < b0 + nb); S.init(nMp * BM, N, nb, on ? bx - b0 : 0); pm0 = pm0_; }
    __device__ __forceinline__ bool next(int i, Unit& u) const { if (!on) return false; if (!S.next(i, u)) return false; u.pm += pm0; return true; }
    __device__ __forceinline__ void a_ready(const Unit&) const {}
    __device__ __forceinline__ void done(const Unit&) const {}
};
struct OneUnit {
    Unit u0; bool on;
    __device__ __forceinline__ bool next(int i, Unit& u) const { if (!on || i != 0) return false; u = u0; return true; }
    __device__ __forceinline__ void a_ready(const Unit&) const {}
    __device__ __forceinline__ void done(const Unit&) const {}
};
template <class Epi, class Sched, bool ALIGN_EPI = false, bool SP2 = false>
__device__ __forceinline__ void gemm_phase(PG8_LAS unsigned char* lds, const Gemm g, const Sched& S, const Epi& E) {
    const int tid = threadIdx.x, wid = __builtin_amdgcn_readfirstlane(tid >> 6), lane = tid & 63, wr = wid >> 2, wc = wid & 3, fr = lane & 15, fq = lane >> 4;
    const int K = g.ld, nt = g.K / BK;
    unsigned voffA[2], voffB[2];
#pragma unroll
    for (int i = 0; i < 2; ++i) { int R, C; stage_rc(tid * 16 + i * 8192, R, C); const int Rb = Epi::PERM ? ((R & ~31) + perm32(R & 31)) : R;
        voffA[i] = (unsigned)(R * K + C) * 2u; voffB[i] = (unsigned)(Rb * K + C) * 2u; }
    const size_t kstep = (size_t)(BK * 2);
    const size_t hstep = (size_t)HALF * K * 2;
    const size_t tstep = 2 * hstep;
    const unsigned ldsw = (unsigned)wid * 1024u;
    const int aoff = lds_byte(wr * 64 + fr, fq * 8), boff = lds_byte(wc * 32 + fr, fq * 8);
#define PG8_SA(b, h) (((b) * 2 + (h)) * HTB)
#define PG8_SB(b, h) ((4 + (b) * 2 + (h)) * HTB)
#define PG8_STAGE(bufoff, gbase, voff) do { _Pragma("unroll") for (int _i = 0; _i < 2; ++_i) \
        __builtin_amdgcn_global_load_lds((const unsigned*)((const char*)(gbase) + (voff)[_i]), (PG8_LAS unsigned*)(lds + (bufoff) + ldsw + _i * 8192), 16, 0, 0); } while (0)
#define PG8_LDA(dst, b, h) do { _Pragma("unroll") for (int m = 0; m < 4; ++m) _Pragma("unroll") for (int k = 0; k < 2; ++k) dst[m][k] = *(const PG8_LAS bf16x8*)(lds + PG8_SA(b, h) + aoff + m * 2048 + k * 1024); } while (0)
#define PG8_LDB(dst, b, h) do { _Pragma("unroll") for (int n = 0; n < 2; ++n) _Pragma("unroll") for (int k = 0; k < 2; ++k) dst[n][k] = *(const PG8_LAS bf16x8*)(lds + PG8_SB(b, h) + boff + n * 2048 + k * 1024); } while (0)
#define PG8_MMA(ai, bj, At, Bt) do { __builtin_amdgcn_s_setprio(1); _Pragma("unroll") for (int m = 0; m < 4; ++m) _Pragma("unroll") for (int n = 0; n < 2; ++n) _Pragma("unroll") for (int k = 0; k < 2; ++k) \
        acc[ai][bj][m][n] = __builtin_amdgcn_mfma_f32_16x16x32_bf16(Bt[n][k], At[m][k], acc[ai][bj][m][n], 0, 0, 0); __builtin_amdgcn_s_setprio(0); } while (0)
#define PG8_WAIT_V(n) asm volatile("s_waitcnt vmcnt(" #n ")" ::: "memory")
#define PG8_WAIT_L(n) asm volatile("s_waitcnt lgkmcnt(" #n ")" ::: "memory")
#define PG8_BAR __builtin_amdgcn_s_barrier()
#define PG8_SCHED __builtin_amdgcn_sched_barrier(0)
    Unit cur, nxt; int ui = 0;
    if (!S.next(0, cur)) return;
    f32x4 acc[2][2][4][2];
#pragma unroll
    for (int a = 0; a < 2; ++a)
#pragma unroll
        for (int b = 0; b < 2; ++b)
#pragma unroll
            for (int m = 0; m < 4; ++m)
#pragma unroll
                for (int n = 0; n < 2; ++n) acc[a][b][m][n] = (f32x4){0.f, 0.f, 0.f, 0.f};
    bf16x8 At[4][2], B0[2][2], B1[2][2];
    const char* cA = (const char*)g.A + (size_t)cur.pm * tstep; const char* cB = (const char*)g.Bt + (size_t)cur.pn * tstep;
    S.a_ready(cur);
    if constexpr (SP2) {
        PG8_STAGE(PG8_SB(0, 0), cB, voffB); PG8_STAGE(PG8_SB(0, 1), cB + hstep, voffB); PG8_STAGE(PG8_SA(0, 0), cA, voffA); PG8_STAGE(PG8_SA(0, 1), cA + hstep, voffA);
        if (wr == 1) PG8_BAR;
        PG8_WAIT_V(2); PG8_BAR;
        PG8_STAGE(PG8_SB(1, 0), cB + kstep, voffB); PG8_STAGE(PG8_SA(1, 0), cA + kstep, voffA); PG8_STAGE(PG8_SB(1, 1), cB + hstep + kstep, voffB);
        PG8_WAIT_V(6); PG8_BAR;
    } else {
        PG8_STAGE(PG8_SB(0, 0), cB, voffB); PG8_STAGE(PG8_SA(0, 0), cA, voffA); PG8_STAGE(PG8_SB(0, 1), cB + hstep, voffB); PG8_STAGE(PG8_SA(0, 1), cA + hstep, voffA);
        if (wr == 1) PG8_BAR;
        PG8_WAIT_V(4); PG8_BAR;
        PG8_STAGE(PG8_SB(1, 0), cB + kstep, voffB); PG8_STAGE(PG8_SA(1, 0), cA + kstep, voffA); PG8_STAGE(PG8_SB(1, 1), cB + hstep + kstep, voffB);
        PG8_WAIT_V(6); PG8_BAR;
    }
    for (;;) {
        const bool has_next = S.next(ui + 1, nxt);
        const char* nA = has_next ? (const char*)g.A + (size_t)nxt.pm * tstep : cA; const char* nB = has_next ? (const char*)g.Bt + (size_t)nxt.pn * tstep : cB;
        for (int t = 0; t < nt; t += 2) {
            const bool last = (t == nt - 2);
            const char* a1 = cA + (size_t)(t + 1) * kstep;
            const char* a2 = last ? nA : cA + (size_t)(t + 2) * kstep; const char* b2 = last ? nB : cB + (size_t)(t + 2) * kstep;
            const char* a3 = a2 + kstep; const char* b3 = b2 + kstep;
            if (last && has_next) S.a_ready(nxt);
            if constexpr (SP2) {
            PG8_LDB(B0, 0, 0); PG8_LDB(B1, 0, 1); PG8_SCHED; PG8_LDA(At, 0, 0); PG8_STAGE(PG8_SA(1, 1), a1 + hstep, voffA);
            PG8_WAIT_V(8); PG8_WAIT_L(0); PG8_BAR; PG8_MMA(0, 0, At, B0); PG8_MMA(0, 1, At, B1); PG8_BAR; PG8_SCHED;
            PG8_LDA(At, 0, 1); PG8_STAGE(PG8_SB(0, 0), b2, voffB); PG8_STAGE(PG8_SB(0, 1), b2 + hstep, voffB); PG8_STAGE(PG8_SA(0, 0), a2, voffA);
            PG8_WAIT_V(8); PG8_WAIT_L(0); PG8_BAR; PG8_MMA(1, 0, At, B0); PG8_MMA(1, 1, At, B1); PG8_BAR; PG8_SCHED;
            PG8_LDB(B0, 1, 0); PG8_LDB(B1, 1, 1); PG8_SCHED; PG8_LDA(At, 1, 0); PG8_STAGE(PG8_SA(0, 1), a2 + hstep, voffA);
            PG8_WAIT_V(8); PG8_WAIT_L(0); PG8_BAR; PG8_MMA(0, 0, At, B0); PG8_MMA(0, 1, At, B1); PG8_BAR; PG8_SCHED;
            PG8_LDA(At, 1, 1); PG8_STAGE(PG8_SB(1, 0), b3, voffB); PG8_STAGE(PG8_SB(1, 1), b3 + hstep, voffB); PG8_STAGE(PG8_SA(1, 0), a3, voffA);
            PG8_WAIT_V(8); PG8_WAIT_L(0); PG8_BAR; PG8_MMA(1, 0, At, B0); PG8_MMA(1, 1, At, B1); PG8_BAR; PG8_SCHED;
            } else {
            PG8_LDB(B0, 0, 0); PG8_SCHED; PG8_LDA(At, 0, 0); PG8_STAGE(PG8_SA(1, 1), a1 + hstep, voffA);
            PG8_WAIT_L(8); PG8_BAR; PG8_WAIT_L(0); PG8_MMA(0, 0, At, B0); PG8_BAR; PG8_SCHED;
            PG8_LDB(B1, 0, 1); PG8_STAGE(PG8_SB(0, 0), b2, voffB);
            PG8_BAR; PG8_WAIT_L(0); PG8_MMA(0, 1, At, B1); PG8_BAR;
            PG8_LDA(At, 0, 1); PG8_STAGE(PG8_SA(0, 0), a2, voffA);
            PG8_BAR; PG8_WAIT_L(0); PG8_MMA(1, 0, At, B0); PG8_BAR; PG8_SCHED;
            PG8_STAGE(PG8_SB(0, 1), b2 + hstep, voffB);
            PG8_WAIT_V(6); PG8_BAR; PG8_MMA(1, 1, At, B1); PG8_BAR;
            PG8_LDB(B0, 1, 0); PG8_SCHED; PG8_LDA(At, 1, 0); PG8_STAGE(PG8_SA(0, 1), a2 + hstep, voffA);
            PG8_WAIT_L(8); PG8_BAR; PG8_WAIT_L(0); PG8_MMA(0, 0, At, B0); PG8_BAR; PG8_SCHED;
            PG8_LDB(B1, 1, 1); PG8_STAGE(PG8_SB(1, 0), b3, voffB);
            PG8_BAR; PG8_WAIT_L(0); PG8_MMA(0, 1, At, B1); PG8_BAR;
            PG8_LDA(At, 1, 1); PG8_STAGE(PG8_SA(1, 0), a3, voffA);
            PG8_BAR; PG8_WAIT_L(0); PG8_MMA(1, 0, At, B0); PG8_BAR; PG8_SCHED;
            PG8_STAGE(PG8_SB(1, 1), b3 + hstep, voffB);
            PG8_WAIT_V(6); PG8_BAR; PG8_MMA(1, 1, At, B1); PG8_BAR;
            }
        }
        if constexpr (ALIGN_EPI) { if (wr == 0) PG8_BAR; }
        if constexpr (!Epi::AFTER_DRAIN) { E(acc, cur, wr, wc, fr, fq); S.done(cur); }
        if (!has_next) break;
#pragma unroll
        for (int a = 0; a < 2; ++a)
#pragma unroll
            for (int b = 0; b < 2; ++b)
#pragma unroll
                for (int m = 0; m < 4; ++m)
#pragma unroll
                    for (int n = 0; n < 2; ++n) acc[a][b][m][n] = (f32x4){0.f, 0.f, 0.f, 0.f};
        cur = nxt; cA = nA; cB = nB; ++ui;
        if constexpr (ALIGN_EPI) { if (wr == 1) PG8_BAR; }
    }
    PG8_WAIT_V(0);
    if constexpr (!ALIGN_EPI) { if (wr == 0) PG8_BAR; }
    PG8_BAR;
    if constexpr (Epi::AFTER_DRAIN) { E.fused(acc, cur, wr, wc, fr, fq, lds, wid, lane); S.done(cur); }
#undef PG8_SA
#undef PG8_SB
#undef PG8_STAGE
#undef PG8_LDA
#undef PG8_LDB
#undef PG8_MMA
#undef PG8_WAIT_V
#undef PG8_WAIT_L
#undef PG8_BAR
#undef PG8_SCHED
}
}
#define GAS __attribute__((address_space(1)))
#define LAS __attribute__((address_space(3)))
typedef unsigned short bf16;
typedef unsigned v4u __attribute__((ext_vector_type(4)));
typedef float f32x4 __attribute__((ext_vector_type(4)));
typedef short bf16x8 __attribute__((ext_vector_type(8)));
typedef GAS unsigned gu32;
typedef GAS unsigned long long gu64;
#define RLX_AGENT __ATOMIC_RELAXED, __HIP_MEMORY_SCOPE_AGENT
#define LDS_WAIT() asm volatile("s_waitcnt lgkmcnt(0)" ::: "memory")
#define VM_WAIT() asm volatile("s_waitcnt vmcnt(0)" ::: "memory")
__device__ __forceinline__ unsigned long long rt() { return __builtin_amdgcn_s_memrealtime(); }
__device__ __forceinline__ unsigned f2bf(float f) { unsigned u = __builtin_bit_cast(unsigned, f); return (u + 0x7fffu + ((u >> 16) & 1u)) >> 16; }
__device__ __forceinline__ unsigned pk2(float lo, float hi) { return f2bf(lo) | (f2bf(hi) << 16); }

#define XB_TMO      128
#define XB_XCNT(j)  (256  + 64 * (j))
#define XB_XSUB(j)  (1280 + 64 * (j))
#define XB_XGEN(j)  (2304 + 64 * (j))
#define XB_TOP      3328
#define XB_TOPGEN   3392
#define XCD_BAR_WORDS 3456
#define XB_SPIN_CAP (1u << 18)

__device__ __forceinline__ unsigned xb_ld(unsigned* p)              { return __hip_atomic_load(p, __ATOMIC_RELAXED, __HIP_MEMORY_SCOPE_AGENT); }
__device__ __forceinline__ unsigned xb_add(unsigned* p, unsigned v) { return __hip_atomic_fetch_add(p, v, __ATOMIC_RELAXED, __HIP_MEMORY_SCOPE_AGENT); }
__device__ __forceinline__ unsigned xb_xcc_id() { return (unsigned)__builtin_amdgcn_s_getreg((3 << 11) | 20) & 0xFu; }
#define XB_SPIN(cond, bar) do { unsigned _sp = 0; while (cond) { __builtin_amdgcn_s_sleep(1); \
    if ((++_sp & 255u) == 0u) { if (xb_ld(&(bar)[XB_TMO])) break; if (_sp > XB_SPIN_CAP) { atomicAdd(&(bar)[XB_TMO], 1u); break; } } } } while (0)

struct XcdBarrier {
    unsigned* bar; unsigned x;
    volatile LAS unsigned* st;
};

__device__ __forceinline__ XcdBarrier xcd_barrier_post(unsigned* bar, volatile LAS unsigned* st) {
    XcdBarrier b; b.bar = bar; b.x = xb_xcc_id(); b.st = st;
    if (threadIdx.x == 0) (void)xb_add(&bar[XB_XCNT(b.x)], 1u);
    return b;
}
__device__ __forceinline__ void xcd_barrier_complete(unsigned* bar, unsigned x, unsigned& nloc, unsigned& nx) {
    const unsigned G = gridDim.x * gridDim.y * gridDim.z;
    unsigned sum, cnt, mine, sp = 0u;
    for (;;) {
        sum = 0u; cnt = 0u; mine = 0u;
#pragma unroll
        for (unsigned j = 0; j < 16; ++j) { const unsigned c = xb_ld(&bar[XB_XCNT(j)]); sum += c; cnt += (c > 0u) ? 1u : 0u; mine = (j == x) ? c : mine; }
        if (sum == G) break;
        __builtin_amdgcn_s_sleep(1);
        if ((++sp & 255u) == 0u) { if (xb_ld(&bar[XB_TMO])) break; if (sp > XB_SPIN_CAP) { atomicAdd(&bar[XB_TMO], 1u); break; } }
    }
    nloc = mine > 0u ? mine : 1u; nx = cnt > 0u ? cnt : 1u;
}

__device__ __forceinline__ void xcd_barrier(const XcdBarrier& b) {
    asm volatile("s_waitcnt vmcnt(0)" ::: "memory");
    __syncthreads();
    if (threadIdx.x == 0) {
        unsigned* bar = b.bar;
        __builtin_amdgcn_s_waitcnt(0);
        unsigned nloc = b.st[0], nx = b.st[1];
        if (nloc == 0u) { xcd_barrier_complete(bar, b.x, nloc, nx); b.st[0] = nloc; b.st[1] = nx; }
        const unsigned old = xb_add(&bar[XB_XSUB(b.x)], 1u);
        const unsigned gen = old / nloc;
        if (old + 1u == (gen + 1u) * nloc) {
            __builtin_amdgcn_fence(__ATOMIC_RELEASE, "agent");
            asm volatile("s_waitcnt vmcnt(0)" ::: "memory");
            const unsigned og = xb_add(&bar[XB_TOP], 1u);
            const unsigned tg = og / nx;
            if (og + 1u == (tg + 1u) * nx) xb_add(&bar[XB_TOPGEN], 1u);
            else XB_SPIN(xb_ld(&bar[XB_TOPGEN]) == tg, bar);
            __builtin_amdgcn_fence(__ATOMIC_ACQUIRE, "agent");
            xb_add(&bar[XB_XGEN(b.x)], 1u);
            asm volatile("s_waitcnt vmcnt(0)" ::: "memory");
        } else {
            XB_SPIN(xb_ld(&bar[XB_XGEN(b.x)]) == gen, bar);
            __builtin_amdgcn_fence(__ATOMIC_ACQUIRE, "agent");
            asm volatile("s_waitcnt vmcnt(0)" ::: "memory");
        }
    }
    __syncthreads();
}

constexpr size_t MiB = 1u << 20;
constexpr size_t WS_CTL = 0, CTL_ZERO_BYTES = 64 * 1024;
constexpr size_t SZ_WGU = (size_t)5632 * 1024 * 2, SZ_WD = (size_t)1024 * 2816 * 2, SZ_WIN = (size_t)NPROJ * 1024 * 2, SZ_WOUT = (size_t)1024 * 1024 * 2;
constexpr size_t WS_WGU1 = 1 * MiB, WS_WD1 = WS_WGU1 + SZ_WGU, WS_WGU2 = WS_WD1 + SZ_WD, WS_WD2 = WS_WGU2 + SZ_WGU, WS_WIN = WS_WD2 + SZ_WD, WS_WOUT = WS_WIN + SZ_WIN;
constexpr size_t SZ_ACT = (size_t)M * 1024 * 2;
constexpr size_t WS_XN = WS_WOUT + SZ_WOUT, WS_MIX = WS_XN + SZ_ACT, WS_SS = WS_MIX + SZ_ACT;
constexpr size_t SZ_SS = (size_t)M * 16 * 4, SZ_SSW = (size_t)M * 8 * 4, SZ_ALR = (size_t)M * 16 * 4, SZ_G = (size_t)256 * 4 * 64 * 4;
constexpr size_t WS_SSW = WS_SS + SZ_SS, WS_ALR = WS_SSW + SZ_SSW, WS_G = WS_ALR + SZ_ALR, WS_R = WS_G + SZ_G;
constexpr size_t SZ_R = (size_t)M * 2816 * 2;
constexpr size_t R_QG = 0, R_KG = R_QG + (size_t)M * 256 * 2, R_VG = R_KG + (size_t)M * 256 * 2, R_RG = R_VG + (size_t)M * 512 * 2, R_QS = R_RG + (size_t)M * 512 * 2,
                 R_KVS = R_QS + (size_t)M * 512 * 2, R_CUM = R_KVS + (size_t)M * 256 * 2, R_END = R_CUM + (size_t)SEQ * 256 * 4;
static_assert(R_END <= SZ_R, "projection overlay fits inside H");
constexpr size_t WS_DS = WS_R + SZ_R, SZ_DS = (size_t)256 * 4 * 64 * 128 * 4, WS_END = WS_DS + SZ_DS;
static_assert(WS_END <= 256 * MiB, "d_ws map");
constexpr size_t O_Y = 0, O_SP = (size_t)M * 1024, O_CKP = O_SP + 32768, O_CVP = O_CKP + 16384, O_SS = O_CVP + 16384, O_CKS = O_SS + (size_t)DECB * 32768, O_CVS = O_CKS + (size_t)DECB * 16384,
                 O_END = O_CVS + (size_t)DECB * 16384;
constexpr int RING_BYTES = 131072, MISC_OFF = RING_BYTES + 320, LDS_BYTES = 147456;
constexpr int NWAVES = 8, NTHR = 512;

struct Args {
    const float* in[22]; float* out; unsigned char* ws; int ph_lo, ph_hi, bar_region, pad;
};
struct Ptrs {
    const float *x_p, *x_s, *state0, *ck_in, *cv_in, *g_ffn1, *wg1, *wu1, *wd1, *g_mix, *w_in, *w_gate_up, *b_gate, *g_head, *g_swa, *sinks, *w_out, *g_ffn2, *wg2, *wu2, *wd2, *g_final;
    float* out;
    bf16 *wgu1, *wd1t, *wgu2, *wd2t, *wint, *woutt, *xn, *mix, *hbuf, *qg, *kg, *vg, *rg, *qs, *kvs;
    float *ss, *ssw, *alr, *g, *cum, *ds;
};

__device__ __forceinline__ float bflo(unsigned w) { return __uint_as_float(w << 16); }
__device__ __forceinline__ float bfhi(unsigned w) { return __uint_as_float(w & 0xffff0000u); }
__device__ __forceinline__ float bf1(bf16 b) { return __uint_as_float((unsigned)b << 16); }
__device__ __forceinline__ float wave_sum(float v) {
#pragma unroll
    for (int o = 1; o < 64; o <<= 1) v += __shfl_xor(v, o);
    return v;
}
__device__ __forceinline__ float logsig(float x) { return fminf(x, 0.f) - log1pf(__expf(-fabsf(x))); }
__device__ __forceinline__ bf16x8 frag(const LAS bf16* base, int row0, int ld, int k0, int fr, int fq) { return *(const LAS bf16x8*)(base + (row0 + fr) * ld + k0 + 8 * fq); }
#define MFMA16(a, b, c) __builtin_amdgcn_mfma_f32_16x16x32_bf16((a), (b), (c), 0, 0, 0)

__device__ __forceinline__ int dest_row(int kind, int n) {
    if (kind == 0) return n;
    if (kind == 1) return 256 * (n >> 7) + (n & 127);
    if (kind == 2) return 256 * (n >> 7) + 128 + (n & 127);
    return n < 1536 ? n : (n < 1552 ? 2304 + (n - 1536) : n - 16);
}
__device__ __forceinline__ void p0_transpose_item(const float* W, int K, int N, bf16* WT, int kind, LAS float* scr, int item, int lane) {
    const int nblk = (N + 31) / 32, kb = item / nblk, nb = item % nblk, k0 = 64 * kb, n0 = 32 * nb;
    const int kr = lane >> 3, n4 = (lane & 7) * 4; const bool ok = n0 + n4 < N;
    f32x4 v[8];
#pragma unroll
    for (int i = 0; i < 8; ++i) v[i] = ok ? *(const GAS f32x4*)(W + (size_t)(k0 + 8 * i + kr) * N + n0 + n4) : (f32x4){0.f, 0.f, 0.f, 0.f};
#pragma unroll
    for (int i = 0; i < 8; ++i) { LAS float* d = scr + (8 * i + kr) * 33 + n4; d[0] = v[i].x; d[1] = v[i].y; d[2] = v[i].z; d[3] = v[i].w; }
    LDS_WAIT(); asm volatile("" ::: "memory");
    const int c = lane & 7;
#pragma unroll
    for (int j = 0; j < 4; ++j) { const int n = (lane >> 3) + 8 * j; const LAS float* s = scr + (8 * c) * 33 + n;
        v4u o; o.x = pk2(s[0 * 33], s[1 * 33]); o.y = pk2(s[2 * 33], s[3 * 33]); o.z = pk2(s[4 * 33], s[5 * 33]); o.w = pk2(s[6 * 33], s[7 * 33]);
        if (n0 + n < N) *(GAS v4u*)(WT + (size_t)dest_row(kind, n0 + n) * K + k0 + 8 * c) = o; }
    LDS_WAIT(); asm volatile("" ::: "memory");
}
__device__ __forceinline__ void p0_prologue(const Ptrs& P, LAS unsigned char* lds, int tid, int wave, int lane, int vcu, int G) {
    LAS float* scr = (LAS float*)(lds + wave * 16384);
    const int gw = vcu * NWAVES + wave, NGW = G * NWAVES;
    constexpr int I_GU = (1024 / 64) * (2816 / 32), I_D = (2816 / 64) * (1024 / 32), I_IN = (1024 / 64) * ((DIN + 31) / 32), I_O = (1024 / 64) * (1024 / 32);
    constexpr int NITEMS = 4 * I_GU + 2 * I_D + I_IN + I_O;
    for (int it = gw; it < NITEMS; it += NGW) {
        int r = it;
        if (r < I_GU) { p0_transpose_item(P.wg1, 1024, 2816, P.wgu1, 1, scr, r, lane); continue; } r -= I_GU;
        if (r < I_GU) { p0_transpose_item(P.wu1, 1024, 2816, P.wgu1, 2, scr, r, lane); continue; } r -= I_GU;
        if (r < I_D)  { p0_transpose_item(P.wd1, 2816, 1024, P.wd1t, 0, scr, r, lane); continue; } r -= I_D;
        if (r < I_GU) { p0_transpose_item(P.wg2, 1024, 2816, P.wgu2, 1, scr, r, lane); continue; } r -= I_GU;
        if (r < I_GU) { p0_transpose_item(P.wu2, 1024, 2816, P.wgu2, 2, scr, r, lane); continue; } r -= I_GU;
        if (r < I_D)  { p0_transpose_item(P.wd2, 2816, 1024, P.wd2t, 0, scr, r, lane); continue; } r -= I_D;
        if (r < I_IN) { p0_transpose_item(P.w_in, 1024, DIN, P.wint, 3, scr, r, lane); continue; } r -= I_IN;
        p0_transpose_item(P.w_out, 1024, 1024, P.woutt, 0, scr, r, lane);
    }
    for (int m0 = gw; m0 < M; m0 += 2 * NGW) {
        const int m1 = m0 + NGW; const bool has1 = m1 < M; const int m1c = has1 ? m1 : m0;
        const float* xrow0 = (m0 < SEQ) ? P.x_p + (size_t)m0 * D : P.x_s + (size_t)(m0 - SEQ) * D;
        const float* xrow1 = (m1c < SEQ) ? P.x_p + (size_t)m1c * D : P.x_s + (size_t)(m1c - SEQ) * D;
        const GAS f32x4* xr0 = (const GAS f32x4*)xrow0 + lane; const GAS f32x4* xr1 = (const GAS f32x4*)xrow1 + lane;
        f32x4 v[4], w[4]; float s0 = 0.f, s1 = 0.f;
#pragma unroll
        for (int j = 0; j < 4; ++j) { v[j] = xr0[64 * j]; w[j] = xr1[64 * j]; }
#pragma unroll
        for (int j = 0; j < 4; ++j) { s0 += (v[j].x * v[j].x + v[j].y * v[j].y) + (v[j].z * v[j].z + v[j].w * v[j].w); s1 += (w[j].x * w[j].x + w[j].y * w[j].y) + (w[j].z * w[j].z + w[j].w * w[j].w); }
        const float rs0 = rsqrtf(wave_sum(s0) * (1.f / D) + EPS), rs1 = rsqrtf(wave_sum(s1) * (1.f / D) + EPS);
        GAS unsigned long long* o0 = (GAS unsigned long long*)(P.xn + (size_t)m0 * D) + lane;
        GAS unsigned long long* o1 = (GAS unsigned long long*)(P.xn + (size_t)m1c * D) + lane;
#pragma unroll
        for (int j = 0; j < 4; ++j) { const f32x4 gg = *((const GAS f32x4*)P.g_ffn1 + lane + 64 * j);
            o0[64 * j] = (unsigned long long)pk2(v[j].x * rs0 * gg.x, v[j].y * rs0 * gg.y) | ((unsigned long long)pk2(v[j].z * rs0 * gg.z, v[j].w * rs0 * gg.w) << 32);
            if (has1) o1[64 * j] = (unsigned long long)pk2(w[j].x * rs1 * gg.x, w[j].y * rs1 * gg.y) | ((unsigned long long)pk2(w[j].z * rs1 * gg.z, w[j].w * rs1 * gg.w) << 32); }
    }
    {
        const int gt = vcu * NTHR + tid, NGT = G * NTHR;
        constexpr int PER_B = 124 * 128 / 4;
#pragma unroll 4
        for (int i = gt; i < 2 * DECB * PER_B; i += NGT) {
            const int which = i / (DECB * PER_B), r = i % (DECB * PER_B), b = r / PER_B, o = r % PER_B;
            const float* src = (which ? P.cv_in : P.ck_in) + (size_t)b * 16384 + 512 + 4 * o;
            float* dst = P.out + (which ? O_CVS : O_CKS) + (size_t)b * 16384 + 4 * o;
            *(f32x4*)dst = *(const f32x4*)src;
        }
    }
}

#define BAR_LDS() do { asm volatile("s_waitcnt lgkmcnt(0)" ::: "memory"); __builtin_amdgcn_s_barrier(); asm volatile("" ::: "memory"); } while (0)

struct GlRegs { f32x4 a; v4u kk; v4u vv[2]; float w[16]; float bg; };
__device__ __forceinline__ void gla_local_load(const Ptrs& P, int c, int h, int tid, GlRegs& R) {
    const int t0 = c * 64;
    { const int t = (tid & 255) >> 2, q = (tid & 3) * 4; R.a = *(const f32x4*)(P.alr + (size_t)(t0 + t) * 16 + q); }
    { const int j = tid >> 3, dc = tid & 7; R.kk = *(const v4u*)(P.kg + (size_t)(t0 + j) * 256 + 64 * h + 8 * dc); }
#pragma unroll
    for (int i = 0; i < 2; ++i) { const int q = tid + 512 * i, jj = q >> 4, cc = q & 15; R.vv[i] = *(const v4u*)(P.vg + (size_t)(t0 + jj) * 512 + 128 * h + 8 * cc); }
    const int d = tid & 63;
#pragma unroll
    for (int r = 0; r < 16; ++r) R.w[r] = P.w_gate_up[r * 256 + 64 * h + d];
    R.bg = P.b_gate[64 * h + d];
}
__device__ __forceinline__ void gla_local_unit(const Ptrs& P, LAS unsigned char* lds, int c, int h, int tid, int wave, int lane, const GlRegs& R) {
    LAS float* alrS = (LAS float*)(lds);
    LAS bf16* kS = (LAS bf16*)(lds + 4096);
    LAS float* segS = (LAS float*)(lds + 13312);
    LAS bf16* khT = (LAS bf16*)(lds + 15360);
    LAS bf16* vT = (LAS bf16*)(lds + 24576);
    const int t0 = c * 64, fr = lane & 15, fq = lane >> 4;
    if (tid < 256) { const int t = tid >> 2, q = (tid & 3) * 4; *(LAS f32x4*)(alrS + t * 16 + q) = R.a; }
    { const int j = tid >> 3, dc = tid & 7; *(LAS v4u*)(kS + j * 72 + 8 * dc) = R.kk; }
#pragma unroll
    for (int i = 0; i < 2; ++i) { const int q = tid + 512 * i, jj = q >> 4, cc = q & 15;
#pragma unroll
        for (int e = 0; e < 8; ++e) { const unsigned w = R.vv[i][e >> 1]; vT[(8 * cc + e) * 72 + jj] = (bf16)((e & 1) ? (w >> 16) : (w & 0xffffu)); } }
    BAR_LDS();
    const int d = tid & 63, seg = wave;
    float cum[8]; float run = 0.f;
#pragma unroll
    for (int i = 0; i < 8; ++i) { const LAS f32x4* ap = (const LAS f32x4*)(alrS + (8 * seg + i) * 16); float x = R.bg;
#pragma unroll
        for (int r4 = 0; r4 < 4; ++r4) { const f32x4 a = ap[r4]; x += (a[0] * R.w[4 * r4] + a[1] * R.w[4 * r4 + 1]) + (a[2] * R.w[4 * r4 + 2] + a[3] * R.w[4 * r4 + 3]); }
        run += logsig(x) * (1.0f / 16.0f); cum[i] = run; }
    segS[seg * 64 + d] = run;
    BAR_LDS();
    { float off = 0.f, last = 0.f;
#pragma unroll
      for (int s2 = 0; s2 < 8; ++s2) { const float v = segS[s2 * 64 + d]; last += v; off += (s2 < seg) ? v : 0.f; }
      unsigned pk[4];
#pragma unroll
      for (int i = 0; i < 8; i += 2) { const float ca = cum[i] + off, cb = cum[i + 1] + off;
          P.cum[(size_t)(t0 + 8 * seg + i) * 256 + 64 * h + d] = ca; P.cum[(size_t)(t0 + 8 * seg + i + 1) * 256 + 64 * h + d] = cb;
          pk[i >> 1] = pk2(bf1(kS[(8 * seg + i) * 72 + d]) * __expf(last - ca), bf1(kS[(8 * seg + i + 1) * 72 + d]) * __expf(last - cb)); }
      *(LAS v4u*)(khT + d * 72 + 8 * seg) = (v4u){pk[0], pk[1], pk[2], pk[3]};
      if (seg == 0) P.g[(size_t)(c * 4 + h) * 64 + d] = __expf(last); }
    BAR_LDS();
    { const int d0 = (wave & 3) * 16;
#pragma unroll
      for (int q = 0; q < 4; ++q) { const int dv0 = ((wave >> 2) * 4 + q) * 16; f32x4 acc = (f32x4){0.f, 0.f, 0.f, 0.f};
#pragma unroll
          for (int kk = 0; kk < 2; ++kk) acc = MFMA16(frag(vT, dv0, 72, 32 * kk, fr, fq), frag(khT, d0, 72, 32 * kk, fr, fq), acc);
          *(f32x4*)(P.ds + ((size_t)(c * 4 + h) * 64 + d0 + fr) * 128 + dv0 + 4 * fq) = acc; } }
}
__device__ __forceinline__ void gla_local_loop(const Ptrs& P, LAS unsigned char* lds, int first, int stride, int tid, int wave, int lane) {
    int u = first; if (u >= 1024) return;
    GlRegs R; gla_local_load(P, u >> 2, u & 3, tid, R);
    for (;;) {
        GlRegs C = R; const int un = u + stride; const bool more = un < 1024;
        if (more) gla_local_load(P, un >> 2, un & 3, tid, R);
        gla_local_unit(P, lds, u >> 2, u & 3, tid, wave, lane, C);
        BAR_LDS();
        if (!more) break; u = un;
    }
}

__device__ __forceinline__ void gla_sample_unit(const Ptrs& P, LAS unsigned char* lds, int b, int tid, int wave, int lane) {
    LAS float* cumS = (LAS float*)(lds);
    LAS float* qd = (LAS float*)(lds + 4096);
    LAS float* kd = (LAS float*)(lds + 8192);
    LAS float* ke = (LAS float*)(lds + 12288);
    LAS float* vS = (LAS float*)(lds + 16384);
    LAS float* attS = (LAS float*)(lds + 24576);
    LAS float* e3S = (LAS float*)(lds + 25088);
    const int r0 = SEQ + 4 * b;
#pragma unroll 1
    for (int i = 0; i < 2; ++i) { const int item = tid + 512 * i, t = item >> 8, col = item & 255; float x = P.b_gate[col];
#pragma unroll
        for (int r = 0; r < 16; ++r) x += P.alr[(size_t)(r0 + t) * 16 + r] * P.w_gate_up[r * 256 + col];
        cumS[t * 256 + col] = logsig(x) * (1.0f / 16.0f); }
    { const int t = tid >> 7, c4 = (tid & 127) * 4; const unsigned long long w = *(const unsigned long long*)(P.vg + (size_t)(r0 + t) * 512 + c4);
      vS[t * 512 + c4] = bflo((unsigned)w); vS[t * 512 + c4 + 1] = bfhi((unsigned)w); vS[t * 512 + c4 + 2] = bflo((unsigned)(w >> 32)); vS[t * 512 + c4 + 3] = bfhi((unsigned)(w >> 32)); }
    __syncthreads();
    if (tid < 256) { const int d = tid; const float c0 = cumS[d], c1 = c0 + cumS[256 + d], c2 = c1 + cumS[512 + d], c3 = c2 + cumS[768 + d];
        cumS[256 + d] = c1; cumS[512 + d] = c2; cumS[768 + d] = c3; e3S[d] = __expf(c3); }
    __syncthreads();
#pragma unroll 1
    for (int i = 0; i < 2; ++i) { const int item = tid + 512 * i, t = item >> 8, col = item & 255; const float cu = cumS[t * 256 + col], c3 = cumS[768 + col];
        const float q = bf1(P.qg[(size_t)(r0 + t) * 256 + col]), k = bf1(P.kg[(size_t)(r0 + t) * 256 + col]);
        qd[t * 256 + col] = q * __expf(cu); kd[t * 256 + col] = k * __expf(c3 - cu); ke[t * 256 + col] = k * __expf(-cu); }
    __syncthreads();
    { const int pr = tid >> 3, l8 = tid & 7, h = pr >> 4, i = (pr >> 2) & 3, j = pr & 3; float s = 0.f;
#pragma unroll
      for (int m = 0; m < 8; ++m) { const int col = 64 * h + l8 + 8 * m; s += qd[i * 256 + col] * ke[j * 256 + col]; }
      s += __shfl_xor(s, 1); s += __shfl_xor(s, 2); s += __shfl_xor(s, 4);
      if (l8 == 0) attS[pr] = (j <= i) ? s : 0.f; }
    __syncthreads();
    { const int h = tid >> 7, dv = tid & 127, c = 128 * h + dv;
      const float v0 = vS[c], v1 = vS[512 + c], v2 = vS[1024 + c], v3 = vS[1536 + c];
      float po[4] = {0.f, 0.f, 0.f, 0.f};
      const size_t sbase = ((size_t)(b * 4 + h) * 64) * 128 + dv;
#pragma unroll 1
      for (int d0 = 0; d0 < 64; d0 += 16) { float s0r[16];
#pragma unroll
          for (int dd = 0; dd < 16; ++dd) s0r[dd] = P.state0[sbase + (size_t)(d0 + dd) * 128];
#pragma unroll
          for (int dd = 0; dd < 16; ++dd) { const int col = 64 * h + d0 + dd; const float s0 = s0r[dd];
              P.out[O_SS + sbase + (size_t)(d0 + dd) * 128] = s0 * e3S[col] + ((kd[col] * v0 + kd[256 + col] * v1) + (kd[512 + col] * v2 + kd[768 + col] * v3));
              po[0] += qd[col] * s0; po[1] += qd[256 + col] * s0; po[2] += qd[512 + col] * s0; po[3] += qd[768 + col] * s0; } }
#pragma unroll
      for (int i = 0; i < 4; ++i) {
#pragma unroll
          for (int j = 0; j < 4; ++j) po[i] += attS[h * 16 + i * 4 + j] * ((j == 0) ? v0 : (j == 1) ? v1 : (j == 2) ? v2 : v3);
          const float sq = wave_sum(po[i] * po[i]); if (lane == 0) cumS[wave * 4 + i] = sq; }
      __syncthreads();
#pragma unroll
      for (int i = 0; i < 4; ++i) { const float tot = cumS[(2 * h) * 4 + i] + cumS[(2 * h + 1) * 4 + i];
          const float rs = rsqrtf(tot * (1.0f / 128.0f) + EPS);
          P.mix[(size_t)(r0 + i) * 1024 + c] = (bf16)f2bf(po[i] * rs * P.g_head[c] * bf1(P.rg[(size_t)(r0 + i) * 512 + c])); } }
    __syncthreads();
}

__device__ __forceinline__ void swa_sample_unit(const Ptrs& P, LAS unsigned char* lds, int b, int tid, int wave, int lane) {
    LAS float* qS = (LAS float*)(lds);
    LAS float* pS = (LAS float*)(lds + 8192);
    LAS float* kL = (LAS float*)(lds + 25600);
    LAS float* oP = (LAS float*)(lds + 93952);
    const int r0 = SEQ + 4 * b;
    { const int t = tid >> 7, c4 = (tid & 127) * 4;
      const unsigned long long w = *(const unsigned long long*)(P.qs + (size_t)(r0 + t) * 512 + c4);
      qS[t * 512 + c4] = bflo((unsigned)w); qS[t * 512 + c4 + 1] = bfhi((unsigned)w); qS[t * 512 + c4 + 2] = bflo((unsigned)(w >> 32)); qS[t * 512 + c4 + 3] = bfhi((unsigned)(w >> 32)); }
    { f32x4 kr[9];
#pragma unroll
      for (int i = 0; i < 9; ++i) { const int idx = tid + 512 * i, j = idx >> 5, c4 = (idx & 31) * 4;
          kr[i] = (f32x4){0.f, 0.f, 0.f, 0.f};
          if (idx < 4224) kr[i] = *(const f32x4*)((j < 128) ? P.ck_in + ((size_t)b * 128 + j) * 128 + c4 : P.out + O_CKS + ((size_t)b * 128 + 124 + (j - 128)) * 128 + c4); }
#pragma unroll
      for (int i = 0; i < 9; ++i) { const int idx = tid + 512 * i, j = idx >> 5, c4 = (idx & 31) * 4;
          if (idx < 4224) { LAS float* d = kL + j * 129 + c4; d[0] = kr[i].x; d[1] = kr[i].y; d[2] = kr[i].z; d[3] = kr[i].w; } } }
    __syncthreads();
    f32x4 vr[9];
#pragma unroll
    for (int i = 0; i < 9; ++i) { const int idx = tid + 512 * i, j = idx >> 5, c4 = (idx & 31) * 4;
        vr[i] = (f32x4){0.f, 0.f, 0.f, 0.f};
        if (idx < 4224) vr[i] = *(const f32x4*)((j < 128) ? P.cv_in + ((size_t)b * 128 + j) * 128 + c4 : P.out + O_CVS + ((size_t)b * 128 + 124 + (j - 128)) * 128 + c4); }
    if (tid < 264) {
        const int j = tid >> 1, kvh = tid & 1; float s[16];
#pragma unroll
        for (int i = 0; i < 16; ++i) s[i] = 0.f;
#pragma unroll 2
        for (int d = 0; d < 64; ++d) { const float kv = kL[j * 129 + 64 * kvh + d];
#pragma unroll
            for (int hl = 0; hl < 4; ++hl)
#pragma unroll
                for (int t = 0; t < 4; ++t) s[hl * 4 + t] += qS[t * 512 + 64 * (4 * kvh + hl) + d] * kv; }
#pragma unroll
        for (int hl = 0; hl < 4; ++hl)
#pragma unroll
            for (int t = 0; t < 4; ++t) { const bool valid = (j <= 128 + t) && (j >= t + 1); pS[((4 * kvh + hl) * 4 + t) * 136 + j] = valid ? s[hl * 4 + t] : -INFINITY; }
    }
    __syncthreads();
#pragma unroll
    for (int i = 0; i < 9; ++i) { const int idx = tid + 512 * i, j = idx >> 5, c4 = (idx & 31) * 4;
        if (idx < 4224) { LAS float* d = kL + j * 129 + c4; d[0] = vr[i].x; d[1] = vr[i].y; d[2] = vr[i].z; d[3] = vr[i].w; } }
    {
#pragma unroll 1
        for (int rr = 0; rr < 4; ++rr) { const int row = 4 * wave + rr, hh = row >> 2; const float sink = P.sinks[hh];
            float v0 = pS[row * 136 + lane], v1 = pS[row * 136 + 64 + lane], v2 = (lane < 4) ? pS[row * 136 + 128 + lane] : -INFINITY;
            float m = fmaxf(fmaxf(v0, v1), v2);
#pragma unroll
            for (int o = 1; o < 64; o <<= 1) m = fmaxf(m, __shfl_xor(m, o));
            m = fmaxf(m, sink);
            const float e0 = __expf(v0 - m), e1 = __expf(v1 - m), e2 = (lane < 4) ? __expf(v2 - m) : 0.f;
            const float den = wave_sum(e0 + e1 + e2) + __expf(sink - m), inv = 1.0f / den;
            pS[row * 136 + lane] = e0 * inv; pS[row * 136 + 64 + lane] = e1 * inv; if (lane < 4) pS[row * 136 + 128 + lane] = e2 * inv; }
    }
    __syncthreads();
    {
        const int part = tid >> 7, kvh = (tid >> 6) & 1, d = tid & 63; float o[16];
#pragma unroll
        for (int i = 0; i < 16; ++i) o[i] = 0.f;
#pragma unroll 1
        for (int jj = 0; jj < 33; ++jj) { const int j = part * 33 + jj; const float vv = kL[j * 129 + 64 * kvh + d];
#pragma unroll
            for (int hl = 0; hl < 4; ++hl)
#pragma unroll
                for (int t = 0; t < 4; ++t) o[hl * 4 + t] += pS[((4 * kvh + hl) * 4 + t) * 136 + j] * vv; }
#pragma unroll
        for (int hl = 0; hl < 4; ++hl)
#pragma unroll
            for (int t = 0; t < 4; ++t) oP[(part * 4 + t) * 512 + 64 * (4 * kvh + hl) + d] = o[hl * 4 + t];
    }
    __syncthreads();
    if (wave < 4) { const int t = wave; float v[8]; float sq = 0.f;
#pragma unroll
        for (int e = 0; e < 8; ++e) { const int c = lane + 64 * e; v[e] = (oP[(0 * 4 + t) * 512 + c] + oP[(1 * 4 + t) * 512 + c]) + (oP[(2 * 4 + t) * 512 + c] + oP[(3 * 4 + t) * 512 + c]); sq += v[e] * v[e]; }
        const float rs = rsqrtf(wave_sum(sq) * (1.0f / 512.0f) + EPS);
#pragma unroll
        for (int e = 0; e < 8; ++e) P.mix[(size_t)(r0 + t) * 1024 + 512 + lane + 64 * e] = (bf16)f2bf(v[e] * rs * P.g_swa[lane + 64 * e]); }
    __syncthreads();
}

__device__ __forceinline__ void gla_scan2(const Ptrs& P, LAS unsigned char* lds, int blk, int tid) {
    LAS float* As = (LAS float*)lds;
    LAS float* Ps = (LAS float*)(lds + 2048);
    const int seg = tid >> 6, el = tid & 63, e = blk * 64 + el, h = e >> 13, d = (e >> 7) & 63;
    float* dsp = P.ds + e + (size_t)(seg * 32) * 32768;
    const float* gp = P.g + h * 64 + d + (size_t)(seg * 32) * 256;
    float dsv[32], gv[32];
#pragma unroll
    for (int i = 0; i < 32; ++i) { dsv[i] = dsp[(size_t)i * 32768]; gv[i] = gp[(size_t)i * 256]; }
    float A = 0.f, Pm = 1.f;
#pragma unroll
    for (int i = 0; i < 32; ++i) { A = A * gv[i] + dsv[i]; Pm *= gv[i]; }
    As[seg * 64 + el] = A; Ps[seg * 64 + el] = Pm;
    __syncthreads();
    float S = 0.f;
    for (int s2 = 0; s2 < seg; ++s2) S = S * Ps[s2 * 64 + el] + As[s2 * 64 + el];
#pragma unroll
    for (int i = 0; i < 32; ++i) { dsp[(size_t)i * 32768] = S; S = S * gv[i] + dsv[i]; }
    if (seg == 7) P.out[O_SP + e] = S;
    __syncthreads();
}

struct SwRegs { v4u kk[3], vv[3], qq[2]; };
__device__ __forceinline__ void swa_prompt_load(const Ptrs& P, int qb, int g, int tid, SwRegs& R) {
    const int q0 = qb * 32, kbase = q0 - 128;
#pragma unroll
    for (int i = 0; i < 3; ++i) { const int q = tid + 512 * i, j = q >> 3, ch = q & 7, tok = kbase + j;
        R.kk[i] = (v4u){0u, 0u, 0u, 0u}; R.vv[i] = (v4u){0u, 0u, 0u, 0u};
        if (q < 1280 && tok >= 0) { const bf16* p = P.kvs + (size_t)tok * 256 + 64 * g + 8 * ch; R.kk[i] = *(const v4u*)p; R.vv[i] = *(const v4u*)(p + 128); } }
#pragma unroll
    for (int i = 0; i < 2; ++i) { const int q = tid + 512 * i, r = q >> 3, ch = q & 7, hl = r >> 5, ql = r & 31;
        R.qq[i] = *(const v4u*)(P.qs + (size_t)(q0 + ql) * 512 + 64 * (4 * g + hl) + 8 * ch); }
}
__device__ __forceinline__ void swa_prompt_unit(const Ptrs& P, LAS unsigned char* lds, int qb, int g, int tid, int wave, int lane, const SwRegs& R) {
    LAS bf16* Ks = (LAS bf16*)(lds);
    LAS bf16* VsT = (LAS bf16*)(lds + 23040);
    LAS bf16* Qs = (LAS bf16*)(lds + 44544);
    LAS bf16* Ps = (LAS bf16*)(lds + 62976);
    const int q0 = qb * 32, kbase = q0 - 128, fr = lane & 15, fq = lane >> 4;
#pragma unroll
    for (int i = 0; i < 3; ++i) { const int q = tid + 512 * i, j = q >> 3, ch = q & 7;
        if (q < 1280) { *(LAS v4u*)(Ks + j * 72 + 8 * ch) = R.kk[i];
#pragma unroll
            for (int e = 0; e < 8; ++e) { const unsigned w = R.vv[i][e >> 1]; VsT[(8 * ch + e) * 168 + j] = (bf16)((e & 1) ? (w >> 16) : (w & 0xffffu)); } } }
#pragma unroll
    for (int i = 0; i < 2; ++i) { const int q = tid + 512 * i, r = q >> 3, ch = q & 7; *(LAS v4u*)(Qs + r * 72 + 8 * ch) = R.qq[i]; }
    BAR_LDS();
    const int r0 = 16 * wave, head = 4 * g + (wave >> 1), ql0 = 16 * (wave & 1);
    const int qpos = q0 + ql0 + fr; const float sink = P.sinks[head];
    f32x4 s[10];
#pragma unroll
    for (int t = 0; t < 10; ++t) s[t] = (f32x4){0.f, 0.f, 0.f, 0.f};
#pragma unroll
    for (int kk = 0; kk < 2; ++kk) { const bf16x8 bq = frag(Qs, r0, 72, 32 * kk, fr, fq);
#pragma unroll
        for (int t = 0; t < 10; ++t) s[t] = MFMA16(frag(Ks, 16 * t, 72, 32 * kk, fr, fq), bq, s[t]); }
    float m = -INFINITY;
#pragma unroll
    for (int t = 0; t < 10; ++t)
#pragma unroll
        for (int r = 0; r < 4; ++r) { const int kpos = kbase + 16 * t + 4 * fq + r; const bool valid = (kpos >= 0) && (kpos <= qpos) && (qpos - kpos < 128);
            s[t][r] = valid ? s[t][r] : -INFINITY; m = fmaxf(m, s[t][r]); }
    m = fmaxf(m, __shfl_xor(m, 16)); m = fmaxf(m, __shfl_xor(m, 32)); m = fmaxf(m, sink);
    float sum = 0.f;
#pragma unroll
    for (int t = 0; t < 10; ++t)
#pragma unroll
        for (int r = 0; r < 4; ++r) { const float p = __expf(s[t][r] - m); s[t][r] = p; sum += p; }
    sum += __shfl_xor(sum, 16); sum += __shfl_xor(sum, 32);
    const float inv = 1.0f / (sum + __expf(sink - m));
#pragma unroll
    for (int t = 0; t < 10; ++t) { unsigned long long w = (unsigned long long)pk2(s[t][0] * inv, s[t][1] * inv) | ((unsigned long long)pk2(s[t][2] * inv, s[t][3] * inv) << 32);
        *(LAS unsigned long long*)(Ps + (r0 + fr) * 168 + 16 * t + 4 * fq) = w; }
    asm volatile("s_waitcnt lgkmcnt(0)" ::: "memory");
    f32x4 o[4];
#pragma unroll
    for (int dt = 0; dt < 4; ++dt) o[dt] = (f32x4){0.f, 0.f, 0.f, 0.f};
#pragma unroll
    for (int ks = 0; ks < 5; ++ks) { const bf16x8 bp = frag(Ps, r0, 168, 32 * ks, fr, fq);
#pragma unroll
        for (int dt = 0; dt < 4; ++dt) o[dt] = MFMA16(frag(VsT, 16 * dt, 168, 32 * ks, fr, fq), bp, o[dt]); }
    float sq = 0.f;
#pragma unroll
    for (int dt = 0; dt < 4; ++dt) sq += (o[dt][0] * o[dt][0] + o[dt][1] * o[dt][1]) + (o[dt][2] * o[dt][2] + o[dt][3] * o[dt][3]);
    sq += __shfl_xor(sq, 16); sq += __shfl_xor(sq, 32);
    if (fq == 0) P.ssw[(size_t)qpos * 8 + head] = sq;
#pragma unroll
    for (int dt = 0; dt < 4; ++dt) { const unsigned long long w = (unsigned long long)pk2(o[dt][0], o[dt][1]) | ((unsigned long long)pk2(o[dt][2], o[dt][3]) << 32);
        *(unsigned long long*)(P.mix + (size_t)qpos * 1024 + 512 + 64 * head + 16 * dt + 4 * fq) = w; }
}
__device__ __forceinline__ void swa_prompt_loop(const Ptrs& P, LAS unsigned char* lds, int first, int stride, int tid, int wave, int lane) {
    int u = first; if (u >= 1024) return;
    SwRegs R; swa_prompt_load(P, u >> 1, u & 1, tid, R);
    for (;;) {
        SwRegs C = R; const int un = u + stride; const bool more = un < 1024;
        if (more) swa_prompt_load(P, un >> 1, un & 1, tid, R);
        swa_prompt_unit(P, lds, u >> 1, u & 1, tid, wave, lane, C);
        BAR_LDS();
        if (!more) break; u = un;
    }
}

struct GoRegs { v4u qq, kk; f32x4 c0, c1; v4u vv[2]; f32x4 sv[4]; };
struct GoEpi { v4u r0, r1, a0, a1; f32x4 sa, sb; };
__device__ __forceinline__ void gla_out_load(const Ptrs& P, int c, int h, int tid, GoRegs& R) {
    const int t0 = c * 64, j = tid >> 3, dc = tid & 7;
    R.qq = *(const v4u*)(P.qg + (size_t)(t0 + j) * 256 + 64 * h + 8 * dc); R.kk = *(const v4u*)(P.kg + (size_t)(t0 + j) * 256 + 64 * h + 8 * dc);
    const float* cp = P.cum + (size_t)(t0 + j) * 256 + 64 * h + 8 * dc; R.c0 = *(const f32x4*)cp; R.c1 = *(const f32x4*)(cp + 4);
#pragma unroll
    for (int i = 0; i < 2; ++i) { const int q = tid + 512 * i, jj = q >> 4, cc = q & 15; R.vv[i] = *(const v4u*)(P.vg + (size_t)(t0 + jj) * 512 + 128 * h + 8 * cc); }
#pragma unroll
    for (int i = 0; i < 4; ++i) { const int q = tid + 512 * i, d = q >> 5, dv4 = (q & 31) * 4; R.sv[i] = *(const f32x4*)(P.ds + ((size_t)(c * 4 + h) * 64 + d) * 128 + dv4); }
}
__device__ __forceinline__ void gla_out_load_epi(const Ptrs& P, int c, int h, int tid, GoEpi& E) {
    const int i = tid >> 3, seg = tid & 7, tok = c * 64 + i, col = 128 * h + 16 * seg;
    E.r0 = *(const v4u*)(P.rg + (size_t)tok * 512 + col); E.r1 = *(const v4u*)(P.rg + (size_t)tok * 512 + col + 8);
    const bf16* mp = P.mix + (size_t)tok * 1024 + 512 + col; E.a0 = *(const v4u*)mp; E.a1 = *(const v4u*)(mp + 8);
    E.sa = *(const f32x4*)(P.ssw + (size_t)tok * 8); E.sb = *(const f32x4*)(P.ssw + (size_t)tok * 8 + 4);
}
__device__ __forceinline__ void gla_out_unit(const Ptrs& P, LAS unsigned char* lds, int c, int h, int tid, int wave, int lane, const GoRegs& R, const GoEpi& E) {
    LAS bf16* qT = (LAS bf16*)(lds);
    LAS bf16* kT = (LAS bf16*)(lds + 9216);
    LAS bf16* vT = (LAS bf16*)(lds + 18432);
    LAS bf16* sT = (LAS bf16*)(lds + 36864);
    LAS bf16* aS = (LAS bf16*)(lds + 55296);
    LAS float* oS = (LAS float*)(lds + 64512);
    const int t0 = c * 64, fr = lane & 15, fq = lane >> 4;
    { const int j = tid >> 3, dc = tid & 7;
      float cu[8] = {R.c0[0], R.c0[1], R.c0[2], R.c0[3], R.c1[0], R.c1[1], R.c1[2], R.c1[3]}; v4u qo, ko;
#pragma unroll
      for (int e2 = 0; e2 < 4; ++e2) { const float ea = __expf(cu[2 * e2]), eb = __expf(cu[2 * e2 + 1]);
          qo[e2] = pk2(bflo(R.qq[e2]) * ea, bfhi(R.qq[e2]) * eb); ko[e2] = pk2(bflo(R.kk[e2]) / ea, bfhi(R.kk[e2]) / eb); }
      *(LAS v4u*)(qT + j * 72 + 8 * dc) = qo; *(LAS v4u*)(kT + j * 72 + 8 * dc) = ko;
#pragma unroll
      for (int i = 0; i < 2; ++i) { const int q = tid + 512 * i, jj = q >> 4, cc = q & 15;
#pragma unroll
          for (int e = 0; e < 8; ++e) { const unsigned w = R.vv[i][e >> 1]; vT[(8 * cc + e) * 72 + jj] = (bf16)((e & 1) ? (w >> 16) : (w & 0xffffu)); } }
#pragma unroll
      for (int i = 0; i < 4; ++i) { const int q = tid + 512 * i, d = q >> 5, dv4 = (q & 31) * 4;
#pragma unroll
          for (int e = 0; e < 4; ++e) sT[(dv4 + e) * 72 + d] = (bf16)f2bf(R.sv[i][e]); } }
    BAR_LDS();
    { const int i0 = (wave >> 1) * 16;
#pragma unroll
      for (int q = 0; q < 2; ++q) { const int j0 = ((wave & 1) * 2 + q) * 16; f32x4 acc = (f32x4){0.f, 0.f, 0.f, 0.f};
#pragma unroll
          for (int kk = 0; kk < 2; ++kk) acc = MFMA16(frag(kT, j0, 72, 32 * kk, fr, fq), frag(qT, i0, 72, 32 * kk, fr, fq), acc);
          const int i = i0 + fr, jb = j0 + 4 * fq;
          const unsigned long long w = (unsigned long long)pk2(jb <= i ? acc[0] : 0.f, jb + 1 <= i ? acc[1] : 0.f) | ((unsigned long long)pk2(jb + 2 <= i ? acc[2] : 0.f, jb + 3 <= i ? acc[3] : 0.f) << 32);
          *(LAS unsigned long long*)(aS + i * 72 + jb) = w; } }
    BAR_LDS();
    { const int i0 = (wave & 3) * 16;
#pragma unroll
      for (int q = 0; q < 4; ++q) { const int dv0 = ((wave >> 2) * 4 + q) * 16; f32x4 acc = (f32x4){0.f, 0.f, 0.f, 0.f};
#pragma unroll
          for (int kk = 0; kk < 2; ++kk) { acc = MFMA16(frag(vT, dv0, 72, 32 * kk, fr, fq), frag(aS, i0, 72, 32 * kk, fr, fq), acc);
                                           acc = MFMA16(frag(sT, dv0, 72, 32 * kk, fr, fq), frag(qT, i0, 72, 32 * kk, fr, fq), acc); }
          *(LAS f32x4*)(oS + (i0 + fr) * 132 + dv0 + 4 * fq) = acc; } }
    BAR_LDS();
    { const int i = tid >> 3, seg = tid & 7, tok = t0 + i, col = 128 * h + 16 * seg;
      f32x4 ov[4]; float sq = 0.f;
#pragma unroll
      for (int e = 0; e < 4; ++e) { ov[e] = *(const LAS f32x4*)(oS + i * 132 + 16 * seg + 4 * e); sq += (ov[e][0] * ov[e][0] + ov[e][1] * ov[e][1]) + (ov[e][2] * ov[e][2] + ov[e][3] * ov[e][3]); }
      sq += __shfl_xor(sq, 1); sq += __shfl_xor(sq, 2); sq += __shfl_xor(sq, 4);
      const float rs = rsqrtf(sq * (1.0f / 128.0f) + EPS);
      v4u w0, w1;
#pragma unroll
      for (int e2 = 0; e2 < 4; ++e2) { const int cc = col + 2 * e2;
          w0[e2] = pk2(ov[e2 >> 1][(2 * e2) & 3] * rs * P.g_head[cc] * bflo(E.r0[e2]), ov[e2 >> 1][(2 * e2 + 1) & 3] * rs * P.g_head[cc + 1] * bfhi(E.r0[e2]));
          w1[e2] = pk2(ov[2 + (e2 >> 1)][(2 * e2) & 3] * rs * P.g_head[cc + 8] * bflo(E.r1[e2]), ov[2 + (e2 >> 1)][(2 * e2 + 1) & 3] * rs * P.g_head[cc + 9] * bfhi(E.r1[e2])); }
      *(v4u*)(P.mix + (size_t)tok * 1024 + col) = w0; *(v4u*)(P.mix + (size_t)tok * 1024 + col + 8) = w1;
      const float rs2 = rsqrtf((((E.sa[0] + E.sa[1]) + (E.sa[2] + E.sa[3])) + ((E.sb[0] + E.sb[1]) + (E.sb[2] + E.sb[3]))) * (1.0f / 512.0f) + EPS);
      bf16* mp = P.mix + (size_t)tok * 1024 + 512 + col; v4u b0, b1;
#pragma unroll
      for (int e2 = 0; e2 < 4; ++e2) { const int cc = col + 2 * e2;
          b0[e2] = pk2(bflo(E.a0[e2]) * rs2 * P.g_swa[cc], bfhi(E.a0[e2]) * rs2 * P.g_swa[cc + 1]);
          b1[e2] = pk2(bflo(E.a1[e2]) * rs2 * P.g_swa[cc + 8], bfhi(E.a1[e2]) * rs2 * P.g_swa[cc + 9]); }
      *(v4u*)mp = b0; *(v4u*)(mp + 8) = b1; }
}
__device__ __forceinline__ void gla_out_loop(const Ptrs& P, LAS unsigned char* lds, int first, int stride, int tid, int wave, int lane) {
    int u = first; if (u >= 1024) return;
    GoRegs R; GoEpi E; gla_out_load(P, u >> 2, u & 3, tid, R); gla_out_load_epi(P, u >> 2, u & 3, tid, E);
    for (;;) {
        GoRegs C = R; const int un = u + stride; const bool more = un < 1024;
        if (more) gla_out_load(P, un >> 2, un & 3, tid, R);
        gla_out_unit(P, lds, u >> 2, u & 3, tid, wave, lane, C, E);
        if (more) gla_out_load_epi(P, un >> 2, un & 3, tid, E);
        BAR_LDS();
        if (!more) break; u = un;
    }
}

__device__ __forceinline__ void final_norm_prompt(const Ptrs& P, int wave, int lane, int bidx, int nb) {
    const int gw = bidx * NWAVES + wave, NGW = nb * NWAVES;
    f32x4 gg[4];
#pragma unroll
    for (int j = 0; j < 4; ++j) gg[j] = *((const GAS f32x4*)P.g_final + lane + 64 * j);
    for (int m0 = gw; m0 < SEQ; m0 += 4 * NGW) {
        f32x4 v[4][4]; float rs[4]; int mm[4];
#pragma unroll
        for (int r = 0; r < 4; ++r) { const int m = m0 + r * NGW; mm[r] = m < SEQ ? m : m0;
            const GAS f32x4* xr = (const GAS f32x4*)(P.out + (size_t)mm[r] * D) + lane;
#pragma unroll
            for (int j = 0; j < 4; ++j) v[r][j] = xr[64 * j]; }
#pragma unroll
        for (int r = 0; r < 4; ++r) rs[r] = pg8::row_rs16(P.ss, mm[r]);
#pragma unroll
        for (int r = 0; r < 4; ++r) { if (r > 0 && m0 + r * NGW >= SEQ) continue;
            GAS f32x4* xw = (GAS f32x4*)(P.out + (size_t)mm[r] * D) + lane;
#pragma unroll
            for (int j = 0; j < 4; ++j) xw[64 * j] = v[r][j] * rs[r] * gg[j]; }
    }
}
__device__ __forceinline__ void final_sample(const Ptrs& P, const float* slabs, int wave, int lane, int vcu, int G) {
    const int gw = vcu * NWAVES + wave, NGW = G * NWAVES;
    for (int r = gw; r < NSAMP; r += NGW) {
        GAS f32x4* xr = (GAS f32x4*)(P.out + (size_t)(SEQ + r) * D) + lane;
        f32x4 v[4]; float s = 0.f;
#pragma unroll
        for (int j = 0; j < 4; ++j) { const GAS f32x4* sp = (const GAS f32x4*)(slabs + (size_t)r * D) + lane + 64 * j;
            const f32x4 a = (sp[0] + sp[(size_t)NSAMP * D / 4]) + (sp[(size_t)2 * NSAMP * D / 4] + sp[(size_t)3 * NSAMP * D / 4]);
            v[j] = xr[64 * j] + a * 0.5f; s += (v[j].x * v[j].x + v[j].y * v[j].y) + (v[j].z * v[j].z + v[j].w * v[j].w); }
        const float rs = rsqrtf(wave_sum(s) * (1.f / D) + EPS);
#pragma unroll
        for (int j = 0; j < 4; ++j) { const f32x4 gg = *((const GAS f32x4*)P.g_final + lane + 64 * j); xr[64 * j] = v[j] * rs * gg; }
    }
}

#ifndef PROBE_REP_HI
#define PROBE_REP_HI (-1)
#endif
#ifndef MK_N_LAUNCHES
#define MK_N_LAUNCHES 1
#endif
constexpr int N_PHASES = 12;
__global__ void __launch_bounds__(NTHR, 2) hymba_fwd(Args args) {
    extern __shared__ __attribute__((aligned(16))) unsigned char lds_raw[];
    LAS unsigned char* lds = (LAS unsigned char*)lds_raw;
    volatile LAS unsigned* MISC = (volatile LAS unsigned*)(lds + MISC_OFF);
    const int tid = threadIdx.x, lane = tid & 63, wave = __builtin_amdgcn_readfirstlane(tid >> 6);
    const int G = gridDim.x, bx = blockIdx.x, vcu = (G % 8 == 0) ? (bx % 8) * (G / 8) + bx / 8 : bx;
    unsigned char* ws = args.ws;
    Ptrs P;
    P.x_p = args.in[0]; P.x_s = args.in[1]; P.state0 = args.in[2]; P.ck_in = args.in[3]; P.cv_in = args.in[4]; P.g_ffn1 = args.in[5]; P.wg1 = args.in[6]; P.wu1 = args.in[7]; P.wd1 = args.in[8];
    P.g_mix = args.in[9]; P.w_in = args.in[10]; P.w_gate_up = args.in[11]; P.b_gate = args.in[12]; P.g_head = args.in[13]; P.g_swa = args.in[14]; P.sinks = args.in[15]; P.w_out = args.in[16];
    P.g_ffn2 = args.in[17]; P.wg2 = args.in[18]; P.wu2 = args.in[19]; P.wd2 = args.in[20]; P.g_final = args.in[21];
    P.out = args.out;
    P.wgu1 = (bf16*)(ws + WS_WGU1); P.wd1t = (bf16*)(ws + WS_WD1); P.wgu2 = (bf16*)(ws + WS_WGU2); P.wd2t = (bf16*)(ws + WS_WD2); P.wint = (bf16*)(ws + WS_WIN); P.woutt = (bf16*)(ws + WS_WOUT);
    P.xn = (bf16*)(ws + WS_XN); P.mix = (bf16*)(ws + WS_MIX); P.hbuf = (bf16*)(ws + WS_R);
    P.qg = (bf16*)(ws + WS_R + R_QG); P.kg = (bf16*)(ws + WS_R + R_KG); P.vg = (bf16*)(ws + WS_R + R_VG); P.rg = (bf16*)(ws + WS_R + R_RG); P.qs = (bf16*)(ws + WS_R + R_QS); P.kvs = (bf16*)(ws + WS_R + R_KVS);
    P.cum = (float*)(ws + WS_R + R_CUM);
    P.ss = (float*)(ws + WS_SS); P.ssw = (float*)(ws + WS_SSW); P.alr = (float*)(ws + WS_ALR); P.g = (float*)(ws + WS_G); P.ds = (float*)(ws + WS_DS);

    for (int u = tid; u < (LDS_BYTES - RING_BYTES) / 4; u += NTHR) ((LAS unsigned*)(lds + RING_BYTES))[u] = 0u;
    __syncthreads();
    const int lo = args.ph_lo, hi = args.ph_hi;
    unsigned* barw = (unsigned*)(ws + WS_CTL) + args.bar_region * XCD_BAR_WORDS;
    XcdBarrier bar; bar.bar = barw; bar.x = 0; bar.st = nullptr;
    if (hi - lo > 1) bar = xcd_barrier_post(barw, MISC + 8);
#define IN(k) (lo <= (k) && (k) < hi)
#define SEAM(k) do { if (IN(k) && IN((k) + 1)) xcd_barrier(bar); } while (0)

    if (IN(0)) p0_prologue(P, lds, tid, wave, lane, vcu, G);
    SEAM(0);
    if (IN(1)) { pg8::Gemm g{P.xn, P.wgu1, M, 5632, 1024, 1024}; pg8::StaticOrder S; S.init(M, 5632, G, bx); pg8::EpiGU E{P.hbuf, nullptr};
        pg8::gemm_phase<pg8::EpiGU, pg8::StaticOrder, true, true>(lds, g, S, E); }
    SEAM(1);
    if (IN(2)) { pg8::Gemm g{P.hbuf, P.wd1t, M, 1024, 2816, 2816}; pg8::SubOrder S; S.init(64, 1024, 0, G, 0, bx); pg8::EpiRes E{P.x_p, P.x_s, P.out, P.xn, P.g_mix, P.ss, 0.5f};
        pg8::gemm_phase<pg8::EpiRes, pg8::SubOrder, true, true>(lds, g, S, E); }
    SEAM(2);
    if (IN(3)) {
        if (bx < G - 8) { pg8::Gemm g{P.xn, P.wint, M, NPROJ, 1024, 1024}; pg8::SubOrder S; S.init(64, NPROJ, 0, G - 8, 0, bx);
            pg8::EpiProj E{P.ss, P.qg, P.kg, P.vg, P.rg, P.qs, P.kvs, P.alr, P.out + O_CKP, P.out + O_CVP, P.out + O_CKS, P.out + O_CVS};
            pg8::gemm_phase<pg8::EpiProj, pg8::SubOrder, true, true>(lds, g, S, E); }
        else { pg8::Gemm g{P.hbuf, P.wd1t, M, 1024, 2816, 2816}; pg8::SubOrder S; S.init(2, 1024, G - 8, 8, 64, bx); pg8::EpiRes E{P.x_p, P.x_s, P.out, P.xn, P.g_mix, P.ss, 0.5f};
            pg8::gemm_phase<pg8::EpiRes, pg8::SubOrder, true, true>(lds, g, S, E); }
    }
    SEAM(3);
    if (IN(4)) {
        if (bx < G - 20) { gla_local_loop(P, lds, bx, G - 20, tid, wave, lane); swa_prompt_loop(P, lds, bx, G - 20, tid, wave, lane); }
        else { pg8::Gemm g{P.xn, P.wint, M, NPROJ, 1024, 1024}; pg8::SubOrder S; S.init(2, NPROJ, G - 20, 20, 64, bx);
            pg8::EpiProj E{P.ss, P.qg, P.kg, P.vg, P.rg, P.qs, P.kvs, P.alr, P.out + O_CKP, P.out + O_CVP, P.out + O_CKS, P.out + O_CVS};
            pg8::gemm_phase<pg8::EpiProj, pg8::SubOrder, true, true>(lds, g, S, E); }
    }
    SEAM(4);
    if (IN(5)) {
        for (int sb = bx; sb < 512; sb += G) gla_scan2(P, lds, sb, tid);
        for (int u = bx; u < 128; u += G) swa_sample_unit(P, lds, u, tid, wave, lane);
        for (int u = bx; u < 256; u += G) if (u >= 128) gla_sample_unit(P, lds, u - 128, tid, wave, lane);
    }
    SEAM(5);
    if (IN(6)) {
        if (bx < G - 8) gla_out_loop(P, lds, bx, G - 8, tid, wave, lane);
        else { pg8::Gemm g{P.mix, P.woutt, M, 1024, 1024, 1024}; pg8::SubOrder S; S.init(2, 1024, G - 8, 8, 64, bx); pg8::EpiRes E{P.out, P.out + (size_t)SEQ * 1024, P.out, P.xn, P.g_ffn2, P.ss, 1.0f};
            pg8::gemm_phase<pg8::EpiRes, pg8::SubOrder, true, true>(lds, g, S, E); }
    }
    SEAM(6);
    if (IN(7)) { pg8::Gemm g{P.mix, P.woutt, M, 1024, 1024, 1024}; pg8::SubOrder S; S.init(64, 1024, 0, G, 0, bx); pg8::EpiRes E{P.out, P.out + (size_t)SEQ * 1024, P.out, P.xn, P.g_ffn2, P.ss, 1.0f};
        pg8::gemm_phase<pg8::EpiRes, pg8::SubOrder, true, true>(lds, g, S, E); }
    SEAM(7);
    if (IN(8)) { pg8::Gemm g{P.xn, P.wgu2, M, 5632, 1024, 1024}; pg8::StaticOrder S; S.init(M, 5632, G, bx); pg8::EpiGU E{P.hbuf, P.ss};
        pg8::gemm_phase<pg8::EpiGU, pg8::StaticOrder, true, true>(lds, g, S, E); }
    SEAM(8);
    if (IN(9)) { pg8::Gemm g{P.hbuf, P.wd2t, M, 1024, 2816, 2816}; pg8::SubOrder S; S.init(64, 1024, 0, G, 0, bx); pg8::EpiRes E{P.out, P.out + (size_t)SEQ * 1024, P.out, nullptr, nullptr, P.ss, 0.5f};
        pg8::gemm_phase<pg8::EpiRes, pg8::SubOrder, true, true>(lds, g, S, E); }
    SEAM(9);
    if (IN(10)) {
        if (bx < G - 32) final_norm_prompt(P, wave, lane, bx, G - 32);
        else { const int j = bx - (G - 32), ks = j >> 3, tile = j & 7;
            const int koff = ks < 2 ? 768 * ks : 1536 + 640 * (ks - 2), klen = ks < 2 ? 768 : 640;
            pg8::Gemm g{P.hbuf + koff, P.wd2t + koff, M, 1024, klen, 2816}; pg8::OneUnit S; S.u0.pm = 64 + (tile & 1); S.u0.pn = tile >> 1; S.on = true;
            pg8::EpiPartial E{P.ds + (size_t)ks * NSAMP * 1024};
            pg8::gemm_phase<pg8::EpiPartial, pg8::OneUnit, true, true>(lds, g, S, E); }
    }
    SEAM(10);
    if (IN(11)) final_sample(P, P.ds, wave, lane, vcu, G);
#undef IN
#undef SEAM
}

extern "C" void kernel_launch(void* const* d_in, const int* in_sizes, int n_in, void* d_out, int out_size, void* d_ws, size_t ws_size, hipStream_t stream) {
    static int grid = 0;
    if (grid == 0) {
        if (n_in != 22 || (size_t)out_size != O_END || ws_size < WS_END) { fprintf(stderr, "kernel_launch: unexpected shapes (n_in %d, out %d, ws %zu); nothing launched\n", n_in, out_size, ws_size); grid = -1; return; }
        int dev = 0, cus = 0, per_cu = 0;
        if (hipGetDevice(&dev) != hipSuccess || hipDeviceGetAttribute(&cus, hipDeviceAttributeMultiprocessorCount, dev) != hipSuccess) { grid = -1; return; }
        if (hipFuncSetAttribute((const void*)hymba_fwd, hipFuncAttributeMaxDynamicSharedMemorySize, LDS_BYTES) != hipSuccess) { fprintf(stderr, "kernel_launch: hipFuncSetAttribute failed\n"); grid = -1; return; }
        if (hipOccupancyMaxActiveBlocksPerMultiprocessor(&per_cu, (const void*)hymba_fwd, NTHR, LDS_BYTES) != hipSuccess || per_cu < 1) { fprintf(stderr, "kernel_launch: occupancy query says %d blocks per CU\n", per_cu); (void)hipGetLastError(); grid = -1; return; }
        grid = cus;
    }
    if (grid < 0) return;
    if (hipMemsetAsync((char*)d_ws + WS_CTL, 0, CTL_ZERO_BYTES, stream) != hipSuccess) return;
    Args a{};
    for (int i = 0; i < 22; ++i) a.in[i] = (const float*)d_in[i];
    a.out = (float*)d_out; a.ws = (unsigned char*)d_ws;
#if MK_N_LAUNCHES == 1
    void* kargs[] = {&a};
#if PROBE_REP_HI >= 0
    a.ph_lo = 0; a.ph_hi = PROBE_REP_HI + 1; a.bar_region = 1;
    (void)hipLaunchCooperativeKernel((const void*)hymba_fwd, dim3(grid), dim3(NTHR), kargs, LDS_BYTES, stream);
#endif
    a.ph_lo = 0; a.ph_hi = N_PHASES; a.bar_region = 0;
    hipError_t e = hipLaunchCooperativeKernel((const void*)hymba_fwd, dim3(grid), dim3(NTHR), kargs, LDS_BYTES, stream);
    if (e != hipSuccess) fprintf(stderr, "kernel_launch: cooperative launch failed: %s (grid %d)\n", hipGetErrorString(e), grid);
#else
    for (int p = 0; p < N_PHASES; ++p) { a.ph_lo = p; a.ph_hi = p + 1; hipLaunchKernelGGL(hymba_fwd, dim3(grid), dim3(NTHR), LDS_BYTES, stream, a); }
#endif
}
```

```cpp
#include <hip/hip_runtime.h>
#include <hip/hip_cooperative_groups.h>
#include <cstdio>
#include <cstdint>
namespace cg = cooperative_groups;

constexpr int D = 1024, SEQ = 16384, NSAMP = 512, M = SEQ + NSAMP, FF = 2816, DIN = 2320, NPROJ = 2560;
constexpr int DECB = 128, DECT = 4;
constexpr float EPS = 1e-6f;
namespace pg8 {
#define PG8_LAS __attribute__((address_space(3)))
typedef unsigned short bf16_t;
typedef short bf16x8 __attribute__((ext_vector_type(8)));
typedef float f32x4 __attribute__((ext_vector_type(4)));
typedef unsigned u32x4 __attribute__((ext_vector_type(4)));
constexpr int BM = 256, BK = 64, HALF = 128, HTB = HALF * BK * 2  , STAGE_BYTES = 8 * HTB, NXCD = 8, WGM = 8;

__host__ __device__ __forceinline__ int lds_byte(int r, int c) { const int st = (r >> 4) * 2 + (c >> 5), rr = r & 15, cc = c & 31, ob = rr * 64 + cc * 2; return st * 1024 + (ob ^ (((ob >> 9) & 1) << 5)); }
__host__ __device__ __forceinline__ void stage_rc(int b, int& R, int& C) { const int st = b / 1024, sb = b % 1024, swz = sb ^ (((sb >> 9) & 1) << 5); R = (st >> 1) * 16 + swz / 64; C = (st & 1) * 32 + (swz % 64) / 2; }
__host__ __device__ __forceinline__ int perm32(int rho) { const int n = rho >> 4, i = rho & 15; return 8 * (i >> 2) + 4 * n + (i & 3); }

struct Unit { int pm, pn; };
struct Gemm { const bf16_t* A; const bf16_t* Bt; int M, N, K, ld; };

struct StaticOrder {
    int nM, nN, nwg, G, c;
    __host__ __device__ void init(int M, int N, int G_, int c_) { nM = M / BM; nN = N / BM; nwg = nM * nN; G = G_; c = c_; }
    __host__ __device__ bool next(int i, Unit& u) const {
        const long L = (long)i * G + c; if (L >= nwg) return false;
        int wgid = (int)L; { const int q = nwg / NXCD, r = nwg % NXCD, xcd = wgid % NXCD, off = wgid / NXCD; wgid = (xcd < r ? xcd * (q + 1) : r * (q + 1) + (xcd - r) * q) + off; }
        const int nig = WGM * nN, gid = wgid / nig, fm = gid * WGM, gsz = (nM - fm) < WGM ? (nM - fm) : WGM;
        u.pm = fm + ((wgid % nig) % gsz); u.pn = (wgid % nig) / gsz; return true;
    }
    __device__ __forceinline__ void a_ready(const Unit&) const {}
    __device__ __forceinline__ void done(const Unit&) const {}
};

__device__ __forceinline__ unsigned cvt_pk_bf16(float lo, float hi) { unsigned r; asm volatile("v_cvt_pk_bf16_f32 %0, %1, %2" : "=v"(r) : "v"(lo), "v"(hi)); return r; }
typedef float f32x2 __attribute__((ext_vector_type(2)));
__device__ __forceinline__ float row_rs16(const float* ss, int row) {
    const f32x4* p = (const f32x4*)(ss + (size_t)row * 16);
    const f32x4 t = (p[0] + p[1]) + (p[2] + p[3]);
    return rsqrtf(((t[0] + t[1]) + (t[2] + t[3])) * (1.0f / 1024.0f) + 1e-6f);
}
__device__ __forceinline__ float silu_f(float g) { return g * __builtin_amdgcn_rcpf(1.0f + __builtin_amdgcn_exp2f(-1.4426950408889634f * g)); }

struct EpiGU {
    static constexpr bool PERM = true, AFTER_DRAIN = false;
    bf16_t* H; const float* ss;
    __device__ __forceinline__ void operator()(const f32x4 (&acc)[2][2][4][2], const Unit& u, int wr, int wc, int fr, int fq) const {
        const int row0 = u.pm * BM + wr * 64 + fr;
        const int col0 = u.pn * 128 + wc * 32 + 8 * fq;
#pragma unroll
        for (int ai = 0; ai < 2; ++ai)
#pragma unroll
            for (int m = 0; m < 4; ++m) {
                const int row = row0 + ai * HALF + m * 16;
                float rs = 1.0f;
                if (ss) rs = row_rs16(ss, row);
                float h[8];
#pragma unroll
                for (int n = 0; n < 2; ++n)
#pragma unroll
                    for (int e = 0; e < 4; ++e) { const float g = acc[ai][0][m][n][e] * rs, up = acc[ai][1][m][n][e] * rs; h[4 * n + e] = silu_f(g) * up; }
                u32x4 w; w.x = cvt_pk_bf16(h[0], h[1]); w.y = cvt_pk_bf16(h[2], h[3]); w.z = cvt_pk_bf16(h[4], h[5]); w.w = cvt_pk_bf16(h[6], h[7]);
                *(u32x4*)(H + (size_t)row * 2816 + col0) = w;
            }
    }
};

struct EpiRes {
    static constexpr bool PERM = true, AFTER_DRAIN = false;
    bf16_t* xb; float* ss; float scale;
    __device__ __forceinline__ void operator()(const f32x4 (&acc)[2][2][4][2], const Unit& u, int wr, int wc, int fr, int fq) const {
        const int row0 = u.pm * BM + wr * 64 + fr;
        const int col0 = u.pn * BM + wc * 32 + 8 * fq;
#pragma unroll
        for (int ai = 0; ai < 2; ++ai)
#pragma unroll
            for (int m = 0; m < 4; ++m) {
                const int row = row0 + ai * HALF + m * 16;
                bf16_t* rp = xb + (size_t)row * 1024 + col0;
                float sq = 0.f;
#pragma unroll
                for (int bj = 0; bj < 2; ++bj) {
                    const u32x4 r = *(const u32x4*)(rp + bj * HALF);
                    const f32x4 r0 = (f32x4){__uint_as_float(r.x << 16), __uint_as_float(r.x & 0xffff0000u), __uint_as_float(r.y << 16), __uint_as_float(r.y & 0xffff0000u)};
                    const f32x4 r1 = (f32x4){__uint_as_float(r.z << 16), __uint_as_float(r.z & 0xffff0000u), __uint_as_float(r.w << 16), __uint_as_float(r.w & 0xffff0000u)};
                    const f32x4 v0 = r0 + acc[ai][bj][m][0] * scale, v1 = r1 + acc[ai][bj][m][1] * scale;
                    sq += (v0[0] * v0[0] + v0[1] * v0[1]) + (v0[2] * v0[2] + v0[3] * v0[3]);
                    sq += (v1[0] * v1[0] + v1[1] * v1[1]) + (v1[2] * v1[2] + v1[3] * v1[3]);
                    u32x4 w; w.x = cvt_pk_bf16(v0[0], v0[1]); w.y = cvt_pk_bf16(v0[2], v0[3]); w.z = cvt_pk_bf16(v1[0], v1[1]); w.w = cvt_pk_bf16(v1[2], v1[3]);
                    *(u32x4*)(rp + bj * HALF) = w;
                }
                sq += __shfl_xor(sq, 16); sq += __shfl_xor(sq, 32);
                if (fq == 0) ss[(size_t)row * 16 + u.pn * 4 + wc] = sq;
            }
    }
};

struct EpiProj {
    static constexpr bool PERM = true, AFTER_DRAIN = false;
    const float* ss; bf16_t *qg, *kg, *vg, *rg, *qs, *kvs; float* alr; float *ckp, *cvp, *cks, *cvs;
    __device__ __forceinline__ void operator()(const f32x4 (&acc)[2][2][4][2], const Unit& u, int wr, int wc, int fr, int fq) const {
        const int row0 = u.pm * BM + wr * 64 + fr;
        const int pn = u.pn;
#pragma unroll
        for (int ai = 0; ai < 2; ++ai)
#pragma unroll
            for (int m = 0; m < 4; ++m) {
                const int row = row0 + ai * HALF + m * 16;
                const float rs = row_rs16(ss, row);
#pragma unroll
                for (int bj = 0; bj < 2; ++bj) {
                    const int cl = bj * HALF + wc * 32 + 8 * fq;
                    f32x4 v0 = acc[ai][bj][m][0] * rs, v1 = acc[ai][bj][m][1] * rs;
                    if (pn == 9) {
                        if (cl < 16) { float* p = alr + (size_t)row * 16 + cl; *(f32x4*)p = v0; *(f32x4*)(p + 4) = v1; }
                        continue;
                    }
                    bf16_t* dst;
                    if (pn == 0) { dst = qg + (size_t)row * 256 + cl; v0 = v0 * 0.125f; v1 = v1 * 0.125f; }
                    else if (pn == 1) { dst = kg + (size_t)row * 256 + cl; }
                    else if (pn < 4) { dst = vg + (size_t)row * 512 + (pn - 2) * 256 + cl; }
                    else if (pn < 6) { dst = rg + (size_t)row * 512 + (pn - 4) * 256 + cl;
#pragma unroll
                        for (int e = 0; e < 4; ++e) { v0[e] = silu_f(v0[e]); v1[e] = silu_f(v1[e]); } }
                    else if (pn < 8) { dst = qs + (size_t)row * 512 + (pn - 6) * 256 + cl; v0 = v0 * 0.125f; v1 = v1 * 0.125f; }
                    else { dst = kvs + (size_t)row * 256 + cl;
                        float* cp = nullptr;
                        if (row >= 16384) { const int sr = row - 16384; cp = (bj ? cvs : cks) + ((size_t)(sr >> 2) * 128 + 124 + (sr & 3)) * 128 + (cl & 127); }
                        else if (row >= 16384 - 128) { cp = (bj ? cvp : ckp) + (size_t)(row - (16384 - 128)) * 128 + (cl & 127); }
                        if (cp) { *(f32x4*)cp = v0; *(f32x4*)(cp + 4) = v1; }
                    }
                    u32x4 w; w.x = cvt_pk_bf16(v0[0], v0[1]); w.y = cvt_pk_bf16(v0[2], v0[3]); w.z = cvt_pk_bf16(v1[0], v1[1]); w.w = cvt_pk_bf16(v1[2], v1[3]);
                    *(u32x4*)dst = w;
                }
            }
    }
};

struct EpiPartial {
    static constexpr bool PERM = true, AFTER_DRAIN = false;
    float* slab;
    __device__ __forceinline__ void operator()(const f32x4 (&acc)[2][2][4][2], const Unit& u, int wr, int wc, int fr, int fq) const {
        const int row0 = (u.pm - 64) * BM + wr * 64 + fr;
        const int col0 = u.pn * BM + wc * 32 + 8 * fq;
#pragma unroll
        for (int ai = 0; ai < 2; ++ai)
#pragma unroll
            for (int m = 0; m < 4; ++m) { float* rp = slab + (size_t)(row0 + ai * HALF + m * 16) * 1024 + col0;
#pragma unroll
                for (int bj = 0; bj < 2; ++bj) { *(f32x4*)(rp + bj * HALF) = acc[ai][bj][m][0]; *(f32x4*)(rp + bj * HALF + 4) = acc[ai][bj][m][1]; } }
    }
};
struct SubOrder {
    StaticOrder S; int pm0; bool on;
    __device__ __forceinline__ void init(int nMp, int N, int b0, int nb, int pm0_, int bx) { on = (bx >= b0) && (bx < b0 + nb); S.init(nMp * BM, N, nb, on ? bx - b0 : 0); pm0 = pm0_; }
    __device__ __forceinline__ bool next(int i, Unit& u) const { if (!on) return false; if (!S.next(i, u)) return false; u.pm += pm0; return true; }
    __device__ __forceinline__ void a_ready(const Unit&) const {}
    __device__ __forceinline__ void done(const Unit&) const {}
};
struct OneUnit {
    Unit u0; bool on;
    __device__ __forceinline__ bool next(int i, Unit& u) const { if (!on || i != 0) return false; u = u0; return true; }
    __device__ __forceinline__ void a_ready(const Unit&) const {}
    __device__ __forceinline__ void done(const Unit&) const {}
};
template <class Epi, class Sched, bool ALIGN_EPI = false, bool SP2 = false>
__device__ __forceinline__ void gemm_phase(PG8_LAS unsigned char* lds, const Gemm g, const Sched& S, const Epi& E) {
    const int tid = threadIdx.x, wid = __builtin_amdgcn_readfirstlane(tid >> 6), lane = tid & 63, wr = wid >> 2, wc = wid & 3, fr = lane & 15, fq = lane >> 4;
    const int K = g.ld, nt = g.K / BK;
    unsigned voffA[2], voffB[2];
#pragma unroll
    for (int i = 0; i < 2; ++i) { int R, C; stage_rc(tid * 16 + i * 8192, R, C); const int Rb = Epi::PERM ? ((R & ~31) + perm32(R & 31)) : R;
        voffA[i] = (unsigned)(R * K + C) * 2u; voffB[i] = (unsigned)(Rb * K + C) * 2u; }
    const size_t kstep = (size_t)(BK * 2);
    const size_t hstep = (size_t)HALF * K * 2;
    const size_t tstep = 2 * hstep;
    const unsigned ldsw = (unsigned)wid * 1024u;
    const int aoff = lds_byte(wr * 64 + fr, fq * 8), boff = lds_byte(wc * 32 + fr, fq * 8);
#define PG8_SA(b, h) (((b) * 2 + (h)) * HTB)
#define PG8_SB(b, h) ((4 + (b) * 2 + (h)) * HTB)
#define PG8_STAGE(bufoff, gbase, voff) do { _Pragma("unroll") for (int _i = 0; _i < 2; ++_i) \
        __builtin_amdgcn_global_load_lds((const unsigned*)((const char*)(gbase) + (voff)[_i]), (PG8_LAS unsigned*)(lds + (bufoff) + ldsw + _i * 8192), 16, 0, 0); } while (0)
#define PG8_LDA(dst, b, h) do { _Pragma("unroll") for (int m = 0; m < 4; ++m) _Pragma("unroll") for (int k = 0; k < 2; ++k) dst[m][k] = *(const PG8_LAS bf16x8*)(lds + PG8_SA(b, h) + aoff + m * 2048 + k * 1024); } while (0)
#define PG8_LDB(dst, b, h) do { _Pragma("unroll") for (int n = 0; n < 2; ++n) _Pragma("unroll") for (int k = 0; k < 2; ++k) dst[n][k] = *(const PG8_LAS bf16x8*)(lds + PG8_SB(b, h) + boff + n * 2048 + k * 1024); } while (0)
#define PG8_MMA(ai, bj, At, Bt) do { __builtin_amdgcn_s_setprio(1); _Pragma("unroll") for (int m = 0; m < 4; ++m) _Pragma("unroll") for (int n = 0; n < 2; ++n) _Pragma("unroll") for (int k = 0; k < 2; ++k) \
        acc[ai][bj][m][n] = __builtin_amdgcn_mfma_f32_16x16x32_bf16(Bt[n][k], At[m][k], acc[ai][bj][m][n], 0, 0, 0); __builtin_amdgcn_s_setprio(0); } while (0)
#define PG8_WAIT_V(n) asm volatile("s_waitcnt vmcnt(" #n ")" ::: "memory")
#define PG8_WAIT_L(n) asm volatile("s_waitcnt lgkmcnt(" #n ")" ::: "memory")
#define PG8_BAR __builtin_amdgcn_s_barrier()
#define PG8_SCHED __builtin_amdgcn_sched_barrier(0)
    Unit cur, nxt; int ui = 0;
    if (!S.next(0, cur)) return;
    f32x4 acc[2][2][4][2];
#pragma unroll
    for (int a = 0; a < 2; ++a)
#pragma unroll
        for (int b = 0; b < 2; ++b)
#pragma unroll
            for (int m = 0; m < 4; ++m)
#pragma unroll
                for (int n = 0; n < 2; ++n) acc[a][b][m][n] = (f32x4){0.f, 0.f, 0.f, 0.f};
    bf16x8 At[4][2], B0[2][2], B1[2][2];
    const char* cA = (const char*)g.A + (size_t)cur.pm * tstep; const char* cB = (const char*)g.Bt + (size_t)cur.pn * tstep;
    S.a_ready(cur);
    if constexpr (SP2) {
        PG8_STAGE(PG8_SB(0, 0), cB, voffB); PG8_STAGE(PG8_SB(0, 1), cB + hstep, voffB); PG8_STAGE(PG8_SA(0, 0), cA, voffA); PG8_STAGE(PG8_SA(0, 1), cA + hstep, voffA);
        if (wr == 1) PG8_BAR;
        PG8_WAIT_V(2); PG8_BAR;
        PG8_STAGE(PG8_SB(1, 0), cB + kstep, voffB); PG8_STAGE(PG8_SA(1, 0), cA + kstep, voffA); PG8_STAGE(PG8_SB(1, 1), cB + hstep + kstep, voffB);
        PG8_WAIT_V(6); PG8_BAR;
    } else {
        PG8_STAGE(PG8_SB(0, 0), cB, voffB); PG8_STAGE(PG8_SA(0, 0), cA, voffA); PG8_STAGE(PG8_SB(0, 1), cB + hstep, voffB); PG8_STAGE(PG8_SA(0, 1), cA + hstep, voffA);
        if (wr == 1) PG8_BAR;
        PG8_WAIT_V(4); PG8_BAR;
        PG8_STAGE(PG8_SB(1, 0), cB + kstep, voffB); PG8_STAGE(PG8_SA(1, 0), cA + kstep, voffA); PG8_STAGE(PG8_SB(1, 1), cB + hstep + kstep, voffB);
        PG8_WAIT_V(6); PG8_BAR;
    }
    for (;;) {
        const bool has_next = S.next(ui + 1, nxt);
        const char* nA = has_next ? (const char*)g.A + (size_t)nxt.pm * tstep : cA; const char* nB = has_next ? (const char*)g.Bt + (size_t)nxt.pn * tstep : cB;
        for (int t = 0; t < nt; t += 2) {
            const bool last = (t == nt - 2);
            const char* a1 = cA + (size_t)(t + 1) * kstep;
            const char* a2 = last ? nA : cA + (size_t)(t + 2) * kstep; const char* b2 = last ? nB : cB + (size_t)(t + 2) * kstep;
            const char* a3 = a2 + kstep; const char* b3 = b2 + kstep;
            if (last && has_next) S.a_ready(nxt);
            if constexpr (SP2) {
            PG8_LDB(B0, 0, 0); PG8_LDB(B1, 0, 1); PG8_SCHED; PG8_LDA(At, 0, 0); PG8_STAGE(PG8_SA(1, 1), a1 + hstep, voffA);
            PG8_WAIT_V(8); PG8_WAIT_L(0); PG8_BAR; PG8_MMA(0, 0, At, B0); PG8_MMA(0, 1, At, B1); PG8_BAR; PG8_SCHED;
            PG8_LDA(At, 0, 1); PG8_STAGE(PG8_SB(0, 0), b2, voffB); PG8_STAGE(PG8_SB(0, 1), b2 + hstep, voffB); PG8_STAGE(PG8_SA(0, 0), a2, voffA);
            PG8_WAIT_V(8); PG8_WAIT_L(0); PG8_BAR; PG8_MMA(1, 0, At, B0); PG8_MMA(1, 1, At, B1); PG8_BAR; PG8_SCHED;
            PG8_LDB(B0, 1, 0); PG8_LDB(B1, 1, 1); PG8_SCHED; PG8_LDA(At, 1, 0); PG8_STAGE(PG8_SA(0, 1), a2 + hstep, voffA);
            PG8_WAIT_V(8); PG8_WAIT_L(0); PG8_BAR; PG8_MMA(0, 0, At, B0); PG8_MMA(0, 1, At, B1); PG8_BAR; PG8_SCHED;
            PG8_LDA(At, 1, 1); PG8_STAGE(PG8_SB(1, 0), b3, voffB); PG8_STAGE(PG8_SB(1, 1), b3 + hstep, voffB); PG8_STAGE(PG8_SA(1, 0), a3, voffA);
            PG8_WAIT_V(8); PG8_WAIT_L(0); PG8_BAR; PG8_MMA(1, 0, At, B0); PG8_MMA(1, 1, At, B1); PG8_BAR; PG8_SCHED;
            } else {
            PG8_LDB(B0, 0, 0); PG8_SCHED; PG8_LDA(At, 0, 0); PG8_STAGE(PG8_SA(1, 1), a1 + hstep, voffA);
            PG8_WAIT_L(8); PG8_BAR; PG8_WAIT_L(0); PG8_MMA(0, 0, At, B0); PG8_BAR; PG8_SCHED;
            PG8_LDB(B1, 0, 1); PG8_STAGE(PG8_SB(0, 0), b2, voffB);
            PG8_BAR; PG8_WAIT_L(0); PG8_MMA(0, 1, At, B1); PG8_BAR;
            PG8_LDA(At, 0, 1); PG8_STAGE(PG8_SA(0, 0), a2, voffA);
            PG8_BAR; PG8_WAIT_L(0); PG8_MMA(1, 0, At, B0); PG8_BAR; PG8_SCHED;
            PG8_STAGE(PG8_SB(0, 1), b2 + hstep, voffB);
            PG8_WAIT_V(6); PG8_BAR; PG8_MMA(1, 1, At, B1); PG8_BAR;
            PG8_LDB(B0, 1, 0); PG8_SCHED; PG8_LDA(At, 1, 0); PG8_STAGE(PG8_SA(0, 1), a2 + hstep, voffA);
            PG8_WAIT_L(8); PG8_BAR; PG8_WAIT_L(0); PG8_MMA(0, 0, At, B0); PG8_BAR; PG8_SCHED;
            PG8_LDB(B1, 1, 1); PG8_STAGE(PG8_SB(1, 0), b3, voffB);
            PG8_BAR; PG8_WAIT_L(0); PG8_MMA(0, 1, At, B1); PG8_BAR;
            PG8_LDA(At, 1, 1); PG8_STAGE(PG8_SA(1, 0), a3, voffA);
            PG8_BAR; PG8_WAIT_L(0); PG8_MMA(1, 0, At, B0); PG8_BAR; PG8_SCHED;
            PG8_STAGE(PG8_SB(1, 1), b3 + hstep, voffB);
            PG8_WAIT_V(6); PG8_BAR; PG8_MMA(1, 1, At, B1); PG8_BAR;
            }
        }
        if constexpr (ALIGN_EPI) { if (wr == 0) PG8_BAR; }
        if constexpr (!Epi::AFTER_DRAIN) { E(acc, cur, wr, wc, fr, fq); S.done(cur); }
        if (!has_next) break;
#pragma unroll
        for (int a = 0; a < 2; ++a)
#pragma unroll
            for (int b = 0; b < 2; ++b)
#pragma unroll
                for (int m = 0; m < 4; ++m)
#pragma unroll
                    for (int n = 0; n < 2; ++n) acc[a][b][m][n] = (f32x4){0.f, 0.f, 0.f, 0.f};
        cur = nxt; cA = nA; cB = nB; ++ui;
        if constexpr (ALIGN_EPI) { if (wr == 1) PG8_BAR; }
    }
    PG8_WAIT_V(0);
    if constexpr (!ALIGN_EPI) { if (wr == 0) PG8_BAR; }
    PG8_BAR;
    if constexpr (Epi::AFTER_DRAIN) { E.fused(acc, cur, wr, wc, fr, fq, lds, wid, lane); S.done(cur); }
#undef PG8_SA
#undef PG8_SB
#undef PG8_STAGE
#undef PG8_LDA
#undef PG8_LDB
#undef PG8_MMA
#undef PG8_WAIT_V
#undef PG8_WAIT_L
#undef PG8_BAR
#undef PG8_SCHED
}
}
#define GAS __attribute__((address_space(1)))
#define LAS __attribute__((address_space(3)))
typedef unsigned short bf16;
typedef unsigned v4u __attribute__((ext_vector_type(4)));
typedef float f32x4 __attribute__((ext_vector_type(4)));
typedef short bf16x8 __attribute__((ext_vector_type(8)));
typedef GAS unsigned gu32;
typedef GAS unsigned long long gu64;
#define RLX_AGENT __ATOMIC_RELAXED, __HIP_MEMORY_SCOPE_AGENT
#define LDS_WAIT() asm volatile("s_waitcnt lgkmcnt(0)" ::: "memory")
#define VM_WAIT() asm volatile("s_waitcnt vmcnt(0)" ::: "memory")
__device__ __forceinline__ unsigned long long rt() { return __builtin_amdgcn_s_memrealtime(); }
__device__ __forceinline__ unsigned f2bf(float f) { unsigned u = __builtin_bit_cast(unsigned, f); return (u + 0x7fffu + ((u >> 16) & 1u)) >> 16; }
__device__ __forceinline__ unsigned pk2(float lo, float hi) { return f2bf(lo) | (f2bf(hi) << 16); }

#define XB_TMO      128
#define XB_XCNT(j)  (256  + 64 * (j))
#define XB_XSUB(j)  (1280 + 64 * (j))
#define XB_XGEN(j)  (2304 + 64 * (j))
#define XB_TOP      3328
#define XB_TOPGEN   3392
#define XCD_BAR_WORDS 3456
#define XB_SPIN_CAP (1u << 18)

__device__ __forceinline__ unsigned xb_ld(unsigned* p)              { return __hip_atomic_load(p, __ATOMIC_RELAXED, __HIP_MEMORY_SCOPE_AGENT); }
__device__ __forceinline__ unsigned xb_add(unsigned* p, unsigned v) { return __hip_atomic_fetch_add(p, v, __ATOMIC_RELAXED, __HIP_MEMORY_SCOPE_AGENT); }
__device__ __forceinline__ unsigned xb_xcc_id() { return (unsigned)__builtin_amdgcn_s_getreg((3 << 11) | 20) & 0xFu; }
#define XB_SPIN(cond, bar) do { unsigned _sp = 0; while (cond) { __builtin_amdgcn_s_sleep(1); \
    if ((++_sp & 255u) == 0u) { if (xb_ld(&(bar)[XB_TMO])) break; if (_sp > XB_SPIN_CAP) { atomicAdd(&(bar)[XB_TMO], 1u); break; } } } } while (0)

struct XcdBarrier {
    unsigned* bar; unsigned x;
    volatile LAS unsigned* st;
};

__device__ __forceinline__ XcdBarrier xcd_barrier_post(unsigned* bar, volatile LAS unsigned* st) {
    XcdBarrier b; b.bar = bar; b.x = xb_xcc_id(); b.st = st;
    if (threadIdx.x == 0) (void)xb_add(&bar[XB_XCNT(b.x)], 1u);
    return b;
}
__device__ __forceinline__ void xcd_barrier_complete(unsigned* bar, unsigned x, unsigned& nloc, unsigned& nx) {
    const unsigned G = gridDim.x * gridDim.y * gridDim.z;
    unsigned sum, cnt, mine, sp = 0u;
    for (;;) {
        sum = 0u; cnt = 0u; mine = 0u;
#pragma unroll
        for (unsigned j = 0; j < 16; ++j) { const unsigned c = xb_ld(&bar[XB_XCNT(j)]); sum += c; cnt += (c > 0u) ? 1u : 0u; mine = (j == x) ? c : mine; }
        if (sum == G) break;
        __builtin_amdgcn_s_sleep(1);
        if ((++sp & 255u) == 0u) { if (xb_ld(&bar[XB_TMO])) break; if (sp > XB_SPIN_CAP) { atomicAdd(&bar[XB_TMO], 1u); break; } }
    }
    nloc = mine > 0u ? mine : 1u; nx = cnt > 0u ? cnt : 1u;
}

__device__ __forceinline__ void xcd_barrier(const XcdBarrier& b) {
    asm volatile("s_waitcnt vmcnt(0)" ::: "memory");
    __syncthreads();
    if (threadIdx.x == 0) {
        unsigned* bar = b.bar;
        __builtin_amdgcn_s_waitcnt(0);
        unsigned nloc = b.st[0], nx = b.st[1];
        if (nloc == 0u) { xcd_barrier_complete(bar, b.x, nloc, nx); b.st[0] = nloc; b.st[1] = nx; }
        const unsigned old = xb_add(&bar[XB_XSUB(b.x)], 1u);
        const unsigned gen = old / nloc;
        if (old + 1u == (gen + 1u) * nloc) {
            __builtin_amdgcn_fence(__ATOMIC_RELEASE, "agent");
            asm volatile("s_waitcnt vmcnt(0)" ::: "memory");
            const unsigned og = xb_add(&bar[XB_TOP], 1u);
            const unsigned tg = og / nx;
            if (og + 1u == (tg + 1u) * nx) xb_add(&bar[XB_TOPGEN], 1u);
            else XB_SPIN(xb_ld(&bar[XB_TOPGEN]) == tg, bar);
            __builtin_amdgcn_fence(__ATOMIC_ACQUIRE, "agent");
            xb_add(&bar[XB_XGEN(b.x)], 1u);
            asm volatile("s_waitcnt vmcnt(0)" ::: "memory");
        } else {
            XB_SPIN(xb_ld(&bar[XB_XGEN(b.x)]) == gen, bar);
            __builtin_amdgcn_fence(__ATOMIC_ACQUIRE, "agent");
            asm volatile("s_waitcnt vmcnt(0)" ::: "memory");
        }
    }
    __syncthreads();
}

constexpr size_t MiB = 1u << 20;
constexpr size_t WS_CTL = 0, CTL_ZERO_BYTES = 64 * 1024;
constexpr size_t SZ_WGU = (size_t)5632 * 1024 * 2, SZ_WD = (size_t)1024 * 2816 * 2, SZ_WIN = (size_t)NPROJ * 1024 * 2, SZ_WOUT = (size_t)1024 * 1024 * 2;
constexpr size_t WS_WGU1 = 1 * MiB, WS_WD1 = WS_WGU1 + SZ_WGU, WS_WGU2 = WS_WD1 + SZ_WD, WS_WD2 = WS_WGU2 + SZ_WGU, WS_WIN = WS_WD2 + SZ_WD, WS_WOUT = WS_WIN + SZ_WIN;
constexpr size_t SZ_ACT = (size_t)M * 1024 * 2;
constexpr size_t WS_XN = WS_WOUT + SZ_WOUT, WS_MIX = WS_XN + SZ_ACT, WS_SS = WS_MIX + SZ_ACT;
constexpr size_t SZ_SS = (size_t)M * 16 * 4, SZ_SSW = (size_t)M * 8 * 4, SZ_ALR = (size_t)M * 16 * 4, SZ_G = (size_t)256 * 4 * 64 * 4;
constexpr size_t WS_SSW = WS_SS + SZ_SS, WS_ALR = WS_SSW + SZ_SSW, WS_G = WS_ALR + SZ_ALR, WS_R = WS_G + SZ_G;
constexpr size_t SZ_R = (size_t)M * 2816 * 2;
constexpr size_t R_QG = 0, R_KG = R_QG + (size_t)M * 256 * 2, R_VG = R_KG + (size_t)M * 256 * 2, R_RG = R_VG + (size_t)M * 512 * 2, R_QS = R_RG + (size_t)M * 512 * 2,
                 R_KVS = R_QS + (size_t)M * 512 * 2, R_CUM = R_KVS + (size_t)M * 256 * 2, R_END = R_CUM + (size_t)SEQ * 256 * 4;
static_assert(R_END <= SZ_R, "projection overlay fits inside H");
constexpr size_t WS_DS = WS_R + SZ_R, SZ_DS = (size_t)256 * 4 * 64 * 128 * 4, WS_END = WS_DS + SZ_DS;
static_assert(WS_END <= 256 * MiB, "d_ws map");
constexpr size_t O_Y = 0, O_SP = (size_t)M * 1024, O_CKP = O_SP + 32768, O_CVP = O_CKP + 16384, O_SS = O_CVP + 16384, O_CKS = O_SS + (size_t)DECB * 32768, O_CVS = O_CKS + (size_t)DECB * 16384,
                 O_END = O_CVS + (size_t)DECB * 16384;
constexpr int RING_BYTES = 131072, MISC_OFF = RING_BYTES + 320, LDS_BYTES = 147456;
constexpr int NWAVES = 8, NTHR = 512;

struct Args {
    const float* in[22]; float* out; unsigned char* ws; int ph_lo, ph_hi, bar_region, pad;
};
struct Ptrs {
    const float *x_p, *x_s, *state0, *ck_in, *cv_in, *g_ffn1, *wg1, *wu1, *wd1, *g_mix, *w_in, *w_gate_up, *b_gate, *g_head, *g_swa, *sinks, *w_out, *g_ffn2, *wg2, *wu2, *wd2, *g_final;
    float* out;
    bf16 *wgu1, *wd1t, *wgu2, *wd2t, *wint, *woutt, *xn, *mix, *hbuf, *qg, *kg, *vg, *rg, *qs, *kvs;
    float *ss, *ssw, *alr, *g, *cum, *ds;
};

__device__ __forceinline__ float bflo(unsigned w) { return __uint_as_float(w << 16); }
__device__ __forceinline__ float bfhi(unsigned w) { return __uint_as_float(w & 0xffff0000u); }
__device__ __forceinline__ float bf1(bf16 b) { return __uint_as_float((unsigned)b << 16); }
__device__ __forceinline__ float wave_sum(float v) {
#pragma unroll
    for (int o = 1; o < 64; o <<= 1) v += __shfl_xor(v, o);
    return v;
}
__device__ __forceinline__ float logsig(float x) { return fminf(x, 0.f) - log1pf(__expf(-fabsf(x))); }
__device__ __forceinline__ bf16x8 frag(const LAS bf16* base, int row0, int ld, int k0, int fr, int fq) { return *(const LAS bf16x8*)(base + (row0 + fr) * ld + k0 + 8 * fq); }
#define MFMA16(a, b, c) __builtin_amdgcn_mfma_f32_16x16x32_bf16((a), (b), (c), 0, 0, 0)

__device__ __forceinline__ int dest_row(int kind, int n) {
    if (kind == 0) return n;
    if (kind == 1) return 256 * (n >> 7) + (n & 127);
    if (kind == 2) return 256 * (n >> 7) + 128 + (n & 127);
    return n < 1536 ? n : (n < 1552 ? 2304 + (n - 1536) : n - 16);
}
__device__ __forceinline__ void p0_transpose_item(const float* W, int K, int N, bf16* WT, int kind, const float* gain, LAS float* scr, int item, int lane) {
    const int nblk = (N + 31) / 32, kb = item / nblk, nb = item % nblk, k0 = 64 * kb, n0 = 32 * nb;
    const int kr = lane >> 3, n4 = (lane & 7) * 4; const bool ok = n0 + n4 < N;
    f32x4 v[8];
#pragma unroll
    for (int i = 0; i < 8; ++i) v[i] = ok ? *(const GAS f32x4*)(W + (size_t)(k0 + 8 * i + kr) * N + n0 + n4) : (f32x4){0.f, 0.f, 0.f, 0.f};
#pragma unroll
    for (int i = 0; i < 8; ++i) { LAS float* d = scr + (8 * i + kr) * 33 + n4; d[0] = v[i].x; d[1] = v[i].y; d[2] = v[i].z; d[3] = v[i].w; }
    LDS_WAIT(); asm volatile("" ::: "memory");
    const int c = lane & 7;
    f32x4 g0 = (f32x4){1.f, 1.f, 1.f, 1.f}, g1 = g0;
    if (gain) { g0 = *(const GAS f32x4*)(gain + k0 + 8 * c); g1 = *(const GAS f32x4*)(gain + k0 + 8 * c + 4); }
#pragma unroll
    for (int j = 0; j < 4; ++j) { const int n = (lane >> 3) + 8 * j; const LAS float* s = scr + (8 * c) * 33 + n;
        v4u o; o.x = pk2(s[0 * 33] * g0.x, s[1 * 33] * g0.y); o.y = pk2(s[2 * 33] * g0.z, s[3 * 33] * g0.w); o.z = pk2(s[4 * 33] * g1.x, s[5 * 33] * g1.y); o.w = pk2(s[6 * 33] * g1.z, s[7 * 33] * g1.w);
        if (n0 + n < N) *(GAS v4u*)(WT + (size_t)dest_row(kind, n0 + n) * K + k0 + 8 * c) = o; }
    LDS_WAIT(); asm volatile("" ::: "memory");
}
__device__ __forceinline__ void p0_prologue(const Ptrs& P, LAS unsigned char* lds, int tid, int wave, int lane, int vcu, int G) {
    LAS float* scr = (LAS float*)(lds + wave * 16384);
    const int gw = vcu * NWAVES + wave, NGW = G * NWAVES;
    constexpr int I_GU = (1024 / 64) * (2816 / 32), I_D = (2816 / 64) * (1024 / 32), I_IN = (1024 / 64) * ((DIN + 31) / 32), I_O = (1024 / 64) * (1024 / 32);
    constexpr int NITEMS = 4 * I_GU + 2 * I_D + I_IN + I_O;
    for (int it = gw; it < NITEMS; it += NGW) {
        int r = it;
        if (r < I_GU) { p0_transpose_item(P.wg1, 1024, 2816, P.wgu1, 1, P.g_ffn1, scr, r, lane); continue; } r -= I_GU;
        if (r < I_GU) { p0_transpose_item(P.wu1, 1024, 2816, P.wgu1, 2, P.g_ffn1, scr, r, lane); continue; } r -= I_GU;
        if (r < I_D)  { p0_transpose_item(P.wd1, 2816, 1024, P.wd1t, 0, nullptr, scr, r, lane); continue; } r -= I_D;
        if (r < I_GU) { p0_transpose_item(P.wg2, 1024, 2816, P.wgu2, 1, P.g_ffn2, scr, r, lane); continue; } r -= I_GU;
        if (r < I_GU) { p0_transpose_item(P.wu2, 1024, 2816, P.wgu2, 2, P.g_ffn2, scr, r, lane); continue; } r -= I_GU;
        if (r < I_D)  { p0_transpose_item(P.wd2, 2816, 1024, P.wd2t, 0, nullptr, scr, r, lane); continue; } r -= I_D;
        if (r < I_IN) { p0_transpose_item(P.w_in, 1024, DIN, P.wint, 3, P.g_mix, scr, r, lane); continue; } r -= I_IN;
        p0_transpose_item(P.w_out, 1024, 1024, P.woutt, 0, nullptr, scr, r, lane);
    }
    for (int m0 = gw; m0 < M; m0 += 2 * NGW) {
        const int m1 = m0 + NGW; const bool has1 = m1 < M; const int m1c = has1 ? m1 : m0;
        const float* xrow0 = (m0 < SEQ) ? P.x_p + (size_t)m0 * D : P.x_s + (size_t)(m0 - SEQ) * D;
        const float* xrow1 = (m1c < SEQ) ? P.x_p + (size_t)m1c * D : P.x_s + (size_t)(m1c - SEQ) * D;
        const GAS f32x4* xr0 = (const GAS f32x4*)xrow0 + lane; const GAS f32x4* xr1 = (const GAS f32x4*)xrow1 + lane;
        f32x4 v[4], w[4]; float s0 = 0.f, s1 = 0.f;
#pragma unroll
        for (int j = 0; j < 4; ++j) { v[j] = xr0[64 * j]; w[j] = xr1[64 * j]; }
#pragma unroll
        for (int j = 0; j < 4; ++j) { s0 += (v[j].x * v[j].x + v[j].y * v[j].y) + (v[j].z * v[j].z + v[j].w * v[j].w); s1 += (w[j].x * w[j].x + w[j].y * w[j].y) + (w[j].z * w[j].z + w[j].w * w[j].w); }
        s0 = wave_sum(s0); s1 = wave_sum(s1);
        GAS unsigned long long* o0 = (GAS unsigned long long*)(P.xn + (size_t)m0 * D) + lane;
        GAS unsigned long long* o1 = (GAS unsigned long long*)(P.xn + (size_t)m1c * D) + lane;
#pragma unroll
        for (int j = 0; j < 4; ++j) {
            o0[64 * j] = (unsigned long long)pk2(v[j].x, v[j].y) | ((unsigned long long)pk2(v[j].z, v[j].w) << 32);
            if (has1) o1[64 * j] = (unsigned long long)pk2(w[j].x, w[j].y) | ((unsigned long long)pk2(w[j].z, w[j].w) << 32); }
        if (lane < 16) { P.ss[(size_t)m0 * 16 + lane] = (lane == 0) ? s0 : 0.f; if (has1) P.ss[(size_t)m1 * 16 + lane] = (lane == 0) ? s1 : 0.f; }
    }
    {
        const int gt = vcu * NTHR + tid, NGT = G * NTHR;
        constexpr int PER_B = 124 * 128 / 4;
#pragma unroll 4
        for (int i = gt; i < 2 * DECB * PER_B; i += NGT) {
            const int which = i / (DECB * PER_B), r = i % (DECB * PER_B), b = r / PER_B, o = r % PER_B;
            const float* src = (which ? P.cv_in : P.ck_in) + (size_t)b * 16384 + 512 + 4 * o;
            float* dst = P.out + (which ? O_CVS : O_CKS) + (size_t)b * 16384 + 4 * o;
            *(f32x4*)dst = *(const f32x4*)src;
        }
    }
}

#define BAR_LDS() do { asm volatile("s_waitcnt lgkmcnt(0)" ::: "memory"); __builtin_amdgcn_s_barrier(); asm volatile("" ::: "memory"); } while (0)

struct GlRegs { f32x4 a; v4u kk; v4u vv[2]; float w[16]; float bg; };
__device__ __forceinline__ void gla_local_load(const Ptrs& P, int c, int h, int tid, GlRegs& R) {
    const int t0 = c * 64;
    { const int t = (tid & 255) >> 2, q = (tid & 3) * 4; R.a = *(const f32x4*)(P.alr + (size_t)(t0 + t) * 16 + q); }
    { const int j = tid >> 3, dc = tid & 7; R.kk = *(const v4u*)(P.kg + (size_t)(t0 + j) * 256 + 64 * h + 8 * dc); }
#pragma unroll
    for (int i = 0; i < 2; ++i) { const int q = tid + 512 * i, jj = q >> 4, cc = q & 15; R.vv[i] = *(const v4u*)(P.vg + (size_t)(t0 + jj) * 512 + 128 * h + 8 * cc); }
    const int d = tid & 63;
#pragma unroll
    for (int r = 0; r < 16; ++r) R.w[r] = P.w_gate_up[r * 256 + 64 * h + d];
    R.bg = P.b_gate[64 * h + d];
}
__device__ __forceinline__ void gla_local_unit(const Ptrs& P, LAS unsigned char* lds, int c, int h, int tid, int wave, int lane, const GlRegs& R) {
    LAS float* alrS = (LAS float*)(lds);
    LAS bf16* kS = (LAS bf16*)(lds + 4096);
    LAS float* segS = (LAS float*)(lds + 13312);
    LAS bf16* khT = (LAS bf16*)(lds + 15360);
    LAS bf16* vT = (LAS bf16*)(lds + 24576);
    const int t0 = c * 64, fr = lane & 15, fq = lane >> 4;
    if (tid < 256) { const int t = tid >> 2, q = (tid & 3) * 4; *(LAS f32x4*)(alrS + t * 16 + q) = R.a; }
    { const int j = tid >> 3, dc = tid & 7; *(LAS v4u*)(kS + j * 72 + 8 * dc) = R.kk; }
#pragma unroll
    for (int i = 0; i < 2; ++i) { const int q = tid + 512 * i, jj = q >> 4, cc = q & 15;
#pragma unroll
        for (int e = 0; e < 8; ++e) { const unsigned w = R.vv[i][e >> 1]; vT[(8 * cc + e) * 72 + jj] = (bf16)((e & 1) ? (w >> 16) : (w & 0xffffu)); } }
    BAR_LDS();
    const int d = tid & 63, seg = wave;
    float cum[8]; float run = 0.f;
#pragma unroll
    for (int i = 0; i < 8; ++i) { const LAS f32x4* ap = (const LAS f32x4*)(alrS + (8 * seg + i) * 16); float x = R.bg;
#pragma unroll
        for (int r4 = 0; r4 < 4; ++r4) { const f32x4 a = ap[r4]; x += (a[0] * R.w[4 * r4] + a[1] * R.w[4 * r4 + 1]) + (a[2] * R.w[4 * r4 + 2] + a[3] * R.w[4 * r4 + 3]); }
        run += logsig(x) * (1.0f / 16.0f); cum[i] = run; }
    segS[seg * 64 + d] = run;
    BAR_LDS();
    { float off = 0.f, last = 0.f;
#pragma unroll
      for (int s2 = 0; s2 < 8; ++s2) { const float v = segS[s2 * 64 + d]; last += v; off += (s2 < seg) ? v : 0.f; }
      unsigned pk[4];
#pragma unroll
      for (int i = 0; i < 8; i += 2) { const float ca = cum[i] + off, cb = cum[i + 1] + off;
          P.cum[(size_t)(t0 + 8 * seg + i) * 256 + 64 * h + d] = ca; P.cum[(size_t)(t0 + 8 * seg + i + 1) * 256 + 64 * h + d] = cb;
          pk[i >> 1] = pk2(bf1(kS[(8 * seg + i) * 72 + d]) * __expf(last - ca), bf1(kS[(8 * seg + i + 1) * 72 + d]) * __expf(last - cb)); }
      *(LAS v4u*)(khT + d * 72 + 8 * seg) = (v4u){pk[0], pk[1], pk[2], pk[3]};
      if (seg == 0) P.g[(size_t)(c * 4 + h) * 64 + d] = __expf(last); }
    BAR_LDS();
    { const int d0 = (wave & 3) * 16;
#pragma unroll
      for (int q = 0; q < 4; ++q) { const int dv0 = ((wave >> 2) * 4 + q) * 16; f32x4 acc = (f32x4){0.f, 0.f, 0.f, 0.f};
#pragma unroll
          for (int kk = 0; kk < 2; ++kk) acc = MFMA16(frag(vT, dv0, 72, 32 * kk, fr, fq), frag(khT, d0, 72, 32 * kk, fr, fq), acc);
          *(f32x4*)(P.ds + ((size_t)(c * 4 + h) * 64 + d0 + fr) * 128 + dv0 + 4 * fq) = acc; } }
}
__device__ __forceinline__ void gla_local_loop(const Ptrs& P, LAS unsigned char* lds, int first, int stride, int tid, int wave, int lane) {
    int u = first; if (u >= 1024) return;
    GlRegs R; gla_local_load(P, u >> 2, u & 3, tid, R);
    for (;;) {
        GlRegs C = R; const int un = u + stride; const bool more = un < 1024;
        if (more) gla_local_load(P, un >> 2, un & 3, tid, R);
        gla_local_unit(P, lds, u >> 2, u & 3, tid, wave, lane, C);
        BAR_LDS();
        if (!more) break; u = un;
    }
}

__device__ __forceinline__ void gla_sample_unit(const Ptrs& P, LAS unsigned char* lds, int b, int tid, int wave, int lane) {
    LAS float* cumS = (LAS float*)(lds);
    LAS float* qd = (LAS float*)(lds + 4096);
    LAS float* kd = (LAS float*)(lds + 8192);
    LAS float* ke = (LAS float*)(lds + 12288);
    LAS float* vS = (LAS float*)(lds + 16384);
    LAS float* attS = (LAS float*)(lds + 24576);
    LAS float* e3S = (LAS float*)(lds + 25088);
    const int r0 = SEQ + 4 * b;
#pragma unroll 1
    for (int i = 0; i < 2; ++i) { const int item = tid + 512 * i, t = item >> 8, col = item & 255; float x = P.b_gate[col];
#pragma unroll
        for (int r = 0; r < 16; ++r) x += P.alr[(size_t)(r0 + t) * 16 + r] * P.w_gate_up[r * 256 + col];
        cumS[t * 256 + col] = logsig(x) * (1.0f / 16.0f); }
    { const int t = tid >> 7, c4 = (tid & 127) * 4; const unsigned long long w = *(const unsigned long long*)(P.vg + (size_t)(r0 + t) * 512 + c4);
      vS[t * 512 + c4] = bflo((unsigned)w); vS[t * 512 + c4 + 1] = bfhi((unsigned)w); vS[t * 512 + c4 + 2] = bflo((unsigned)(w >> 32)); vS[t * 512 + c4 + 3] = bfhi((unsigned)(w >> 32)); }
    __syncthreads();
    if (tid < 256) { const int d = tid; const float c0 = cumS[d], c1 = c0 + cumS[256 + d], c2 = c1 + cumS[512 + d], c3 = c2 + cumS[768 + d];
        cumS[256 + d] = c1; cumS[512 + d] = c2; cumS[768 + d] = c3; e3S[d] = __expf(c3); }
    __syncthreads();
#pragma unroll 1
    for (int i = 0; i < 2; ++i) { const int item = tid + 512 * i, t = item >> 8, col = item & 255; const float cu = cumS[t * 256 + col], c3 = cumS[768 + col];
        const float q = bf1(P.qg[(size_t)(r0 + t) * 256 + col]), k = bf1(P.kg[(size_t)(r0 + t) * 256 + col]);
        qd[t * 256 + col] = q * __expf(cu); kd[t * 256 + col] = k * __expf(c3 - cu); ke[t * 256 + col] = k * __expf(-cu); }
    __syncthreads();
    { const int pr = tid >> 3, l8 = tid & 7, h = pr >> 4, i = (pr >> 2) & 3, j = pr & 3; float s = 0.f;
#pragma unroll
      for (int m = 0; m < 8; ++m) { const int col = 64 * h + l8 + 8 * m; s += qd[i * 256 + col] * ke[j * 256 + col]; }
      s += __shfl_xor(s, 1); s += __shfl_xor(s, 2); s += __shfl_xor(s, 4);
      if (l8 == 0) attS[pr] = (j <= i) ? s : 0.f; }
    __syncthreads();
    { const int h = tid >> 7, dv = tid & 127, c = 128 * h + dv;
      const float v0 = vS[c], v1 = vS[512 + c], v2 = vS[1024 + c], v3 = vS[1536 + c];
      float po[4] = {0.f, 0.f, 0.f, 0.f};
      const size_t sbase = ((size_t)(b * 4 + h) * 64) * 128 + dv;
#pragma unroll 1
      for (int d0 = 0; d0 < 64; d0 += 16) { float s0r[16];
#pragma unroll
          for (int dd = 0; dd < 16; ++dd) s0r[dd] = P.state0[sbase + (size_t)(d0 + dd) * 128];
#pragma unroll
          for (int dd = 0; dd < 16; ++dd) { const int col = 64 * h + d0 + dd; const float s0 = s0r[dd];
              P.out[O_SS + sbase + (size_t)(d0 + dd) * 128] = s0 * e3S[col] + ((kd[col] * v0 + kd[256 + col] * v1) + (kd[512 + col] * v2 + kd[768 + col] * v3));
              po[0] += qd[col] * s0; po[1] += qd[256 + col] * s0; po[2] += qd[512 + col] * s0; po[3] += qd[768 + col] * s0; } }
#pragma unroll
      for (int i = 0; i < 4; ++i) {
#pragma unroll
          for (int j = 0; j < 4; ++j) po[i] += attS[h * 16 + i * 4 + j] * ((j == 0) ? v0 : (j == 1) ? v1 : (j == 2) ? v2 : v3);
          const float sq = wave_sum(po[i] * po[i]); if (lane == 0) cumS[wave * 4 + i] = sq; }
      __syncthreads();
#pragma unroll
      for (int i = 0; i < 4; ++i) { const float tot = cumS[(2 * h) * 4 + i] + cumS[(2 * h + 1) * 4 + i];
          const float rs = rsqrtf(tot * (1.0f / 128.0f) + EPS);
          P.mix[(size_t)(r0 + i) * 1024 + c] = (bf16)f2bf(po[i] * rs * P.g_head[c] * bf1(P.rg[(size_t)(r0 + i) * 512 + c])); } }
    __syncthreads();
}

__device__ __forceinline__ void swa_sample_unit(const Ptrs& P, LAS unsigned char* lds, int b, int tid, int wave, int lane) {
    LAS float* qS = (LAS float*)(lds);
    LAS float* pS = (LAS float*)(lds + 8192);
    LAS float* kL = (LAS float*)(lds + 25600);
    LAS float* oP = (LAS float*)(lds + 93952);
    const int r0 = SEQ + 4 * b;
    { const int t = tid >> 7, c4 = (tid & 127) * 4;
      const unsigned long long w = *(const unsigned long long*)(P.qs + (size_t)(r0 + t) * 512 + c4);
      qS[t * 512 + c4] = bflo((unsigned)w); qS[t * 512 + c4 + 1] = bfhi((unsigned)w); qS[t * 512 + c4 + 2] = bflo((unsigned)(w >> 32)); qS[t * 512 + c4 + 3] = bfhi((unsigned)(w >> 32)); }
    { f32x4 kr[9];
#pragma unroll
      for (int i = 0; i < 9; ++i) { const int idx = tid + 512 * i, j = idx >> 5, c4 = (idx & 31) * 4;
          kr[i] = (f32x4){0.f, 0.f, 0.f, 0.f};
          if (idx < 4224) kr[i] = *(const f32x4*)((j < 128) ? P.ck_in + ((size_t)b * 128 + j) * 128 + c4 : P.out + O_CKS + ((size_t)b * 128 + 124 + (j - 128)) * 128 + c4); }
#pragma unroll
      for (int i = 0; i < 9; ++i) { const int idx = tid + 512 * i, j = idx >> 5, c4 = (idx & 31) * 4;
          if (idx < 4224) { LAS float* d = kL + j * 129 + c4; d[0] = kr[i].x; d[1] = kr[i].y; d[2] = kr[i].z; d[3] = kr[i].w; } } }
    __syncthreads();
    f32x4 vr[9];
#pragma unroll
    for (int i = 0; i < 9; ++i) { const int idx = tid + 512 * i, j = idx >> 5, c4 = (idx & 31) * 4;
        vr[i] = (f32x4){0.f, 0.f, 0.f, 0.f};
        if (idx < 4224) vr[i] = *(const f32x4*)((j < 128) ? P.cv_in + ((size_t)b * 128 + j) * 128 + c4 : P.out + O_CVS + ((size_t)b * 128 + 124 + (j - 128)) * 128 + c4); }
    if (tid < 264) {
        const int j = tid >> 1, kvh = tid & 1; float s[16];
#pragma unroll
        for (int i = 0; i < 16; ++i) s[i] = 0.f;
#pragma unroll 2
        for (int d = 0; d < 64; ++d) { const float kv = kL[j * 129 + 64 * kvh + d];
#pragma unroll
            for (int hl = 0; hl < 4; ++hl)
#pragma unroll
                for (int t = 0; t < 4; ++t) s[hl * 4 + t] += qS[t * 512 + 64 * (4 * kvh + hl) + d] * kv; }
#pragma unroll
        for (int hl = 0; hl < 4; ++hl)
#pragma unroll
            for (int t = 0; t < 4; ++t) { const bool valid = (j <= 128 + t) && (j >= t + 1); pS[((4 * kvh + hl) * 4 + t) * 136 + j] = valid ? s[hl * 4 + t] : -INFINITY; }
    }
    __syncthreads();
#pragma unroll
    for (int i = 0; i < 9; ++i) { const int idx = tid + 512 * i, j = idx >> 5, c4 = (idx & 31) * 4;
        if (idx < 4224) { LAS float* d = kL + j * 129 + c4; d[0] = vr[i].x; d[1] = vr[i].y; d[2] = vr[i].z; d[3] = vr[i].w; } }
    {
#pragma unroll 1
        for (int rr = 0; rr < 4; ++rr) { const int row = 4 * wave + rr, hh = row >> 2; const float sink = P.sinks[hh];
            float v0 = pS[row * 136 + lane], v1 = pS[row * 136 + 64 + lane], v2 = (lane < 4) ? pS[row * 136 + 128 + lane] : -INFINITY;
            float m = fmaxf(fmaxf(v0, v1), v2);
#pragma unroll
            for (int o = 1; o < 64; o <<= 1) m = fmaxf(m, __shfl_xor(m, o));
            m = fmaxf(m, sink);
            const float e0 = __expf(v0 - m), e1 = __expf(v1 - m), e2 = (lane < 4) ? __expf(v2 - m) : 0.f;
            const float den = wave_sum(e0 + e1 + e2) + __expf(sink - m), inv = 1.0f / den;
            pS[row * 136 + lane] = e0 * inv; pS[row * 136 + 64 + lane] = e1 * inv; if (lane < 4) pS[row * 136 + 128 + lane] = e2 * inv; }
    }
    __syncthreads();
    {
        const int part = tid >> 7, kvh = (tid >> 6) & 1, d = tid & 63; float o[16];
#pragma unroll
        for (int i = 0; i < 16; ++i) o[i] = 0.f;
#pragma unroll 1
        for (int jj = 0; jj < 33; ++jj) { const int j = part * 33 + jj; const float vv = kL[j * 129 + 64 * kvh + d];
#pragma unroll
            for (int hl = 0; hl < 4; ++hl)
#pragma unroll
                for (int t = 0; t < 4; ++t) o[hl * 4 + t] += pS[((4 * kvh + hl) * 4 + t) * 136 + j] * vv; }
#pragma unroll
        for (int hl = 0; hl < 4; ++hl)
#pragma unroll
            for (int t = 0; t < 4; ++t) oP[(part * 4 + t) * 512 + 64 * (4 * kvh + hl) + d] = o[hl * 4 + t];
    }
    __syncthreads();
    if (wave < 4) { const int t = wave; float v[8]; float sq = 0.f;
#pragma unroll
        for (int e = 0; e < 8; ++e) { const int c = lane + 64 * e; v[e] = (oP[(0 * 4 + t) * 512 + c] + oP[(1 * 4 + t) * 512 + c]) + (oP[(2 * 4 + t) * 512 + c] + oP[(3 * 4 + t) * 512 + c]); sq += v[e] * v[e]; }
        const float rs = rsqrtf(wave_sum(sq) * (1.0f / 512.0f) + EPS);
#pragma unroll
        for (int e = 0; e < 8; ++e) P.mix[(size_t)(r0 + t) * 1024 + 512 + lane + 64 * e] = (bf16)f2bf(v[e] * rs * P.g_swa[lane + 64 * e]); }
    __syncthreads();
}

__device__ __forceinline__ void gla_scan2(const Ptrs& P, LAS unsigned char* lds, int blk, int tid) {
    LAS float* As = (LAS float*)lds;
    LAS float* Ps = (LAS float*)(lds + 2048);
    const int seg = tid >> 6, el = tid & 63, e = blk * 64 + el, h = e >> 13, d = (e >> 7) & 63;
    float* dsp = P.ds + e + (size_t)(seg * 32) * 32768;
    const float* gp = P.g + h * 64 + d + (size_t)(seg * 32) * 256;
    float dsv[32], gv[32];
#pragma unroll
    for (int i = 0; i < 32; ++i) { dsv[i] = dsp[(size_t)i * 32768]; gv[i] = gp[(size_t)i * 256]; }
    float A = 0.f, Pm = 1.f;
#pragma unroll
    for (int i = 0; i < 32; ++i) { A = A * gv[i] + dsv[i]; Pm *= gv[i]; }
    As[seg * 64 + el] = A; Ps[seg * 64 + el] = Pm;
    __syncthreads();
    float S = 0.f;
    for (int s2 = 0; s2 < seg; ++s2) S = S * Ps[s2 * 64 + el] + As[s2 * 64 + el];
#pragma unroll
    for (int i = 0; i < 32; ++i) { dsp[(size_t)i * 32768] = S; S = S * gv[i] + dsv[i]; }
    if (seg == 7) P.out[O_SP + e] = S;
    __syncthreads();
}

struct SwRegs { v4u kk[3], vv[3], qq[2]; };
__device__ __forceinline__ void swa_prompt_load(const Ptrs& P, int qb, int g, int tid, SwRegs& R) {
    const int q0 = qb * 32, kbase = q0 - 128;
#pragma unroll
    for (int i = 0; i < 3; ++i) { const int q = tid + 512 * i, j = q >> 3, ch = q & 7, tok = kbase + j;
        R.kk[i] = (v4u){0u, 0u, 0u, 0u}; R.vv[i] = (v4u){0u, 0u, 0u, 0u};
        if (q < 1280 && tok >= 0) { const bf16* p = P.kvs + (size_t)tok * 256 + 64 * g + 8 * ch; R.kk[i] = *(const v4u*)p; R.vv[i] = *(const v4u*)(p + 128); } }
#pragma unroll
    for (int i = 0; i < 2; ++i) { const int q = tid + 512 * i, r = q >> 3, ch = q & 7, hl = r >> 5, ql = r & 31;
        R.qq[i] = *(const v4u*)(P.qs + (size_t)(q0 + ql) * 512 + 64 * (4 * g + hl) + 8 * ch); }
}
__device__ __forceinline__ void swa_prompt_unit(const Ptrs& P, LAS unsigned char* lds, int qb, int g, int tid, int wave, int lane, const SwRegs& R) {
    LAS bf16* Ks = (LAS bf16*)(lds);
    LAS bf16* VsT = (LAS bf16*)(lds + 23040);
    LAS bf16* Qs = (LAS bf16*)(lds + 44544);
    LAS bf16* Ps = (LAS bf16*)(lds + 62976);
    const int q0 = qb * 32, kbase = q0 - 128, fr = lane & 15, fq = lane >> 4;
#pragma unroll
    for (int i = 0; i < 3; ++i) { const int q = tid + 512 * i, j = q >> 3, ch = q & 7;
        if (q < 1280) { *(LAS v4u*)(Ks + j * 72 + 8 * ch) = R.kk[i];
#pragma unroll
            for (int e = 0; e < 8; ++e) { const unsigned w = R.vv[i][e >> 1]; VsT[(8 * ch + e) * 168 + j] = (bf16)((e & 1) ? (w >> 16) : (w & 0xffffu)); } } }
#pragma unroll
    for (int i = 0; i < 2; ++i) { const int q = tid + 512 * i, r = q >> 3, ch = q & 7; *(LAS v4u*)(Qs + r * 72 + 8 * ch) = R.qq[i]; }
    BAR_LDS();
    const int r0 = 16 * wave, head = 4 * g + (wave >> 1), ql0 = 16 * (wave & 1);
    const int qpos = q0 + ql0 + fr; const float sink = P.sinks[head];
    f32x4 s[10];
#pragma unroll
    for (int t = 0; t < 10; ++t) s[t] = (f32x4){0.f, 0.f, 0.f, 0.f};
#pragma unroll
    for (int kk = 0; kk < 2; ++kk) { const bf16x8 bq = frag(Qs, r0, 72, 32 * kk, fr, fq);
#pragma unroll
        for (int t = 0; t < 10; ++t) s[t] = MFMA16(frag(Ks, 16 * t, 72, 32 * kk, fr, fq), bq, s[t]); }
    float m = -INFINITY;
#pragma unroll
    for (int t = 0; t < 10; ++t)
#pragma unroll
        for (int r = 0; r < 4; ++r) { const int kpos = kbase + 16 * t + 4 * fq + r; const bool valid = (kpos >= 0) && (kpos <= qpos) && (qpos - kpos < 128);
            s[t][r] = valid ? s[t][r] : -INFINITY; m = fmaxf(m, s[t][r]); }
    m = fmaxf(m, __shfl_xor(m, 16)); m = fmaxf(m, __shfl_xor(m, 32)); m = fmaxf(m, sink);
    float sum = 0.f;
#pragma unroll
    for (int t = 0; t < 10; ++t)
#pragma unroll
        for (int r = 0; r < 4; ++r) { const float p = __expf(s[t][r] - m); s[t][r] = p; sum += p; }
    sum += __shfl_xor(sum, 16); sum += __shfl_xor(sum, 32);
    const float inv = 1.0f / (sum + __expf(sink - m));
#pragma unroll
    for (int t = 0; t < 10; ++t) { unsigned long long w = (unsigned long long)pk2(s[t][0] * inv, s[t][1] * inv) | ((unsigned long long)pk2(s[t][2] * inv, s[t][3] * inv) << 32);
        *(LAS unsigned long long*)(Ps + (r0 + fr) * 168 + 16 * t + 4 * fq) = w; }
    asm volatile("s_waitcnt lgkmcnt(0)" ::: "memory");
    f32x4 o[4];
#pragma unroll
    for (int dt = 0; dt < 4; ++dt) o[dt] = (f32x4){0.f, 0.f, 0.f, 0.f};
#pragma unroll
    for (int ks = 0; ks < 5; ++ks) { const bf16x8 bp = frag(Ps, r0, 168, 32 * ks, fr, fq);
#pragma unroll
        for (int dt = 0; dt < 4; ++dt) o[dt] = MFMA16(frag(VsT, 16 * dt, 168, 32 * ks, fr, fq), bp, o[dt]); }
    float sq = 0.f;
#pragma unroll
    for (int dt = 0; dt < 4; ++dt) sq += (o[dt][0] * o[dt][0] + o[dt][1] * o[dt][1]) + (o[dt][2] * o[dt][2] + o[dt][3] * o[dt][3]);
    sq += __shfl_xor(sq, 16); sq += __shfl_xor(sq, 32);
    if (fq == 0) P.ssw[(size_t)qpos * 8 + head] = sq;
#pragma unroll
    for (int dt = 0; dt < 4; ++dt) { const unsigned long long w = (unsigned long long)pk2(o[dt][0], o[dt][1]) | ((unsigned long long)pk2(o[dt][2], o[dt][3]) << 32);
        *(unsigned long long*)(P.mix + (size_t)qpos * 1024 + 512 + 64 * head + 16 * dt + 4 * fq) = w; }
}
__device__ __forceinline__ void swa_prompt_loop(const Ptrs& P, LAS unsigned char* lds, int first, int stride, int tid, int wave, int lane) {
    int u = first; if (u >= 1024) return;
    SwRegs R; swa_prompt_load(P, u >> 1, u & 1, tid, R);
    for (;;) {
        SwRegs C = R; const int un = u + stride; const bool more = un < 1024;
        if (more) swa_prompt_load(P, un >> 1, un & 1, tid, R);
        swa_prompt_unit(P, lds, u >> 1, u & 1, tid, wave, lane, C);
        BAR_LDS();
        if (!more) break; u = un;
    }
}

struct GoRegs { v4u qq, kk; f32x4 c0, c1; v4u vv[2]; f32x4 sv[4]; };
struct GoEpi { v4u r0, r1, a0, a1; f32x4 sa, sb; };
__device__ __forceinline__ void gla_out_load(const Ptrs& P, int c, int h, int tid, GoRegs& R) {
    const int t0 = c * 64, j = tid >> 3, dc = tid & 7;
    R.qq = *(const v4u*)(P.qg + (size_t)(t0 + j) * 256 + 64 * h + 8 * dc); R.kk = *(const v4u*)(P.kg + (size_t)(t0 + j) * 256 + 64 * h + 8 * dc);
    const float* cp = P.cum + (size_t)(t0 + j) * 256 + 64 * h + 8 * dc; R.c0 = *(const f32x4*)cp; R.c1 = *(const f32x4*)(cp + 4);
#pragma unroll
    for (int i = 0; i < 2; ++i) { const int q = tid + 512 * i, jj = q >> 4, cc = q & 15; R.vv[i] = *(const v4u*)(P.vg + (size_t)(t0 + jj) * 512 + 128 * h + 8 * cc); }
#pragma unroll
    for (int i = 0; i < 4; ++i) { const int q = tid + 512 * i, d = q >> 5, dv4 = (q & 31) * 4; R.sv[i] = *(const f32x4*)(P.ds + ((size_t)(c * 4 + h) * 64 + d) * 128 + dv4); }
}
__device__ __forceinline__ void gla_out_load_epi(const Ptrs& P, int c, int h, int tid, GoEpi& E) {
    const int i = tid >> 3, seg = tid & 7, tok = c * 64 + i, col = 128 * h + 16 * seg;
    E.r0 = *(const v4u*)(P.rg + (size_t)tok * 512 + col); E.r1 = *(const v4u*)(P.rg + (size_t)tok * 512 + col + 8);
    const bf16* mp = P.mix + (size_t)tok * 1024 + 512 + col; E.a0 = *(const v4u*)mp; E.a1 = *(const v4u*)(mp + 8);
    E.sa = *(const f32x4*)(P.ssw + (size_t)tok * 8); E.sb = *(const f32x4*)(P.ssw + (size_t)tok * 8 + 4);
}
__device__ __forceinline__ void gla_out_unit(const Ptrs& P, LAS unsigned char* lds, int c, int h, int tid, int wave, int lane, const GoRegs& R, const GoEpi& E) {
    LAS bf16* qT = (LAS bf16*)(lds);
    LAS bf16* kT = (LAS bf16*)(lds + 9216);
    LAS bf16* vT = (LAS bf16*)(lds + 18432);
    LAS bf16* sT = (LAS bf16*)(lds + 36864);
    LAS bf16* aS = (LAS bf16*)(lds + 55296);
    LAS float* oS = (LAS float*)(lds + 64512);
    const int t0 = c * 64, fr = lane & 15, fq = lane >> 4;
    { const int j = tid >> 3, dc = tid & 7;
      float cu[8] = {R.c0[0], R.c0[1], R.c0[2], R.c0[3], R.c1[0], R.c1[1], R.c1[2], R.c1[3]}; v4u qo, ko;
#pragma unroll
      for (int e2 = 0; e2 < 4; ++e2) { const float ea = __expf(cu[2 * e2]), eb = __expf(cu[2 * e2 + 1]);
          qo[e2] = pk2(bflo(R.qq[e2]) * ea, bfhi(R.qq[e2]) * eb); ko[e2] = pk2(bflo(R.kk[e2]) / ea, bfhi(R.kk[e2]) / eb); }
      *(LAS v4u*)(qT + j * 72 + 8 * dc) = qo; *(LAS v4u*)(kT + j * 72 + 8 * dc) = ko;
#pragma unroll
      for (int i = 0; i < 2; ++i) { const int q = tid + 512 * i, jj = q >> 4, cc = q & 15;
#pragma unroll
          for (int e = 0; e < 8; ++e) { const unsigned w = R.vv[i][e >> 1]; vT[(8 * cc + e) * 72 + jj] = (bf16)((e & 1) ? (w >> 16) : (w & 0xffffu)); } }
#pragma unroll
      for (int i = 0; i < 4; ++i) { const int q = tid + 512 * i, d = q >> 5, dv4 = (q & 31) * 4;
#pragma unroll
          for (int e = 0; e < 4; ++e) sT[(dv4 + e) * 72 + d] = (bf16)f2bf(R.sv[i][e]); } }
    BAR_LDS();
    { const int i0 = (wave >> 1) * 16;
#pragma unroll
      for (int q = 0; q < 2; ++q) { const int j0 = ((wave & 1) * 2 + q) * 16; f32x4 acc = (f32x4){0.f, 0.f, 0.f, 0.f};
#pragma unroll
          for (int kk = 0; kk < 2; ++kk) acc = MFMA16(frag(kT, j0, 72, 32 * kk, fr, fq), frag(qT, i0, 72, 32 * kk, fr, fq), acc);
          const int i = i0 + fr, jb = j0 + 4 * fq;
          const unsigned long long w = (unsigned long long)pk2(jb <= i ? acc[0] : 0.f, jb + 1 <= i ? acc[1] : 0.f) | ((unsigned long long)pk2(jb + 2 <= i ? acc[2] : 0.f, jb + 3 <= i ? acc[3] : 0.f) << 32);
          *(LAS unsigned long long*)(aS + i * 72 + jb) = w; } }
    BAR_LDS();
    { const int i0 = (wave & 3) * 16;
#pragma unroll
      for (int q = 0; q < 4; ++q) { const int dv0 = ((wave >> 2) * 4 + q) * 16; f32x4 acc = (f32x4){0.f, 0.f, 0.f, 0.f};
#pragma unroll
          for (int kk = 0; kk < 2; ++kk) { acc = MFMA16(frag(vT, dv0, 72, 32 * kk, fr, fq), frag(aS, i0, 72, 32 * kk, fr, fq), acc);
                                           acc = MFMA16(frag(sT, dv0, 72, 32 * kk, fr, fq), frag(qT, i0, 72, 32 * kk, fr, fq), acc); }
          *(LAS f32x4*)(oS + (i0 + fr) * 132 + dv0 + 4 * fq) = acc; } }
    BAR_LDS();
    { const int i = tid >> 3, seg = tid & 7, tok = t0 + i, col = 128 * h + 16 * seg;
      f32x4 ov[4]; float sq = 0.f;
#pragma unroll
      for (int e = 0; e < 4; ++e) { ov[e] = *(const LAS f32x4*)(oS + i * 132 + 16 * seg + 4 * e); sq += (ov[e][0] * ov[e][0] + ov[e][1] * ov[e][1]) + (ov[e][2] * ov[e][2] + ov[e][3] * ov[e][3]); }
      sq += __shfl_xor(sq, 1); sq += __shfl_xor(sq, 2); sq += __shfl_xor(sq, 4);
      const float rs = rsqrtf(sq * (1.0f / 128.0f) + EPS);
      v4u w0, w1;
#pragma unroll
      for (int e2 = 0; e2 < 4; ++e2) { const int cc = col + 2 * e2;
          w0[e2] = pk2(ov[e2 >> 1][(2 * e2) & 3] * rs * P.g_head[cc] * bflo(E.r0[e2]), ov[e2 >> 1][(2 * e2 + 1) & 3] * rs * P.g_head[cc + 1] * bfhi(E.r0[e2]));
          w1[e2] = pk2(ov[2 + (e2 >> 1)][(2 * e2) & 3] * rs * P.g_head[cc + 8] * bflo(E.r1[e2]), ov[2 + (e2 >> 1)][(2 * e2 + 1) & 3] * rs * P.g_head[cc + 9] * bfhi(E.r1[e2])); }
      *(v4u*)(P.mix + (size_t)tok * 1024 + col) = w0; *(v4u*)(P.mix + (size_t)tok * 1024 + col + 8) = w1;
      const float rs2 = rsqrtf((((E.sa[0] + E.sa[1]) + (E.sa[2] + E.sa[3])) + ((E.sb[0] + E.sb[1]) + (E.sb[2] + E.sb[3]))) * (1.0f / 512.0f) + EPS);
      bf16* mp = P.mix + (size_t)tok * 1024 + 512 + col; v4u b0, b1;
#pragma unroll
      for (int e2 = 0; e2 < 4; ++e2) { const int cc = col + 2 * e2;
          b0[e2] = pk2(bflo(E.a0[e2]) * rs2 * P.g_swa[cc], bfhi(E.a0[e2]) * rs2 * P.g_swa[cc + 1]);
          b1[e2] = pk2(bflo(E.a1[e2]) * rs2 * P.g_swa[cc + 8], bfhi(E.a1[e2]) * rs2 * P.g_swa[cc + 9]); }
      *(v4u*)mp = b0; *(v4u*)(mp + 8) = b1; }
}
__device__ __forceinline__ void gla_out_loop(const Ptrs& P, LAS unsigned char* lds, int first, int stride, int tid, int wave, int lane) {
    int u = first; if (u >= 1024) return;
    GoRegs R; GoEpi E; gla_out_load(P, u >> 2, u & 3, tid, R); gla_out_load_epi(P, u >> 2, u & 3, tid, E);
    for (;;) {
        GoRegs C = R; const int un = u + stride; const bool more = un < 1024;
        if (more) gla_out_load(P, un >> 2, un & 3, tid, R);
        gla_out_unit(P, lds, u >> 2, u & 3, tid, wave, lane, C, E);
        if (more) gla_out_load_epi(P, un >> 2, un & 3, tid, E);
        BAR_LDS();
        if (!more) break; u = un;
    }
}

__device__ __forceinline__ void final_norm_prompt(const Ptrs& P, int wave, int lane, int bidx, int nb) {
    const int gw = bidx * NWAVES + wave, NGW = nb * NWAVES;
    f32x4 gg[4];
#pragma unroll
    for (int j = 0; j < 4; ++j) gg[j] = *((const GAS f32x4*)P.g_final + 4 * lane + j);
    for (int m0 = gw; m0 < SEQ; m0 += 4 * NGW) {
        v4u v[4][2]; float rs[4]; int mm[4];
#pragma unroll
        for (int r = 0; r < 4; ++r) { const int m = m0 + r * NGW; mm[r] = m < SEQ ? m : m0;
            const GAS v4u* xr = (const GAS v4u*)(P.xn + (size_t)mm[r] * D) + 2 * lane; v[r][0] = xr[0]; v[r][1] = xr[1]; }
#pragma unroll
        for (int r = 0; r < 4; ++r) rs[r] = pg8::row_rs16(P.ss, mm[r]);
#pragma unroll
        for (int r = 0; r < 4; ++r) { if (r > 0 && m0 + r * NGW >= SEQ) continue;
            GAS f32x4* yw = (GAS f32x4*)(P.out + (size_t)mm[r] * D) + 4 * lane;
#pragma unroll
            for (int j = 0; j < 4; ++j) { const unsigned a = v[r][j >> 1][(2 * j) & 3], b = v[r][j >> 1][(2 * j + 1) & 3];
                yw[j] = (f32x4){bflo(a), bfhi(a), bflo(b), bfhi(b)} * rs[r] * gg[j]; } }
    }
}
__device__ __forceinline__ void final_sample(const Ptrs& P, const float* slabs, int wave, int lane, int vcu, int G) {
    const int gw = vcu * NWAVES + wave, NGW = G * NWAVES;
    for (int r = gw; r < NSAMP; r += NGW) {
        const GAS unsigned long long* xb = (const GAS unsigned long long*)(P.xn + (size_t)(SEQ + r) * D) + lane;
        GAS f32x4* yr = (GAS f32x4*)(P.out + (size_t)(SEQ + r) * D) + lane;
        f32x4 v[4]; float s = 0.f;
#pragma unroll
        for (int j = 0; j < 4; ++j) { const GAS f32x4* sp = (const GAS f32x4*)(slabs + (size_t)r * D) + lane + 64 * j;
            const f32x4 a = (sp[0] + sp[(size_t)NSAMP * D / 4]) + (sp[(size_t)2 * NSAMP * D / 4] + sp[(size_t)3 * NSAMP * D / 4]);
            const unsigned long long w = xb[64 * j];
            v[j] = (f32x4){bflo((unsigned)w), bfhi((unsigned)w), bflo((unsigned)(w >> 32)), bfhi((unsigned)(w >> 32))} + a * 0.5f;
            s += (v[j].x * v[j].x + v[j].y * v[j].y) + (v[j].z * v[j].z + v[j].w * v[j].w); }
        const float rs = rsqrtf(wave_sum(s) * (1.f / D) + EPS);
#pragma unroll
        for (int j = 0; j < 4; ++j) { const f32x4 gg = *((const GAS f32x4*)P.g_final + lane + 64 * j); yr[64 * j] = v[j] * rs * gg; }
    }
}

#ifndef PROBE_REP_HI
#define PROBE_REP_HI (-1)
#endif
#ifndef MK_N_LAUNCHES
#define MK_N_LAUNCHES 1
#endif
constexpr int N_PHASES = 12;
__global__ void __launch_bounds__(NTHR, 2) hymba_fwd(Args args) {
    extern __shared__ __attribute__((aligned(16))) unsigned char lds_raw[];
    LAS unsigned char* lds = (LAS unsigned char*)lds_raw;
    volatile LAS unsigned* MISC = (volatile LAS unsigned*)(lds + MISC_OFF);
    const int tid = threadIdx.x, lane = tid & 63, wave = __builtin_amdgcn_readfirstlane(tid >> 6);
    const int G = gridDim.x, bx = blockIdx.x, vcu = (G % 8 == 0) ? (bx % 8) * (G / 8) + bx / 8 : bx;
    unsigned char* ws = args.ws;
    Ptrs P;
    P.x_p = args.in[0]; P.x_s = args.in[1]; P.state0 = args.in[2]; P.ck_in = args.in[3]; P.cv_in = args.in[4]; P.g_ffn1 = args.in[5]; P.wg1 = args.in[6]; P.wu1 = args.in[7]; P.wd1 = args.in[8];
    P.g_mix = args.in[9]; P.w_in = args.in[10]; P.w_gate_up = args.in[11]; P.b_gate = args.in[12]; P.g_head = args.in[13]; P.g_swa = args.in[14]; P.sinks = args.in[15]; P.w_out = args.in[16];
    P.g_ffn2 = args.in[17]; P.wg2 = args.in[18]; P.wu2 = args.in[19]; P.wd2 = args.in[20]; P.g_final = args.in[21];
    P.out = args.out;
    P.wgu1 = (bf16*)(ws + WS_WGU1); P.wd1t = (bf16*)(ws + WS_WD1); P.wgu2 = (bf16*)(ws + WS_WGU2); P.wd2t = (bf16*)(ws + WS_WD2); P.wint = (bf16*)(ws + WS_WIN); P.woutt = (bf16*)(ws + WS_WOUT);
    P.xn = (bf16*)(ws + WS_XN); P.mix = (bf16*)(ws + WS_MIX); P.hbuf = (bf16*)(ws + WS_R);
    P.qg = (bf16*)(ws + WS_R + R_QG); P.kg = (bf16*)(ws + WS_R + R_KG); P.vg = (bf16*)(ws + WS_R + R_VG); P.rg = (bf16*)(ws + WS_R + R_RG); P.qs = (bf16*)(ws + WS_R + R_QS); P.kvs = (bf16*)(ws + WS_R + R_KVS);
    P.cum = (float*)(ws + WS_R + R_CUM);
    P.ss = (float*)(ws + WS_SS); P.ssw = (float*)(ws + WS_SSW); P.alr = (float*)(ws + WS_ALR); P.g = (float*)(ws + WS_G); P.ds = (float*)(ws + WS_DS);

    for (int u = tid; u < (LDS_BYTES - RING_BYTES) / 4; u += NTHR) ((LAS unsigned*)(lds + RING_BYTES))[u] = 0u;
    __syncthreads();
    const int lo = args.ph_lo, hi = args.ph_hi;
    unsigned* barw = (unsigned*)(ws + WS_CTL) + args.bar_region * XCD_BAR_WORDS;
    XcdBarrier bar; bar.bar = barw; bar.x = 0; bar.st = nullptr;
    if (hi - lo > 1) bar = xcd_barrier_post(barw, MISC + 8);
#define IN(k) (lo <= (k) && (k) < hi)
#define SEAM(k) do { if (IN(k) && IN((k) + 1)) xcd_barrier(bar); } while (0)

    if (IN(0)) p0_prologue(P, lds, tid, wave, lane, vcu, G);
    SEAM(0);
    if (IN(1)) { pg8::Gemm g{P.xn, P.wgu1, M, 5632, 1024, 1024}; pg8::StaticOrder S; S.init(M, 5632, G, bx); pg8::EpiGU E{P.hbuf, P.ss};
        pg8::gemm_phase<pg8::EpiGU, pg8::StaticOrder, true, true>(lds, g, S, E); }
    SEAM(1);
    if (IN(2)) { pg8::Gemm g{P.hbuf, P.wd1t, M, 1024, 2816, 2816}; pg8::SubOrder S; S.init(64, 1024, 0, G, 0, bx); pg8::EpiRes E{P.xn, P.ss, 0.5f};
        pg8::gemm_phase<pg8::EpiRes, pg8::SubOrder, true, true>(lds, g, S, E); }
    SEAM(2);
    if (IN(3)) {
        if (bx < G - 8) { pg8::Gemm g{P.xn, P.wint, M, NPROJ, 1024, 1024}; pg8::SubOrder S; S.init(64, NPROJ, 0, G - 8, 0, bx);
            pg8::EpiProj E{P.ss, P.qg, P.kg, P.vg, P.rg, P.qs, P.kvs, P.alr, P.out + O_CKP, P.out + O_CVP, P.out + O_CKS, P.out + O_CVS};
            pg8::gemm_phase<pg8::EpiProj, pg8::SubOrder, true, true>(lds, g, S, E); }
        else { pg8::Gemm g{P.hbuf, P.wd1t, M, 1024, 2816, 2816}; pg8::SubOrder S; S.init(2, 1024, G - 8, 8, 64, bx); pg8::EpiRes E{P.xn, P.ss, 0.5f};
            pg8::gemm_phase<pg8::EpiRes, pg8::SubOrder, true, true>(lds, g, S, E); }
    }
    SEAM(3);
    if (IN(4)) {
        if (bx < G - 20) { gla_local_loop(P, lds, bx, G - 20, tid, wave, lane); swa_prompt_loop(P, lds, bx, G - 20, tid, wave, lane); }
        else { pg8::Gemm g{P.xn, P.wint, M, NPROJ, 1024, 1024}; pg8::SubOrder S; S.init(2, NPROJ, G - 20, 20, 64, bx);
            pg8::EpiProj E{P.ss, P.qg, P.kg, P.vg, P.rg, P.qs, P.kvs, P.alr, P.out + O_CKP, P.out + O_CVP, P.out + O_CKS, P.out + O_CVS};
            pg8::gemm_phase<pg8::EpiProj, pg8::SubOrder, true, true>(lds, g, S, E); }
    }
    SEAM(4);
    if (IN(5)) {
        for (int sb = bx; sb < 512; sb += G) gla_scan2(P, lds, sb, tid);
        for (int u = bx; u < 128; u += G) swa_sample_unit(P, lds, u, tid, wave, lane);
        for (int u = bx; u < 256; u += G) if (u >= 128) gla_sample_unit(P, lds, u - 128, tid, wave, lane);
    }
    SEAM(5);
    if (IN(6)) {
        if (bx < G - 8) gla_out_loop(P, lds, bx, G - 8, tid, wave, lane);
        else { pg8::Gemm g{P.mix, P.woutt, M, 1024, 1024, 1024}; pg8::SubOrder S; S.init(2, 1024, G - 8, 8, 64, bx); pg8::EpiRes E{P.xn, P.ss, 1.0f};
            pg8::gemm_phase<pg8::EpiRes, pg8::SubOrder, true, true>(lds, g, S, E); }
    }
    SEAM(6);
    if (IN(7)) { pg8::Gemm g{P.mix, P.woutt, M, 1024, 1024, 1024}; pg8::SubOrder S; S.init(64, 1024, 0, G, 0, bx); pg8::EpiRes E{P.xn, P.ss, 1.0f};
        pg8::gemm_phase<pg8::EpiRes, pg8::SubOrder, true, true>(lds, g, S, E); }
    SEAM(7);
    if (IN(8)) { pg8::Gemm g{P.xn, P.wgu2, M, 5632, 1024, 1024}; pg8::StaticOrder S; S.init(M, 5632, G, bx); pg8::EpiGU E{P.hbuf, P.ss};
        pg8::gemm_phase<pg8::EpiGU, pg8::StaticOrder, true, true>(lds, g, S, E); }
    SEAM(8);
    if (IN(9)) { pg8::Gemm g{P.hbuf, P.wd2t, M, 1024, 2816, 2816}; pg8::SubOrder S; S.init(64, 1024, 0, G, 0, bx); pg8::EpiRes E{P.xn, P.ss, 0.5f};
        pg8::gemm_phase<pg8::EpiRes, pg8::SubOrder, true, true>(lds, g, S, E); }
    SEAM(9);
    if (IN(10)) {
        if (bx < G - 32) final_norm_prompt(P, wave, lane, bx, G - 32);
        else { const int j = bx - (G - 32), ks = j >> 3, tile = j & 7;
            const int koff = ks < 2 ? 768 * ks : 1536 + 640 * (ks - 2), klen = ks < 2 ? 768 : 640;
            pg8::Gemm g{P.hbuf + koff, P.wd2t + koff, M, 1024, klen, 2816}; pg8::OneUnit S; S.u0.pm = 64 + (tile & 1); S.u0.pn = tile >> 1; S.on = true;
            pg8::EpiPartial E{P.ds + (size_t)ks * NSAMP * 1024};
            pg8::gemm_phase<pg8::EpiPartial, pg8::OneUnit, true, true>(lds, g, S, E); }
    }
    SEAM(10);
    if (IN(11)) final_sample(P, P.ds, wave, lane, vcu, G);
#undef IN
#undef SEAM
}

extern "C" void kernel_launch(void* const* d_in, const int* in_sizes, int n_in, void* d_out, int out_size, void* d_ws, size_t ws_size, hipStream_t stream) {
    static int grid = 0;
    if (grid == 0) {
        if (n_in != 22 || (size_t)out_size != O_END || ws_size < WS_END) { fprintf(stderr, "kernel_launch: unexpected shapes (n_in %d, out %d, ws %zu); nothing launched\n", n_in, out_size, ws_size); grid = -1; return; }
        int dev = 0, cus = 0, per_cu = 0;
        if (hipGetDevice(&dev) != hipSuccess || hipDeviceGetAttribute(&cus, hipDeviceAttributeMultiprocessorCount, dev) != hipSuccess) { grid = -1; return; }
        if (hipFuncSetAttribute((const void*)hymba_fwd, hipFuncAttributeMaxDynamicSharedMemorySize, LDS_BYTES) != hipSuccess) { fprintf(stderr, "kernel_launch: hipFuncSetAttribute failed\n"); grid = -1; return; }
        if (hipOccupancyMaxActiveBlocksPerMultiprocessor(&per_cu, (const void*)hymba_fwd, NTHR, LDS_BYTES) != hipSuccess || per_cu < 1) { fprintf(stderr, "kernel_launch: occupancy query says %d blocks per CU\n", per_cu); (void)hipGetLastError(); grid = -1; return; }
        grid = cus;
    }
    if (grid < 0) return;
    if (hipMemsetAsync((char*)d_ws + WS_CTL, 0, CTL_ZERO_BYTES, stream) != hipSuccess) return;
    Args a{};
    for (int i = 0; i < 22; ++i) a.in[i] = (const float*)d_in[i];
    a.out = (float*)d_out; a.ws = (unsigned char*)d_ws;
#if MK_N_LAUNCHES == 1
    void* kargs[] = {&a};
#if PROBE_REP_HI >= 0
    a.ph_lo = 0; a.ph_hi = PROBE_REP_HI + 1; a.bar_region = 1;
    (void)hipLaunchCooperativeKernel((const void*)hymba_fwd, dim3(grid), dim3(NTHR), kargs, LDS_BYTES, stream);
#endif
    a.ph_lo = 0; a.ph_hi = N_PHASES; a.bar_region = 0;
    hipError_t e = hipLaunchCooperativeKernel((const void*)hymba_fwd, dim3(grid), dim3(NTHR), kargs, LDS_BYTES, stream);
    if (e != hipSuccess) fprintf(stderr, "kernel_launch: cooperative launch failed: %s (grid %d)\n", hipGetErrorString(e), grid);
#else
    for (int p = 0; p < N_PHASES; ++p) { a.ph_lo = p; a.ph_hi = p + 1; hipLaunchKernelGGL(hymba_fwd, dim3(grid), dim3(NTHR), LDS_BYTES, stream, a); }
#endif
}
```

```cpp
#include <hip/hip_runtime.h>
#include <hip/hip_cooperative_groups.h>
#include <cstdio>
#include <cstdint>
namespace cg = cooperative_groups;

constexpr int D = 1024, SEQ = 16384, NSAMP = 512, M = SEQ + NSAMP, FF = 2816, DIN = 2320, NPROJ = 2560;
constexpr int DECB = 128, DECT = 4;
constexpr float EPS = 1e-6f;
namespace pg8 {
#define PG8_LAS __attribute__((address_space(3)))
typedef unsigned short bf16_t;
typedef short bf16x8 __attribute__((ext_vector_type(8)));
typedef float f32x4 __attribute__((ext_vector_type(4)));
typedef unsigned u32x4 __attribute__((ext_vector_type(4)));
constexpr int BM = 256, BK = 64, HALF = 128, HTB = HALF * BK * 2  , STAGE_BYTES = 8 * HTB, NXCD = 8, WGM = 8;

__host__ __device__ __forceinline__ int lds_byte(int r, int c) { const int st = (r >> 4) * 2 + (c >> 5), rr = r & 15, cc = c & 31, ob = rr * 64 + cc * 2; return st * 1024 + (ob ^ (((ob >> 9) & 1) << 5)); }
__host__ __device__ __forceinline__ void stage_rc(int b, int& R, int& C) { const int st = b / 1024, sb = b % 1024, swz = sb ^ (((sb >> 9) & 1) << 5); R = (st >> 1) * 16 + swz / 64; C = (st & 1) * 32 + (swz % 64) / 2; }
__host__ __device__ __forceinline__ int perm32(int rho) { const int n = rho >> 4, i = rho & 15; return 8 * (i >> 2) + 4 * n + (i & 3); }

struct Unit { int pm, pn; };
struct Gemm { const bf16_t* A; const bf16_t* Bt; int M, N, K, ld; };

struct StaticOrder {
    int nM, nN, nwg, G, c;
    __host__ __device__ void init(int M, int N, int G_, int c_) { nM = M / BM; nN = N / BM; nwg = nM * nN; G = G_; c = c_; }
    __host__ __device__ bool next(int i, Unit& u) const {
        const long L = (long)i * G + c; if (L >= nwg) return false;
        int wgid = (int)L; { const int q = nwg / NXCD, r = nwg % NXCD, xcd = wgid % NXCD, off = wgid / NXCD; wgid = (xcd < r ? xcd * (q + 1) : r * (q + 1) + (xcd - r) * q) + off; }
        const int nig = WGM * nN, gid = wgid / nig, fm = gid * WGM, gsz = (nM - fm) < WGM ? (nM - fm) : WGM;
        u.pm = fm + ((wgid % nig) % gsz); u.pn = (wgid % nig) / gsz; return true;
    }
    __device__ __forceinline__ void a_ready(const Unit&) const {}
    __device__ __forceinline__ void done(const Unit&) const {}
};

__device__ __forceinline__ unsigned cvt_pk_bf16(float lo, float hi) { unsigned r; asm volatile("v_cvt_pk_bf16_f32 %0, %1, %2" : "=v"(r) : "v"(lo), "v"(hi)); return r; }
typedef float f32x2 __attribute__((ext_vector_type(2)));
__device__ __forceinline__ float row_rs16(const float* ss, int row) {
    const f32x4* p = (const f32x4*)(ss + (size_t)row * 16);
    const f32x4 t = (p[0] + p[1]) + (p[2] + p[3]);
    return rsqrtf(((t[0] + t[1]) + (t[2] + t[3])) * (1.0f / 1024.0f) + 1e-6f);
}
__device__ __forceinline__ void unit_rs_table(const float* ss, int pm, PG8_LAS float* rsS) {
    const int tid = threadIdx.x;
    if (tid < 256) rsS[tid] = row_rs16(ss, pm * BM + tid);
    asm volatile("s_waitcnt lgkmcnt(0)" ::: "memory"); __builtin_amdgcn_s_barrier(); asm volatile("" ::: "memory");
}
__device__ __forceinline__ float silu_f(float g) { return g * __builtin_amdgcn_rcpf(1.0f + __builtin_amdgcn_exp2f(-1.4426950408889634f * g)); }

struct EpiGU {
    static constexpr bool PERM = true, AFTER_DRAIN = false;
    bf16_t* H; const float* ss; PG8_LAS float* rsS;
    __device__ __forceinline__ void operator()(const f32x4 (&acc)[2][2][4][2], const Unit& u, int wr, int wc, int fr, int fq) const {
        const int row0 = u.pm * BM + wr * 64 + fr;
        const int col0 = u.pn * 128 + wc * 32 + 8 * fq;
        unit_rs_table(ss, u.pm, rsS);
#pragma unroll
        for (int ai = 0; ai < 2; ++ai)
#pragma unroll
            for (int m = 0; m < 4; ++m) {
                const int row = row0 + ai * HALF + m * 16;
                const float rs = rsS[ai * HALF + wr * 64 + m * 16 + fr];
                float h[8];
#pragma unroll
                for (int n = 0; n < 2; ++n)
#pragma unroll
                    for (int e = 0; e < 4; ++e) { const float g = acc[ai][0][m][n][e] * rs, up = acc[ai][1][m][n][e] * rs; h[4 * n + e] = silu_f(g) * up; }
                u32x4 w; w.x = cvt_pk_bf16(h[0], h[1]); w.y = cvt_pk_bf16(h[2], h[3]); w.z = cvt_pk_bf16(h[4], h[5]); w.w = cvt_pk_bf16(h[6], h[7]);
                *(u32x4*)(H + (size_t)row * 2816 + col0) = w;
            }
    }
};

struct EpiRes {
    static constexpr bool PERM = true, AFTER_DRAIN = false;
    bf16_t* xb; float* ss; float scale;
    __device__ __forceinline__ void operator()(const f32x4 (&acc)[2][2][4][2], const Unit& u, int wr, int wc, int fr, int fq) const {
        const int row0 = u.pm * BM + wr * 64 + fr;
        const int col0 = u.pn * BM + wc * 32 + 8 * fq;
        u32x4 res[2][4][2];
#pragma unroll
        for (int ai = 0; ai < 2; ++ai)
#pragma unroll
            for (int m = 0; m < 4; ++m)
#pragma unroll
                for (int bj = 0; bj < 2; ++bj) res[ai][m][bj] = *(const u32x4*)(xb + (size_t)(row0 + ai * HALF + m * 16) * 1024 + col0 + bj * HALF);
#pragma unroll
        for (int ai = 0; ai < 2; ++ai)
#pragma unroll
            for (int m = 0; m < 4; ++m) {
                const int row = row0 + ai * HALF + m * 16;
                bf16_t* rp = xb + (size_t)row * 1024 + col0;
                float sq = 0.f;
#pragma unroll
                for (int bj = 0; bj < 2; ++bj) {
                    const u32x4 r = res[ai][m][bj];
                    const f32x4 r0 = (f32x4){__uint_as_float(r.x << 16), __uint_as_float(r.x & 0xffff0000u), __uint_as_float(r.y << 16), __uint_as_float(r.y & 0xffff0000u)};
                    const f32x4 r1 = (f32x4){__uint_as_float(r.z << 16), __uint_as_float(r.z & 0xffff0000u), __uint_as_float(r.w << 16), __uint_as_float(r.w & 0xffff0000u)};
                    const f32x4 v0 = r0 + acc[ai][bj][m][0] * scale, v1 = r1 + acc[ai][bj][m][1] * scale;
                    sq += (v0[0] * v0[0] + v0[1] * v0[1]) + (v0[2] * v0[2] + v0[3] * v0[3]);
                    sq += (v1[0] * v1[0] + v1[1] * v1[1]) + (v1[2] * v1[2] + v1[3] * v1[3]);
                    u32x4 w; w.x = cvt_pk_bf16(v0[0], v0[1]); w.y = cvt_pk_bf16(v0[2], v0[3]); w.z = cvt_pk_bf16(v1[0], v1[1]); w.w = cvt_pk_bf16(v1[2], v1[3]);
                    *(u32x4*)(rp + bj * HALF) = w;
                }
                sq += __shfl_xor(sq, 16); sq += __shfl_xor(sq, 32);
                if (fq == 0) ss[(size_t)row * 16 + u.pn * 4 + wc] = sq;
            }
    }
};

struct EpiProj {
    static constexpr bool PERM = true, AFTER_DRAIN = false;
    const float* ss; bf16_t *qg, *kg, *vg, *rg, *qs, *kvs; float* alr; float *ckp, *cvp, *cks, *cvs; PG8_LAS float* rsS;
    __device__ __forceinline__ void operator()(const f32x4 (&acc)[2][2][4][2], const Unit& u, int wr, int wc, int fr, int fq) const {
        const int row0 = u.pm * BM + wr * 64 + fr;
        const int pn = u.pn;
        unit_rs_table(ss, u.pm, rsS);
#pragma unroll
        for (int ai = 0; ai < 2; ++ai)
#pragma unroll
            for (int m = 0; m < 4; ++m) {
                const int row = row0 + ai * HALF + m * 16;
                const float rs = rsS[ai * HALF + wr * 64 + m * 16 + fr];
#pragma unroll
                for (int bj = 0; bj < 2; ++bj) {
                    const int cl = bj * HALF + wc * 32 + 8 * fq;
                    f32x4 v0 = acc[ai][bj][m][0] * rs, v1 = acc[ai][bj][m][1] * rs;
                    if (pn == 9) {
                        if (cl < 16) { float* p = alr + (size_t)row * 16 + cl; *(f32x4*)p = v0; *(f32x4*)(p + 4) = v1; }
                        continue;
                    }
                    bf16_t* dst;
                    if (pn == 0) { dst = qg + (size_t)row * 256 + cl; v0 = v0 * 0.125f; v1 = v1 * 0.125f; }
                    else if (pn == 1) { dst = kg + (size_t)row * 256 + cl; }
                    else if (pn < 4) { dst = vg + (size_t)row * 512 + (pn - 2) * 256 + cl; }
                    else if (pn < 6) { dst = rg + (size_t)row * 512 + (pn - 4) * 256 + cl;
#pragma unroll
                        for (int e = 0; e < 4; ++e) { v0[e] = silu_f(v0[e]); v1[e] = silu_f(v1[e]); } }
                    else if (pn < 8) { dst = qs + (size_t)row * 512 + (pn - 6) * 256 + cl; v0 = v0 * 0.125f; v1 = v1 * 0.125f; }
                    else { dst = kvs + (size_t)row * 256 + cl;
                        float* cp = nullptr;
                        if (row >= 16384) { const int sr = row - 16384; cp = (bj ? cvs : cks) + ((size_t)(sr >> 2) * 128 + 124 + (sr & 3)) * 128 + (cl & 127); }
                        else if (row >= 16384 - 128) { cp = (bj ? cvp : ckp) + (size_t)(row - (16384 - 128)) * 128 + (cl & 127); }
                        if (cp) { *(f32x4*)cp = v0; *(f32x4*)(cp + 4) = v1; }
                    }
                    u32x4 w; w.x = cvt_pk_bf16(v0[0], v0[1]); w.y = cvt_pk_bf16(v0[2], v0[3]); w.z = cvt_pk_bf16(v1[0], v1[1]); w.w = cvt_pk_bf16(v1[2], v1[3]);
                    *(u32x4*)dst = w;
                }
            }
    }
};

struct EpiPartial {
    static constexpr bool PERM = true, AFTER_DRAIN = false;
    float* slab;
    __device__ __forceinline__ void operator()(const f32x4 (&acc)[2][2][4][2], const Unit& u, int wr, int wc, int fr, int fq) const {
        const int row0 = (u.pm - 64) * BM + wr * 64 + fr;
        const int col0 = u.pn * BM + wc * 32 + 8 * fq;
#pragma unroll
        for (int ai = 0; ai < 2; ++ai)
#pragma unroll
            for (int m = 0; m < 4; ++m) { float* rp = slab + (size_t)(row0 + ai * HALF + m * 16) * 1024 + col0;
#pragma unroll
                for (int bj = 0; bj < 2; ++bj) { *(f32x4*)(rp + bj * HALF) = acc[ai][bj][m][0]; *(f32x4*)(rp + bj * HALF + 4) = acc[ai][bj][m][1]; } }
    }
};
struct SubOrder {
    StaticOrder S; int pm0; bool on;
    __device__ __forceinline__ void init(int nMp, int N, int b0, int nb, int pm0_, int bx) { on = (bx >= b0) && (bx < b0 + nb); S.init(nMp * BM, N, nb, on ? bx - b0 : 0); pm0 = pm0_; }
    __device__ __forceinline__ bool next(int i, Unit& u) const { if (!on) return false; if (!S.next(i, u)) return false; u.pm += pm0; return true; }
    __device__ __forceinline__ void a_ready(const Unit&) const {}
    __device__ __forceinline__ void done(const Unit&) const {}
};
struct OneUnit {
    Unit u0; bool on;
    __device__ __forceinline__ bool next(int i, Unit& u) const { if (!on || i != 0) return false; u = u0; return true; }
    __device__ __forceinline__ void a_ready(const Unit&) const {}
    __device__ __forceinline__ void done(const Unit&) const {}
};
template <class Epi, class Sched, bool ALIGN_EPI = false, bool SP2 = false>
__device__ __forceinline__ void gemm_phase(PG8_LAS unsigned char* lds, const Gemm g, const Sched& S, const Epi& E) {
    const int tid = threadIdx.x, wid = __builtin_amdgcn_readfirstlane(tid >> 6), lane = tid & 63, wr = wid >> 2, wc = wid & 3, fr = lane & 15, fq = lane >> 4;
    const int K = g.ld, nt = g.K / BK;
    unsigned voffA[2], voffB[2];
#pragma unroll
    for (int i = 0; i < 2; ++i) { int R, C; stage_rc(tid * 16 + i * 8192, R, C); const int Rb = Epi::PERM ? ((R & ~31) + perm32(R & 31)) : R;
        voffA[i] = (unsigned)(R * K + C) * 2u; voffB[i] = (unsigned)(Rb * K + C) * 2u; }
    const size_t kstep = (size_t)(BK * 2);
    const size_t hstep = (size_t)HALF * K * 2;
    const size_t tstep = 2 * hstep;
    const unsigned ldsw = (unsigned)wid * 1024u;
    const int aoff = lds_byte(wr * 64 + fr, fq * 8), boff = lds_byte(wc * 32 + fr, fq * 8);
#define PG8_SA(b, h) (((b) * 2 + (h)) * HTB)
#define PG8_SB(b, h) ((4 + (b) * 2 + (h)) * HTB)
#define PG8_STAGE(bufoff, gbase, voff) do { _Pragma("unroll") for (int _i = 0; _i < 2; ++_i) \
        __builtin_amdgcn_global_load_lds((const unsigned*)((const char*)(gbase) + (voff)[_i]), (PG8_LAS unsigned*)(lds + (bufoff) + ldsw + _i * 8192), 16, 0, 0); } while (0)
#define PG8_LDA(dst, b, h) do { _Pragma("unroll") for (int m = 0; m < 4; ++m) _Pragma("unroll") for (int k = 0; k < 2; ++k) dst[m][k] = *(const PG8_LAS bf16x8*)(lds + PG8_SA(b, h) + aoff + m * 2048 + k * 1024); } while (0)
#define PG8_LDB(dst, b, h) do { _Pragma("unroll") for (int n = 0; n < 2; ++n) _Pragma("unroll") for (int k = 0; k < 2; ++k) dst[n][k] = *(const PG8_LAS bf16x8*)(lds + PG8_SB(b, h) + boff + n * 2048 + k * 1024); } while (0)
#define PG8_MMA(ai, bj, At, Bt) do { __builtin_amdgcn_s_setprio(1); _Pragma("unroll") for (int m = 0; m < 4; ++m) _Pragma("unroll") for (int n = 0; n < 2; ++n) _Pragma("unroll") for (int k = 0; k < 2; ++k) \
        acc[ai][bj][m][n] = __builtin_amdgcn_mfma_f32_16x16x32_bf16(Bt[n][k], At[m][k], acc[ai][bj][m][n], 0, 0, 0); __builtin_amdgcn_s_setprio(0); } while (0)
#define PG8_WAIT_V(n) asm volatile("s_waitcnt vmcnt(" #n ")" ::: "memory")
#define PG8_WAIT_L(n) asm volatile("s_waitcnt lgkmcnt(" #n ")" ::: "memory")
#define PG8_BAR __builtin_amdgcn_s_barrier()
#define PG8_SCHED __builtin_amdgcn_sched_barrier(0)
    Unit cur, nxt; int ui = 0;
    if (!S.next(0, cur)) return;
    f32x4 acc[2][2][4][2];
#pragma unroll
    for (int a = 0; a < 2; ++a)
#pragma unroll
        for (int b = 0; b < 2; ++b)
#pragma unroll
            for (int m = 0; m < 4; ++m)
#pragma unroll
                for (int n = 0; n < 2; ++n) acc[a][b][m][n] = (f32x4){0.f, 0.f, 0.f, 0.f};
    bf16x8 At[4][2], B0[2][2], B1[2][2];
    const char* cA = (const char*)g.A + (size_t)cur.pm * tstep; const char* cB = (const char*)g.Bt + (size_t)cur.pn * tstep;
    S.a_ready(cur);
    if constexpr (SP2) {
        PG8_STAGE(PG8_SB(0, 0), cB, voffB); PG8_STAGE(PG8_SB(0, 1), cB + hstep, voffB); PG8_STAGE(PG8_SA(0, 0), cA, voffA); PG8_STAGE(PG8_SA(0, 1), cA + hstep, voffA);
        if (wr == 1) PG8_BAR;
        PG8_WAIT_V(2); PG8_BAR;
        PG8_STAGE(PG8_SB(1, 0), cB + kstep, voffB); PG8_STAGE(PG8_SA(1, 0), cA + kstep, voffA); PG8_STAGE(PG8_SB(1, 1), cB + hstep + kstep, voffB);
        PG8_WAIT_V(6); PG8_BAR;
    } else {
        PG8_STAGE(PG8_SB(0, 0), cB, voffB); PG8_STAGE(PG8_SA(0, 0), cA, voffA); PG8_STAGE(PG8_SB(0, 1), cB + hstep, voffB); PG8_STAGE(PG8_SA(0, 1), cA + hstep, voffA);
        if (wr == 1) PG8_BAR;
        PG8_WAIT_V(4); PG8_BAR;
        PG8_STAGE(PG8_SB(1, 0), cB + kstep, voffB); PG8_STAGE(PG8_SA(1, 0), cA + kstep, voffA); PG8_STAGE(PG8_SB(1, 1), cB + hstep + kstep, voffB);
        PG8_WAIT_V(6); PG8_BAR;
    }
    for (;;) {
        const bool has_next = S.next(ui + 1, nxt);
        const char* nA = has_next ? (const char*)g.A + (size_t)nxt.pm * tstep : cA; const char* nB = has_next ? (const char*)g.Bt + (size_t)nxt.pn * tstep : cB;
        for (int t = 0; t < nt; t += 2) {
            const bool last = (t == nt - 2);
            const char* a1 = cA + (size_t)(t + 1) * kstep;
            const char* a2 = last ? nA : cA + (size_t)(t + 2) * kstep; const char* b2 = last ? nB : cB + (size_t)(t + 2) * kstep;
            const char* a3 = a2 + kstep; const char* b3 = b2 + kstep;
            if (last && has_next) S.a_ready(nxt);
            if constexpr (SP2) {
            PG8_LDB(B0, 0, 0); PG8_LDB(B1, 0, 1); PG8_SCHED; PG8_LDA(At, 0, 0); PG8_STAGE(PG8_SA(1, 1), a1 + hstep, voffA);
            PG8_WAIT_V(8); PG8_WAIT_L(0); PG8_BAR; PG8_MMA(0, 0, At, B0); PG8_MMA(0, 1, At, B1); PG8_BAR; PG8_SCHED;
            PG8_LDA(At, 0, 1); PG8_STAGE(PG8_SB(0, 0), b2, voffB); PG8_STAGE(PG8_SB(0, 1), b2 + hstep, voffB); PG8_STAGE(PG8_SA(0, 0), a2, voffA);
            PG8_WAIT_V(8); PG8_WAIT_L(0); PG8_BAR; PG8_MMA(1, 0, At, B0); PG8_MMA(1, 1, At, B1); PG8_BAR; PG8_SCHED;
            PG8_LDB(B0, 1, 0); PG8_LDB(B1, 1, 1); PG8_SCHED; PG8_LDA(At, 1, 0); PG8_STAGE(PG8_SA(0, 1), a2 + hstep, voffA);
            PG8_WAIT_V(8); PG8_WAIT_L(0); PG8_BAR; PG8_MMA(0, 0, At, B0); PG8_MMA(0, 1, At, B1); PG8_BAR; PG8_SCHED;
            PG8_LDA(At, 1, 1); PG8_STAGE(PG8_SB(1, 0), b3, voffB); PG8_STAGE(PG8_SB(1, 1), b3 + hstep, voffB); PG8_STAGE(PG8_SA(1, 0), a3, voffA);
            PG8_WAIT_V(8); PG8_WAIT_L(0); PG8_BAR; PG8_MMA(1, 0, At, B0); PG8_MMA(1, 1, At, B1); PG8_BAR; PG8_SCHED;
            } else {
            PG8_LDB(B0, 0, 0); PG8_SCHED; PG8_LDA(At, 0, 0); PG8_STAGE(PG8_SA(1, 1), a1 + hstep, voffA);
            PG8_WAIT_L(8); PG8_BAR; PG8_WAIT_L(0); PG8_MMA(0, 0, At, B0); PG8_BAR; PG8_SCHED;
            PG8_LDB(B1, 0, 1); PG8_STAGE(PG8_SB(0, 0), b2, voffB);
            PG8_BAR; PG8_WAIT_L(0); PG8_MMA(0, 1, At, B1); PG8_BAR;
            PG8_LDA(At, 0, 1); PG8_STAGE(PG8_SA(0, 0), a2, voffA);
            PG8_BAR; PG8_WAIT_L(0); PG8_MMA(1, 0, At, B0); PG8_BAR; PG8_SCHED;
            PG8_STAGE(PG8_SB(0, 1), b2 + hstep, voffB);
            PG8_WAIT_V(6); PG8_BAR; PG8_MMA(1, 1, At, B1); PG8_BAR;
            PG8_LDB(B0, 1, 0); PG8_SCHED; PG8_LDA(At, 1, 0); PG8_STAGE(PG8_SA(0, 1), a2 + hstep, voffA);
            PG8_WAIT_L(8); PG8_BAR; PG8_WAIT_L(0); PG8_MMA(0, 0, At, B0); PG8_BAR; PG8_SCHED;
            PG8_LDB(B1, 1, 1); PG8_STAGE(PG8_SB(1, 0), b3, voffB);
            PG8_BAR; PG8_WAIT_L(0); PG8_MMA(0, 1, At, B1); PG8_BAR;
            PG8_LDA(At, 1, 1); PG8_STAGE(PG8_SA(1, 0), a3, voffA);
            PG8_BAR; PG8_WAIT_L(0); PG8_MMA(1, 0, At, B0); PG8_BAR; PG8_SCHED;
            PG8_STAGE(PG8_SB(1, 1), b3 + hstep, voffB);
            PG8_WAIT_V(6); PG8_BAR; PG8_MMA(1, 1, At, B1); PG8_BAR;
            }
        }
        if constexpr (ALIGN_EPI) { if (wr == 0) PG8_BAR; }
        if constexpr (!Epi::AFTER_DRAIN) { E(acc, cur, wr, wc, fr, fq); S.done(cur); }
        if (!has_next) break;
#pragma unroll
        for (int a = 0; a < 2; ++a)
#pragma unroll
            for (int b = 0; b < 2; ++b)
#pragma unroll
                for (int m = 0; m < 4; ++m)
#pragma unroll
                    for (int n = 0; n < 2; ++n) acc[a][b][m][n] = (f32x4){0.f, 0.f, 0.f, 0.f};
        cur = nxt; cA = nA; cB = nB; ++ui;
        if constexpr (ALIGN_EPI) { if (wr == 1) PG8_BAR; }
    }
    PG8_WAIT_V(0);
    if constexpr (!ALIGN_EPI) { if (wr == 0) PG8_BAR; }
    PG8_BAR;
    if constexpr (Epi::AFTER_DRAIN) { E.fused(acc, cur, wr, wc, fr, fq, lds, wid, lane); S.done(cur); }
#undef PG8_SA
#undef PG8_SB
#undef PG8_STAGE
#undef PG8_LDA
#undef PG8_LDB
#undef PG8_MMA
#undef PG8_WAIT_V
#undef PG8_WAIT_L
#undef PG8_BAR
#undef PG8_SCHED
}
}
#define GAS __attribute__((address_space(1)))
#define LAS __attribute__((address_space(3)))
typedef unsigned short bf16;
typedef unsigned v4u __attribute__((ext_vector_type(4)));
typedef float f32x4 __attribute__((ext_vector_type(4)));
typedef short bf16x8 __attribute__((ext_vector_type(8)));
typedef GAS unsigned gu32;
typedef GAS unsigned long long gu64;
#define RLX_AGENT __ATOMIC_RELAXED, __HIP_MEMORY_SCOPE_AGENT
#define LDS_WAIT() asm volatile("s_waitcnt lgkmcnt(0)" ::: "memory")
#define VM_WAIT() asm volatile("s_waitcnt vmcnt(0)" ::: "memory")
__device__ __forceinline__ unsigned long long rt() { return __builtin_amdgcn_s_memrealtime(); }
__device__ __forceinline__ unsigned f2bf(float f) { unsigned u = __builtin_bit_cast(unsigned, f); return (u + 0x7fffu + ((u >> 16) & 1u)) >> 16; }
__device__ __forceinline__ unsigned pk2(float lo, float hi) { return f2bf(lo) | (f2bf(hi) << 16); }

#define XB_TMO      128
#define XB_XCNT(j)  (256  + 64 * (j))
#define XB_XSUB(j)  (1280 + 64 * (j))
#define XB_XGEN(j)  (2304 + 64 * (j))
#define XB_TOP      3328
#define XB_TOPGEN   3392
#define XCD_BAR_WORDS 3456
#define XB_SPIN_CAP (1u << 18)

__device__ __forceinline__ unsigned xb_ld(unsigned* p)              { return __hip_atomic_load(p, __ATOMIC_RELAXED, __HIP_MEMORY_SCOPE_AGENT); }
__device__ __forceinline__ unsigned xb_add(unsigned* p, unsigned v) { return __hip_atomic_fetch_add(p, v, __ATOMIC_RELAXED, __HIP_MEMORY_SCOPE_AGENT); }
__device__ __forceinline__ unsigned xb_xcc_id() { return (unsigned)__builtin_amdgcn_s_getreg((3 << 11) | 20) & 0xFu; }
#define XB_SPIN(cond, bar) do { unsigned _sp = 0; while (cond) { __builtin_amdgcn_s_sleep(1); \
    if ((++_sp & 255u) == 0u) { if (xb_ld(&(bar)[XB_TMO])) break; if (_sp > XB_SPIN_CAP) { atomicAdd(&(bar)[XB_TMO], 1u); break; } } } } while (0)

struct XcdBarrier {
    unsigned* bar; unsigned x;
    volatile LAS unsigned* st;
};

__device__ __forceinline__ XcdBarrier xcd_barrier_post(unsigned* bar, volatile LAS unsigned* st) {
    XcdBarrier b; b.bar = bar; b.x = xb_xcc_id(); b.st = st;
    if (threadIdx.x == 0) (void)xb_add(&bar[XB_XCNT(b.x)], 1u);
    return b;
}
__device__ __forceinline__ void xcd_barrier_complete(unsigned* bar, unsigned x, unsigned& nloc, unsigned& nx) {
    const unsigned G = gridDim.x * gridDim.y * gridDim.z;
    unsigned sum, cnt, mine, sp = 0u;
    for (;;) {
        sum = 0u; cnt = 0u; mine = 0u;
#pragma unroll
        for (unsigned j = 0; j < 16; ++j) { const unsigned c = xb_ld(&bar[XB_XCNT(j)]); sum += c; cnt += (c > 0u) ? 1u : 0u; mine = (j == x) ? c : mine; }
        if (sum == G) break;
        __builtin_amdgcn_s_sleep(1);
        if ((++sp & 255u) == 0u) { if (xb_ld(&bar[XB_TMO])) break; if (sp > XB_SPIN_CAP) { atomicAdd(&bar[XB_TMO], 1u); break; } }
    }
    nloc = mine > 0u ? mine : 1u; nx = cnt > 0u ? cnt : 1u;
}

__device__ __forceinline__ void xcd_barrier(const XcdBarrier& b) {
    asm volatile("s_waitcnt vmcnt(0)" ::: "memory");
    __syncthreads();
    if (threadIdx.x == 0) {
        unsigned* bar = b.bar;
        __builtin_amdgcn_s_waitcnt(0);
        unsigned nloc = b.st[0], nx = b.st[1];
        if (nloc == 0u) { xcd_barrier_complete(bar, b.x, nloc, nx); b.st[0] = nloc; b.st[1] = nx; }
        const unsigned old = xb_add(&bar[XB_XSUB(b.x)], 1u);
        const unsigned gen = old / nloc;
        if (old + 1u == (gen + 1u) * nloc) {
            __builtin_amdgcn_fence(__ATOMIC_RELEASE, "agent");
            asm volatile("s_waitcnt vmcnt(0)" ::: "memory");
            const unsigned og = xb_add(&bar[XB_TOP], 1u);
            const unsigned tg = og / nx;
            if (og + 1u == (tg + 1u) * nx) xb_add(&bar[XB_TOPGEN], 1u);
            else XB_SPIN(xb_ld(&bar[XB_TOPGEN]) == tg, bar);
            __builtin_amdgcn_fence(__ATOMIC_ACQUIRE, "agent");
            xb_add(&bar[XB_XGEN(b.x)], 1u);
            asm volatile("s_waitcnt vmcnt(0)" ::: "memory");
        } else {
            XB_SPIN(xb_ld(&bar[XB_XGEN(b.x)]) == gen, bar);
            __builtin_amdgcn_fence(__ATOMIC_ACQUIRE, "agent");
            asm volatile("s_waitcnt vmcnt(0)" ::: "memory");
        }
    }
    __syncthreads();
}

constexpr size_t MiB = 1u << 20;
constexpr size_t WS_CTL = 0, CTL_ZERO_BYTES = 64 * 1024;
constexpr size_t SZ_WGU = (size_t)5632 * 1024 * 2, SZ_WD = (size_t)1024 * 2816 * 2, SZ_WIN = (size_t)NPROJ * 1024 * 2, SZ_WOUT = (size_t)1024 * 1024 * 2;
constexpr size_t WS_WGU1 = 1 * MiB, WS_WD1 = WS_WGU1 + SZ_WGU, WS_WGU2 = WS_WD1 + SZ_WD, WS_WD2 = WS_WGU2 + SZ_WGU, WS_WIN = WS_WD2 + SZ_WD, WS_WOUT = WS_WIN + SZ_WIN;
constexpr size_t SZ_ACT = (size_t)M * 1024 * 2;
constexpr size_t WS_XN = WS_WOUT + SZ_WOUT, WS_MIX = WS_XN + SZ_ACT, WS_SS = WS_MIX + SZ_ACT;
constexpr size_t SZ_SS = (size_t)M * 16 * 4, SZ_SSW = (size_t)M * 8 * 4, SZ_ALR = (size_t)M * 16 * 4, SZ_G = (size_t)256 * 4 * 64 * 4;
constexpr size_t WS_SSW = WS_SS + SZ_SS, WS_ALR = WS_SSW + SZ_SSW, WS_G = WS_ALR + SZ_ALR, WS_R = WS_G + SZ_G;
constexpr size_t SZ_R = (size_t)M * 2816 * 2;
constexpr size_t R_QG = 0, R_KG = R_QG + (size_t)M * 256 * 2, R_VG = R_KG + (size_t)M * 256 * 2, R_RG = R_VG + (size_t)M * 512 * 2, R_QS = R_RG + (size_t)M * 512 * 2,
                 R_KVS = R_QS + (size_t)M * 512 * 2, R_CUM = R_KVS + (size_t)M * 256 * 2, R_END = R_CUM + (size_t)SEQ * 256 * 4;
static_assert(R_END <= SZ_R, "projection overlay fits inside H");
constexpr size_t WS_DS = WS_R + SZ_R, SZ_DS = (size_t)256 * 4 * 64 * 128 * 4, WS_END = WS_DS + SZ_DS;
static_assert(WS_END <= 256 * MiB, "d_ws map");
constexpr size_t O_Y = 0, O_SP = (size_t)M * 1024, O_CKP = O_SP + 32768, O_CVP = O_CKP + 16384, O_SS = O_CVP + 16384, O_CKS = O_SS + (size_t)DECB * 32768, O_CVS = O_CKS + (size_t)DECB * 16384,
                 O_END = O_CVS + (size_t)DECB * 16384;
constexpr int RING_BYTES = 131072, MISC_OFF = RING_BYTES + 320, LDS_BYTES = 147456;
constexpr int NWAVES = 8, NTHR = 512;

struct Args {
    const float* in[22]; float* out; unsigned char* ws; int ph_lo, ph_hi, bar_region, pad;
};
struct Ptrs {
    const float *x_p, *x_s, *state0, *ck_in, *cv_in, *g_ffn1, *wg1, *wu1, *wd1, *g_mix, *w_in, *w_gate_up, *b_gate, *g_head, *g_swa, *sinks, *w_out, *g_ffn2, *wg2, *wu2, *wd2, *g_final;
    float* out;
    bf16 *wgu1, *wd1t, *wgu2, *wd2t, *wint, *woutt, *xn, *mix, *hbuf, *qg, *kg, *vg, *rg, *qs, *kvs;
    float *ss, *ssw, *alr, *g, *cum, *ds;
};

__device__ __forceinline__ float bflo(unsigned w) { return __uint_as_float(w << 16); }
__device__ __forceinline__ float bfhi(unsigned w) { return __uint_as_float(w & 0xffff0000u); }
__device__ __forceinline__ float bf1(bf16 b) { return __uint_as_float((unsigned)b << 16); }
__device__ __forceinline__ float wave_sum(float v) {
#pragma unroll
    for (int o = 1; o < 64; o <<= 1) v += __shfl_xor(v, o);
    return v;
}
__device__ __forceinline__ float logsig(float x) { return fminf(x, 0.f) - log1pf(__expf(-fabsf(x))); }
__device__ __forceinline__ bf16x8 frag(const LAS bf16* base, int row0, int ld, int k0, int fr, int fq) { return *(const LAS bf16x8*)(base + (row0 + fr) * ld + k0 + 8 * fq); }
#define MFMA16(a, b, c) __builtin_amdgcn_mfma_f32_16x16x32_bf16((a), (b), (c), 0, 0, 0)

__device__ __forceinline__ int dest_row(int kind, int n) {
    if (kind == 0) return n;
    if (kind == 1) return 256 * (n >> 7) + (n & 127);
    if (kind == 2) return 256 * (n >> 7) + 128 + (n & 127);
    return n < 1536 ? n : (n < 1552 ? 2304 + (n - 1536) : n - 16);
}
__device__ __forceinline__ void p0_transpose_item(const float* W, int K, int N, bf16* WT, int kind, const float* gain, LAS float* scr, int item, int lane) {
    const int nblk = (N + 31) / 32, kb = item / nblk, nb = item % nblk, k0 = 64 * kb, n0 = 32 * nb;
    const int kr = lane >> 3, n4 = (lane & 7) * 4; const bool ok = n0 + n4 < N;
    f32x4 v[8];
#pragma unroll
    for (int i = 0; i < 8; ++i) v[i] = ok ? *(const GAS f32x4*)(W + (size_t)(k0 + 8 * i + kr) * N + n0 + n4) : (f32x4){0.f, 0.f, 0.f, 0.f};
#pragma unroll
    for (int i = 0; i < 8; ++i) { LAS float* d = scr + (8 * i + kr) * 33 + n4; d[0] = v[i].x; d[1] = v[i].y; d[2] = v[i].z; d[3] = v[i].w; }
    LDS_WAIT(); asm volatile("" ::: "memory");
    const int c = lane & 7;
    f32x4 g0 = (f32x4){1.f, 1.f, 1.f, 1.f}, g1 = g0;
    if (gain) { g0 = *(const GAS f32x4*)(gain + k0 + 8 * c); g1 = *(const GAS f32x4*)(gain + k0 + 8 * c + 4); }
#pragma unroll
    for (int j = 0; j < 4; ++j) { const int n = (lane >> 3) + 8 * j; const LAS float* s = scr + (8 * c) * 33 + n;
        v4u o; o.x = pk2(s[0 * 33] * g0.x, s[1 * 33] * g0.y); o.y = pk2(s[2 * 33] * g0.z, s[3 * 33] * g0.w); o.z = pk2(s[4 * 33] * g1.x, s[5 * 33] * g1.y); o.w = pk2(s[6 * 33] * g1.z, s[7 * 33] * g1.w);
        if (n0 + n < N) *(GAS v4u*)(WT + (size_t)dest_row(kind, n0 + n) * K + k0 + 8 * c) = o; }
    LDS_WAIT(); asm volatile("" ::: "memory");
}
__device__ __forceinline__ void p0_prologue(const Ptrs& P, LAS unsigned char* lds, int tid, int wave, int lane, int vcu, int G) {
    LAS float* scr = (LAS float*)(lds + wave * 16384);
    const int gw = vcu * NWAVES + wave, NGW = G * NWAVES;
    constexpr int I_GU = (1024 / 64) * (2816 / 32), I_D = (2816 / 64) * (1024 / 32), I_IN = (1024 / 64) * ((DIN + 31) / 32), I_O = (1024 / 64) * (1024 / 32);
    constexpr int NITEMS = 4 * I_GU + 2 * I_D + I_IN + I_O;
    for (int it = gw; it < NITEMS; it += NGW) {
        int r = it;
        if (r < I_GU) { p0_transpose_item(P.wg1, 1024, 2816, P.wgu1, 1, P.g_ffn1, scr, r, lane); continue; } r -= I_GU;
        if (r < I_GU) { p0_transpose_item(P.wu1, 1024, 2816, P.wgu1, 2, P.g_ffn1, scr, r, lane); continue; } r -= I_GU;
        if (r < I_D)  { p0_transpose_item(P.wd1, 2816, 1024, P.wd1t, 0, nullptr, scr, r, lane); continue; } r -= I_D;
        if (r < I_GU) { p0_transpose_item(P.wg2, 1024, 2816, P.wgu2, 1, P.g_ffn2, scr, r, lane); continue; } r -= I_GU;
        if (r < I_GU) { p0_transpose_item(P.wu2, 1024, 2816, P.wgu2, 2, P.g_ffn2, scr, r, lane); continue; } r -= I_GU;
        if (r < I_D)  { p0_transpose_item(P.wd2, 2816, 1024, P.wd2t, 0, nullptr, scr, r, lane); continue; } r -= I_D;
        if (r < I_IN) { p0_transpose_item(P.w_in, 1024, DIN, P.wint, 3, P.g_mix, scr, r, lane); continue; } r -= I_IN;
        p0_transpose_item(P.w_out, 1024, 1024, P.woutt, 0, nullptr, scr, r, lane);
    }
    for (int m0 = gw; m0 < M; m0 += 2 * NGW) {
        const int m1 = m0 + NGW; const bool has1 = m1 < M; const int m1c = has1 ? m1 : m0;
        const float* xrow0 = (m0 < SEQ) ? P.x_p + (size_t)m0 * D : P.x_s + (size_t)(m0 - SEQ) * D;
        const float* xrow1 = (m1c < SEQ) ? P.x_p + (size_t)m1c * D : P.x_s + (size_t)(m1c - SEQ) * D;
        const GAS f32x4* xr0 = (const GAS f32x4*)xrow0 + lane; const GAS f32x4* xr1 = (const GAS f32x4*)xrow1 + lane;
        f32x4 v[4], w[4]; float s0 = 0.f, s1 = 0.f;
#pragma unroll
        for (int j = 0; j < 4; ++j) { v[j] = xr0[64 * j]; w[j] = xr1[64 * j]; }
#pragma unroll
        for (int j = 0; j < 4; ++j) { s0 += (v[j].x * v[j].x + v[j].y * v[j].y) + (v[j].z * v[j].z + v[j].w * v[j].w); s1 += (w[j].x * w[j].x + w[j].y * w[j].y) + (w[j].z * w[j].z + w[j].w * w[j].w); }
        s0 = wave_sum(s0); s1 = wave_sum(s1);
        GAS unsigned long long* o0 = (GAS unsigned long long*)(P.xn + (size_t)m0 * D) + lane;
        GAS unsigned long long* o1 = (GAS unsigned long long*)(P.xn + (size_t)m1c * D) + lane;
#pragma unroll
        for (int j = 0; j < 4; ++j) {
            o0[64 * j] = (unsigned long long)pk2(v[j].x, v[j].y) | ((unsigned long long)pk2(v[j].z, v[j].w) << 32);
            if (has1) o1[64 * j] = (unsigned long long)pk2(w[j].x, w[j].y) | ((unsigned long long)pk2(w[j].z, w[j].w) << 32); }
        if (lane < 16) { P.ss[(size_t)m0 * 16 + lane] = (lane == 0) ? s0 : 0.f; if (has1) P.ss[(size_t)m1 * 16 + lane] = (lane == 0) ? s1 : 0.f; }
    }
    {
        const int gt = vcu * NTHR + tid, NGT = G * NTHR;
        constexpr int PER_B = 124 * 128 / 4;
#pragma unroll 4
        for (int i = gt; i < 2 * DECB * PER_B; i += NGT) {
            const int which = i / (DECB * PER_B), r = i % (DECB * PER_B), b = r / PER_B, o = r % PER_B;
            const float* src = (which ? P.cv_in : P.ck_in) + (size_t)b * 16384 + 512 + 4 * o;
            float* dst = P.out + (which ? O_CVS : O_CKS) + (size_t)b * 16384 + 4 * o;
            *(f32x4*)dst = *(const f32x4*)src;
        }
    }
}

#define BAR_LDS() do { asm volatile("s_waitcnt lgkmcnt(0)" ::: "memory"); __builtin_amdgcn_s_barrier(); asm volatile("" ::: "memory"); } while (0)

struct GlRegs { f32x4 a; v4u kk; v4u vv[2]; float w[16]; float bg; };
__device__ __forceinline__ void gla_local_load(const Ptrs& P, int c, int h, int tid, GlRegs& R) {
    const int t0 = c * 64;
    { const int t = (tid & 255) >> 2, q = (tid & 3) * 4; R.a = *(const f32x4*)(P.alr + (size_t)(t0 + t) * 16 + q); }
    { const int j = tid >> 3, dc = tid & 7; R.kk = *(const v4u*)(P.kg + (size_t)(t0 + j) * 256 + 64 * h + 8 * dc); }
#pragma unroll
    for (int i = 0; i < 2; ++i) { const int q = tid + 512 * i, jj = q >> 4, cc = q & 15; R.vv[i] = *(const v4u*)(P.vg + (size_t)(t0 + jj) * 512 + 128 * h + 8 * cc); }
    const int d = tid & 63;
#pragma unroll
    for (int r = 0; r < 16; ++r) R.w[r] = P.w_gate_up[r * 256 + 64 * h + d];
    R.bg = P.b_gate[64 * h + d];
}
__device__ __forceinline__ void gla_local_unit(const Ptrs& P, LAS unsigned char* lds, int c, int h, int tid, int wave, int lane, const GlRegs& R) {
    LAS float* alrS = (LAS float*)(lds);
    LAS bf16* kS = (LAS bf16*)(lds + 4096);
    LAS float* segS = (LAS float*)(lds + 13312);
    LAS bf16* khT = (LAS bf16*)(lds + 15360);
    LAS bf16* vT = (LAS bf16*)(lds + 24576);
    const int t0 = c * 64, fr = lane & 15, fq = lane >> 4;
    if (tid < 256) { const int t = tid >> 2, q = (tid & 3) * 4; *(LAS f32x4*)(alrS + t * 16 + q) = R.a; }
    { const int j = tid >> 3, dc = tid & 7; *(LAS v4u*)(kS + j * 72 + 8 * dc) = R.kk; }
#pragma unroll
    for (int i = 0; i < 2; ++i) { const int q = tid + 512 * i, jj = q >> 4, cc = q & 15;
#pragma unroll
        for (int e = 0; e < 8; ++e) { const unsigned w = R.vv[i][e >> 1]; vT[(8 * cc + e) * 72 + jj] = (bf16)((e & 1) ? (w >> 16) : (w & 0xffffu)); } }
    BAR_LDS();
    const int d = tid & 63, seg = wave;
    float cum[8]; float run = 0.f;
#pragma unroll
    for (int i = 0; i < 8; ++i) { const LAS f32x4* ap = (const LAS f32x4*)(alrS + (8 * seg + i) * 16); float x = R.bg;
#pragma unroll
        for (int r4 = 0; r4 < 4; ++r4) { const f32x4 a = ap[r4]; x += (a[0] * R.w[4 * r4] + a[1] * R.w[4 * r4 + 1]) + (a[2] * R.w[4 * r4 + 2] + a[3] * R.w[4 * r4 + 3]); }
        run += logsig(x) * (1.0f / 16.0f); cum[i] = run; }
    segS[seg * 64 + d] = run;
    BAR_LDS();
    { float off = 0.f, last = 0.f;
#pragma unroll
      for (int s2 = 0; s2 < 8; ++s2) { const float v = segS[s2 * 64 + d]; last += v; off += (s2 < seg) ? v : 0.f; }
      unsigned pk[4];
#pragma unroll
      for (int i = 0; i < 8; i += 2) { const float ca = cum[i] + off, cb = cum[i + 1] + off;
          P.cum[(size_t)(t0 + 8 * seg + i) * 256 + 64 * h + d] = ca; P.cum[(size_t)(t0 + 8 * seg + i + 1) * 256 + 64 * h + d] = cb;
          pk[i >> 1] = pk2(bf1(kS[(8 * seg + i) * 72 + d]) * __expf(last - ca), bf1(kS[(8 * seg + i + 1) * 72 + d]) * __expf(last - cb)); }
      *(LAS v4u*)(khT + d * 72 + 8 * seg) = (v4u){pk[0], pk[1], pk[2], pk[3]};
      if (seg == 0) P.g[(size_t)(c * 4 + h) * 64 + d] = __expf(last); }
    BAR_LDS();
    { const int d0 = (wave & 3) * 16;
#pragma unroll
      for (int q = 0; q < 4; ++q) { const int dv0 = ((wave >> 2) * 4 + q) * 16; f32x4 acc = (f32x4){0.f, 0.f, 0.f, 0.f};
#pragma unroll
          for (int kk = 0; kk < 2; ++kk) acc = MFMA16(frag(vT, dv0, 72, 32 * kk, fr, fq), frag(khT, d0, 72, 32 * kk, fr, fq), acc);
          *(f32x4*)(P.ds + ((size_t)(c * 4 + h) * 64 + d0 + fr) * 128 + dv0 + 4 * fq) = acc; } }
}
__device__ __forceinline__ void gla_local_loop(const Ptrs& P, LAS unsigned char* lds, int first, int stride, int tid, int wave, int lane) {
    int u = first; if (u >= 1024) return;
    GlRegs R; gla_local_load(P, u >> 2, u & 3, tid, R);
    for (;;) {
        GlRegs C = R; const int un = u + stride; const bool more = un < 1024;
        if (more) gla_local_load(P, un >> 2, un & 3, tid, R);
        gla_local_unit(P, lds, u >> 2, u & 3, tid, wave, lane, C);
        BAR_LDS();
        if (!more) break; u = un;
    }
}

__device__ __forceinline__ void gla_sample_unit(const Ptrs& P, LAS unsigned char* lds, int b, int tid, int wave, int lane) {
    LAS float* cumS = (LAS float*)(lds);
    LAS float* qd = (LAS float*)(lds + 4096);
    LAS float* kd = (LAS float*)(lds + 8192);
    LAS float* ke = (LAS float*)(lds + 12288);
    LAS float* vS = (LAS float*)(lds + 16384);
    LAS float* attS = (LAS float*)(lds + 24576);
    LAS float* e3S = (LAS float*)(lds + 25088);
    const int r0 = SEQ + 4 * b;
#pragma unroll 1
    for (int i = 0; i < 2; ++i) { const int item = tid + 512 * i, t = item >> 8, col = item & 255; float x = P.b_gate[col];
#pragma unroll
        for (int r = 0; r < 16; ++r) x += P.alr[(size_t)(r0 + t) * 16 + r] * P.w_gate_up[r * 256 + col];
        cumS[t * 256 + col] = logsig(x) * (1.0f / 16.0f); }
    { const int t = tid >> 7, c4 = (tid & 127) * 4; const unsigned long long w = *(const unsigned long long*)(P.vg + (size_t)(r0 + t) * 512 + c4);
      vS[t * 512 + c4] = bflo((unsigned)w); vS[t * 512 + c4 + 1] = bfhi((unsigned)w); vS[t * 512 + c4 + 2] = bflo((unsigned)(w >> 32)); vS[t * 512 + c4 + 3] = bfhi((unsigned)(w >> 32)); }
    __syncthreads();
    if (tid < 256) { const int d = tid; const float c0 = cumS[d], c1 = c0 + cumS[256 + d], c2 = c1 + cumS[512 + d], c3 = c2 + cumS[768 + d];
        cumS[256 + d] = c1; cumS[512 + d] = c2; cumS[768 + d] = c3; e3S[d] = __expf(c3); }
    __syncthreads();
#pragma unroll 1
    for (int i = 0; i < 2; ++i) { const int item = tid + 512 * i, t = item >> 8, col = item & 255; const float cu = cumS[t * 256 + col], c3 = cumS[768 + col];
        const float q = bf1(P.qg[(size_t)(r0 + t) * 256 + col]), k = bf1(P.kg[(size_t)(r0 + t) * 256 + col]);
        qd[t * 256 + col] = q * __expf(cu); kd[t * 256 + col] = k * __expf(c3 - cu); ke[t * 256 + col] = k * __expf(-cu); }
    __syncthreads();
    { const int pr = tid >> 3, l8 = tid & 7, h = pr >> 4, i = (pr >> 2) & 3, j = pr & 3; float s = 0.f;
#pragma unroll
      for (int m = 0; m < 8; ++m) { const int col = 64 * h + l8 + 8 * m; s += qd[i * 256 + col] * ke[j * 256 + col]; }
      s += __shfl_xor(s, 1); s += __shfl_xor(s, 2); s += __shfl_xor(s, 4);
      if (l8 == 0) attS[pr] = (j <= i) ? s : 0.f; }
    __syncthreads();
    { const int h = tid >> 7, dv = tid & 127, c = 128 * h + dv;
      const float v0 = vS[c], v1 = vS[512 + c], v2 = vS[1024 + c], v3 = vS[1536 + c];
      float po[4] = {0.f, 0.f, 0.f, 0.f};
      const size_t sbase = ((size_t)(b * 4 + h) * 64) * 128 + dv;
#pragma unroll 1
      for (int d0 = 0; d0 < 64; d0 += 16) { float s0r[16];
#pragma unroll
          for (int dd = 0; dd < 16; ++dd) s0r[dd] = P.state0[sbase + (size_t)(d0 + dd) * 128];
#pragma unroll
          for (int dd = 0; dd < 16; ++dd) { const int col = 64 * h + d0 + dd; const float s0 = s0r[dd];
              P.out[O_SS + sbase + (size_t)(d0 + dd) * 128] = s0 * e3S[col] + ((kd[col] * v0 + kd[256 + col] * v1) + (kd[512 + col] * v2 + kd[768 + col] * v3));
              po[0] += qd[col] * s0; po[1] += qd[256 + col] * s0; po[2] += qd[512 + col] * s0; po[3] += qd[768 + col] * s0; } }
#pragma unroll
      for (int i = 0; i < 4; ++i) {
#pragma unroll
          for (int j = 0; j < 4; ++j) po[i] += attS[h * 16 + i * 4 + j] * ((j == 0) ? v0 : (j == 1) ? v1 : (j == 2) ? v2 : v3);
          const float sq = wave_sum(po[i] * po[i]); if (lane == 0) cumS[wave * 4 + i] = sq; }
      __syncthreads();
#pragma unroll
      for (int i = 0; i < 4; ++i) { const float tot = cumS[(2 * h) * 4 + i] + cumS[(2 * h + 1) * 4 + i];
          const float rs = rsqrtf(tot * (1.0f / 128.0f) + EPS);
          P.mix[(size_t)(r0 + i) * 1024 + c] = (bf16)f2bf(po[i] * rs * P.g_head[c] * bf1(P.rg[(size_t)(r0 + i) * 512 + c])); } }
    __syncthreads();
}

__device__ __forceinline__ void swa_sample_unit(const Ptrs& P, LAS unsigned char* lds, int b, int tid, int wave, int lane) {
    LAS float* qS = (LAS float*)(lds);
    LAS float* pS = (LAS float*)(lds + 8192);
    LAS float* kL = (LAS float*)(lds + 25600);
    LAS float* oP = (LAS float*)(lds + 93952);
    const int r0 = SEQ + 4 * b;
    { const int t = tid >> 7, c4 = (tid & 127) * 4;
      const unsigned long long w = *(const unsigned long long*)(P.qs + (size_t)(r0 + t) * 512 + c4);
      qS[t * 512 + c4] = bflo((unsigned)w); qS[t * 512 + c4 + 1] = bfhi((unsigned)w); qS[t * 512 + c4 + 2] = bflo((unsigned)(w >> 32)); qS[t * 512 + c4 + 3] = bfhi((unsigned)(w >> 32)); }
    { f32x4 kr[9];
#pragma unroll
      for (int i = 0; i < 9; ++i) { const int idx = tid + 512 * i, j = idx >> 5, c4 = (idx & 31) * 4;
          kr[i] = (f32x4){0.f, 0.f, 0.f, 0.f};
          if (idx < 4224) kr[i] = *(const f32x4*)((j < 128) ? P.ck_in + ((size_t)b * 128 + j) * 128 + c4 : P.out + O_CKS + ((size_t)b * 128 + 124 + (j - 128)) * 128 + c4); }
#pragma unroll
      for (int i = 0; i < 9; ++i) { const int idx = tid + 512 * i, j = idx >> 5, c4 = (idx & 31) * 4;
          if (idx < 4224) { LAS float* d = kL + j * 129 + c4; d[0] = kr[i].x; d[1] = kr[i].y; d[2] = kr[i].z; d[3] = kr[i].w; } } }
    __syncthreads();
    f32x4 vr[9];
#pragma unroll
    for (int i = 0; i < 9; ++i) { const int idx = tid + 512 * i, j = idx >> 5, c4 = (idx & 31) * 4;
        vr[i] = (f32x4){0.f, 0.f, 0.f, 0.f};
        if (idx < 4224) vr[i] = *(const f32x4*)((j < 128) ? P.cv_in + ((size_t)b * 128 + j) * 128 + c4 : P.out + O_CVS + ((size_t)b * 128 + 124 + (j - 128)) * 128 + c4); }
    if (tid < 264) {
        const int j = tid >> 1, kvh = tid & 1; float s[16];
#pragma unroll
        for (int i = 0; i < 16; ++i) s[i] = 0.f;
#pragma unroll 2
        for (int d = 0; d < 64; ++d) { const float kv = kL[j * 129 + 64 * kvh + d];
#pragma unroll
            for (int hl = 0; hl < 4; ++hl)
#pragma unroll
                for (int t = 0; t < 4; ++t) s[hl * 4 + t] += qS[t * 512 + 64 * (4 * kvh + hl) + d] * kv; }
#pragma unroll
        for (int hl = 0; hl < 4; ++hl)
#pragma unroll
            for (int t = 0; t < 4; ++t) { const bool valid = (j <= 128 + t) && (j >= t + 1); pS[((4 * kvh + hl) * 4 + t) * 136 + j] = valid ? s[hl * 4 + t] : -INFINITY; }
    }
    __syncthreads();
#pragma unroll
    for (int i = 0; i < 9; ++i) { const int idx = tid + 512 * i, j = idx >> 5, c4 = (idx & 31) * 4;
        if (idx < 4224) { LAS float* d = kL + j * 129 + c4; d[0] = vr[i].x; d[1] = vr[i].y; d[2] = vr[i].z; d[3] = vr[i].w; } }
    {
#pragma unroll 1
        for (int rr = 0; rr < 4; ++rr) { const int row = 4 * wave + rr, hh = row >> 2; const float sink = P.sinks[hh];
            float v0 = pS[row * 136 + lane], v1 = pS[row * 136 + 64 + lane], v2 = (lane < 4) ? pS[row * 136 + 128 + lane] : -INFINITY;
            float m = fmaxf(fmaxf(v0, v1), v2);
#pragma unroll
            for (int o = 1; o < 64; o <<= 1) m = fmaxf(m, __shfl_xor(m, o));
            m = fmaxf(m, sink);
            const float e0 = __expf(v0 - m), e1 = __expf(v1 - m), e2 = (lane < 4) ? __expf(v2 - m) : 0.f;
            const float den = wave_sum(e0 + e1 + e2) + __expf(sink - m), inv = 1.0f / den;
            pS[row * 136 + lane] = e0 * inv; pS[row * 136 + 64 + lane] = e1 * inv; if (lane < 4) pS[row * 136 + 128 + lane] = e2 * inv; }
    }
    __syncthreads();
    {
        const int part = tid >> 7, kvh = (tid >> 6) & 1, d = tid & 63; float o[16];
#pragma unroll
        for (int i = 0; i < 16; ++i) o[i] = 0.f;
#pragma unroll 1
        for (int jj = 0; jj < 33; ++jj) { const int j = part * 33 + jj; const float vv = kL[j * 129 + 64 * kvh + d];
#pragma unroll
            for (int hl = 0; hl < 4; ++hl)
#pragma unroll
                for (int t = 0; t < 4; ++t) o[hl * 4 + t] += pS[((4 * kvh + hl) * 4 + t) * 136 + j] * vv; }
#pragma unroll
        for (int hl = 0; hl < 4; ++hl)
#pragma unroll
            for (int t = 0; t < 4; ++t) oP[(part * 4 + t) * 512 + 64 * (4 * kvh + hl) + d] = o[hl * 4 + t];
    }
    __syncthreads();
    if (wave < 4) { const int t = wave; float v[8]; float sq = 0.f;
#pragma unroll
        for (int e = 0; e < 8; ++e) { const int c = lane + 64 * e; v[e] = (oP[(0 * 4 + t) * 512 + c] + oP[(1 * 4 + t) * 512 + c]) + (oP[(2 * 4 + t) * 512 + c] + oP[(3 * 4 + t) * 512 + c]); sq += v[e] * v[e]; }
        const float rs = rsqrtf(wave_sum(sq) * (1.0f / 512.0f) + EPS);
#pragma unroll
        for (int e = 0; e < 8; ++e) P.mix[(size_t)(r0 + t) * 1024 + 512 + lane + 64 * e] = (bf16)f2bf(v[e] * rs * P.g_swa[lane + 64 * e]); }
    __syncthreads();
}

__device__ __forceinline__ void gla_scan2(const Ptrs& P, LAS unsigned char* lds, int blk, int tid) {
    LAS float* As = (LAS float*)lds;
    LAS float* Ps = (LAS float*)(lds + 2048);
    const int seg = tid >> 6, el = tid & 63, e = blk * 64 + el, h = e >> 13, d = (e >> 7) & 63;
    float* dsp = P.ds + e + (size_t)(seg * 32) * 32768;
    const float* gp = P.g + h * 64 + d + (size_t)(seg * 32) * 256;
    float dsv[32], gv[32];
#pragma unroll
    for (int i = 0; i < 32; ++i) { dsv[i] = dsp[(size_t)i * 32768]; gv[i] = gp[(size_t)i * 256]; }
    float A = 0.f, Pm = 1.f;
#pragma unroll
    for (int i = 0; i < 32; ++i) { A = A * gv[i] + dsv[i]; Pm *= gv[i]; }
    As[seg * 64 + el] = A; Ps[seg * 64 + el] = Pm;
    __syncthreads();
    float S = 0.f;
    for (int s2 = 0; s2 < seg; ++s2) S = S * Ps[s2 * 64 + el] + As[s2 * 64 + el];
#pragma unroll
    for (int i = 0; i < 32; ++i) { dsp[(size_t)i * 32768] = S; S = S * gv[i] + dsv[i]; }
    if (seg == 7) P.out[O_SP + e] = S;
    __syncthreads();
}

struct SwRegs { v4u kk[3], vv[3], qq[2]; };
__device__ __forceinline__ void swa_prompt_load(const Ptrs& P, int qb, int g, int tid, SwRegs& R) {
    const int q0 = qb * 32, kbase = q0 - 128;
#pragma unroll
    for (int i = 0; i < 3; ++i) { const int q = tid + 512 * i, j = q >> 3, ch = q & 7, tok = kbase + j;
        R.kk[i] = (v4u){0u, 0u, 0u, 0u}; R.vv[i] = (v4u){0u, 0u, 0u, 0u};
        if (q < 1280 && tok >= 0) { const bf16* p = P.kvs + (size_t)tok * 256 + 64 * g + 8 * ch; R.kk[i] = *(const v4u*)p; R.vv[i] = *(const v4u*)(p + 128); } }
#pragma unroll
    for (int i = 0; i < 2; ++i) { const int q = tid + 512 * i, r = q >> 3, ch = q & 7, hl = r >> 5, ql = r & 31;
        R.qq[i] = *(const v4u*)(P.qs + (size_t)(q0 + ql) * 512 + 64 * (4 * g + hl) + 8 * ch); }
}
__device__ __forceinline__ void swa_prompt_unit(const Ptrs& P, LAS unsigned char* lds, int qb, int g, int tid, int wave, int lane, const SwRegs& R) {
    LAS bf16* Ks = (LAS bf16*)(lds);
    LAS bf16* VsT = (LAS bf16*)(lds + 23040);
    LAS bf16* Qs = (LAS bf16*)(lds + 44544);
    LAS bf16* Ps = (LAS bf16*)(lds + 62976);
    const int q0 = qb * 32, kbase = q0 - 128, fr = lane & 15, fq = lane >> 4;
#pragma unroll
    for (int i = 0; i < 3; ++i) { const int q = tid + 512 * i, j = q >> 3, ch = q & 7;
        if (q < 1280) { *(LAS v4u*)(Ks + j * 72 + 8 * ch) = R.kk[i];
#pragma unroll
            for (int e = 0; e < 8; ++e) { const unsigned w = R.vv[i][e >> 1]; VsT[(8 * ch + e) * 168 + j] = (bf16)((e & 1) ? (w >> 16) : (w & 0xffffu)); } } }
#pragma unroll
    for (int i = 0; i < 2; ++i) { const int q = tid + 512 * i, r = q >> 3, ch = q & 7; *(LAS v4u*)(Qs + r * 72 + 8 * ch) = R.qq[i]; }
    BAR_LDS();
    const int r0 = 16 * wave, head = 4 * g + (wave >> 1), ql0 = 16 * (wave & 1);
    const int qpos = q0 + ql0 + fr; const float sink = P.sinks[head];
    f32x4 s[10];
#pragma unroll
    for (int t = 0; t < 10; ++t) s[t] = (f32x4){0.f, 0.f, 0.f, 0.f};
#pragma unroll
    for (int kk = 0; kk < 2; ++kk) { const bf16x8 bq = frag(Qs, r0, 72, 32 * kk, fr, fq);
#pragma unroll
        for (int t = 0; t < 10; ++t) s[t] = MFMA16(frag(Ks, 16 * t, 72, 32 * kk, fr, fq), bq, s[t]); }
    float m = -INFINITY;
#pragma unroll
    for (int t = 0; t < 10; ++t)
#pragma unroll
        for (int r = 0; r < 4; ++r) { const int kpos = kbase + 16 * t + 4 * fq + r; const bool valid = (kpos >= 0) && (kpos <= qpos) && (qpos - kpos < 128);
            s[t][r] = valid ? s[t][r] : -INFINITY; m = fmaxf(m, s[t][r]); }
    m = fmaxf(m, __shfl_xor(m, 16)); m = fmaxf(m, __shfl_xor(m, 32)); m = fmaxf(m, sink);
    float sum = 0.f;
#pragma unroll
    for (int t = 0; t < 10; ++t)
#pragma unroll
        for (int r = 0; r < 4; ++r) { const float p = __expf(s[t][r] - m); s[t][r] = p; sum += p; }
    sum += __shfl_xor(sum, 16); sum += __shfl_xor(sum, 32);
    const float inv = 1.0f / (sum + __expf(sink - m));
#pragma unroll
    for (int t = 0; t < 10; ++t) { unsigned long long w = (unsigned long long)pk2(s[t][0] * inv, s[t][1] * inv) | ((unsigned long long)pk2(s[t][2] * inv, s[t][3] * inv) << 32);
        *(LAS unsigned long long*)(Ps + (r0 + fr) * 168 + 16 * t + 4 * fq) = w; }
    asm volatile("s_waitcnt lgkmcnt(0)" ::: "memory");
    f32x4 o[4];
#pragma unroll
    for (int dt = 0; dt < 4; ++dt) o[dt] = (f32x4){0.f, 0.f, 0.f, 0.f};
#pragma unroll
    for (int ks = 0; ks < 5; ++ks) { const bf16x8 bp = frag(Ps, r0, 168, 32 * ks, fr, fq);
#pragma unroll
        for (int dt = 0; dt < 4; ++dt) o[dt] = MFMA16(frag(VsT, 16 * dt, 168, 32 * ks, fr, fq), bp, o[dt]); }
    float sq = 0.f;
#pragma unroll
    for (int dt = 0; dt < 4; ++dt) sq += (o[dt][0] * o[dt][0] + o[dt][1] * o[dt][1]) + (o[dt][2] * o[dt][2] + o[dt][3] * o[dt][3]);
    sq += __shfl_xor(sq, 16); sq += __shfl_xor(sq, 32);
    if (fq == 0) P.ssw[(size_t)qpos * 8 + head] = sq;
#pragma unroll
    for (int dt = 0; dt < 4; ++dt) { const unsigned long long w = (unsigned long long)pk2(o[dt][0], o[dt][1]) | ((unsigned long long)pk2(o[dt][2], o[dt][3]) << 32);
        *(unsigned long long*)(P.mix + (size_t)qpos * 1024 + 512 + 64 * head + 16 * dt + 4 * fq) = w; }
}
__device__ __forceinline__ void swa_prompt_loop(const Ptrs& P, LAS unsigned char* lds, int first, int stride, int tid, int wave, int lane) {
    int u = first; if (u >= 1024) return;
    SwRegs R; swa_prompt_load(P, u >> 1, u & 1, tid, R);
    for (;;) {
        SwRegs C = R; const int un = u + stride; const bool more = un < 1024;
        if (more) swa_prompt_load(P, un >> 1, un & 1, tid, R);
        swa_prompt_unit(P, lds, u >> 1, u & 1, tid, wave, lane, C);
        BAR_LDS();
        if (!more) break; u = un;
    }
}

struct GoRegs { v4u qq, kk; f32x4 c0, c1; v4u vv[2]; f32x4 sv[4]; };
struct GoEpi { v4u r0, r1, a0, a1; f32x4 sa, sb; };
__device__ __forceinline__ void gla_out_load(const Ptrs& P, int c, int h, int tid, GoRegs& R) {
    const int t0 = c * 64, j = tid >> 3, dc = tid & 7;
    R.qq = *(const v4u*)(P.qg + (size_t)(t0 + j) * 256 + 64 * h + 8 * dc); R.kk = *(const v4u*)(P.kg + (size_t)(t0 + j) * 256 + 64 * h + 8 * dc);
    const float* cp = P.cum + (size_t)(t0 + j) * 256 + 64 * h + 8 * dc; R.c0 = *(const f32x4*)cp; R.c1 = *(const f32x4*)(cp + 4);
#pragma unroll
    for (int i = 0; i < 2; ++i) { const int q = tid + 512 * i, jj = q >> 4, cc = q & 15; R.vv[i] = *(const v4u*)(P.vg + (size_t)(t0 + jj) * 512 + 128 * h + 8 * cc); }
#pragma unroll
    for (int i = 0; i < 4; ++i) { const int q = tid + 512 * i, d = q >> 5, dv4 = (q & 31) * 4; R.sv[i] = *(const f32x4*)(P.ds + ((size_t)(c * 4 + h) * 64 + d) * 128 + dv4); }
}
__device__ __forceinline__ void gla_out_load_epi(const Ptrs& P, int c, int h, int tid, GoEpi& E) {
    const int i = tid >> 3, seg = tid & 7, tok = c * 64 + i, col = 128 * h + 16 * seg;
    E.r0 = *(const v4u*)(P.rg + (size_t)tok * 512 + col); E.r1 = *(const v4u*)(P.rg + (size_t)tok * 512 + col + 8);
    const bf16* mp = P.mix + (size_t)tok * 1024 + 512 + col; E.a0 = *(const v4u*)mp; E.a1 = *(const v4u*)(mp + 8);
    E.sa = *(const f32x4*)(P.ssw + (size_t)tok * 8); E.sb = *(const f32x4*)(P.ssw + (size_t)tok * 8 + 4);
}
__device__ __forceinline__ void gla_out_unit(const Ptrs& P, LAS unsigned char* lds, int c, int h, int tid, int wave, int lane, const GoRegs& R, const GoEpi& E) {
    LAS bf16* qT = (LAS bf16*)(lds);
    LAS bf16* kT = (LAS bf16*)(lds + 9216);
    LAS bf16* vT = (LAS bf16*)(lds + 18432);
    LAS bf16* sT = (LAS bf16*)(lds + 36864);
    LAS bf16* aS = (LAS bf16*)(lds + 55296);
    LAS float* oS = (LAS float*)(lds + 64512);
    const int t0 = c * 64, fr = lane & 15, fq = lane >> 4;
    { const int j = tid >> 3, dc = tid & 7;
      float cu[8] = {R.c0[0], R.c0[1], R.c0[2], R.c0[3], R.c1[0], R.c1[1], R.c1[2], R.c1[3]}; v4u qo, ko;
#pragma unroll
      for (int e2 = 0; e2 < 4; ++e2) { const float ea = __expf(cu[2 * e2]), eb = __expf(cu[2 * e2 + 1]);
          qo[e2] = pk2(bflo(R.qq[e2]) * ea, bfhi(R.qq[e2]) * eb); ko[e2] = pk2(bflo(R.kk[e2]) / ea, bfhi(R.kk[e2]) / eb); }
      *(LAS v4u*)(qT + j * 72 + 8 * dc) = qo; *(LAS v4u*)(kT + j * 72 + 8 * dc) = ko;
#pragma unroll
      for (int i = 0; i < 2; ++i) { const int q = tid + 512 * i, jj = q >> 4, cc = q & 15;
#pragma unroll
          for (int e = 0; e < 8; ++e) { const unsigned w = R.vv[i][e >> 1]; vT[(8 * cc + e) * 72 + jj] = (bf16)((e & 1) ? (w >> 16) : (w & 0xffffu)); } }
#pragma unroll
      for (int i = 0; i < 4; ++i) { const int q = tid + 512 * i, d = q >> 5, dv4 = (q & 31) * 4;
#pragma unroll
          for (int e = 0; e < 4; ++e) sT[(dv4 + e) * 72 + d] = (bf16)f2bf(R.sv[i][e]); } }
    BAR_LDS();
    { const int i0 = (wave >> 1) * 16;
#pragma unroll
      for (int q = 0; q < 2; ++q) { const int j0 = ((wave & 1) * 2 + q) * 16; f32x4 acc = (f32x4){0.f, 0.f, 0.f, 0.f};
#pragma unroll
          for (int kk = 0; kk < 2; ++kk) acc = MFMA16(frag(kT, j0, 72, 32 * kk, fr, fq), frag(qT, i0, 72, 32 * kk, fr, fq), acc);
          const int i = i0 + fr, jb = j0 + 4 * fq;
          const unsigned long long w = (unsigned long long)pk2(jb <= i ? acc[0] : 0.f, jb + 1 <= i ? acc[1] : 0.f) | ((unsigned long long)pk2(jb + 2 <= i ? acc[2] : 0.f, jb + 3 <= i ? acc[3] : 0.f) << 32);
          *(LAS unsigned long long*)(aS + i * 72 + jb) = w; } }
    BAR_LDS();
    { const int i0 = (wave & 3) * 16;
#pragma unroll
      for (int q = 0; q < 4; ++q) { const int dv0 = ((wave >> 2) * 4 + q) * 16; f32x4 acc = (f32x4){0.f, 0.f, 0.f, 0.f};
#pragma unroll
          for (int kk = 0; kk < 2; ++kk) { acc = MFMA16(frag(vT, dv0, 72, 32 * kk, fr, fq), frag(aS, i0, 72, 32 * kk, fr, fq), acc);
                                           acc = MFMA16(frag(sT, dv0, 72, 32 * kk, fr, fq), frag(qT, i0, 72, 32 * kk, fr, fq), acc); }
          *(LAS f32x4*)(oS + (i0 + fr) * 132 + dv0 + 4 * fq) = acc; } }
    BAR_LDS();
    { const int i = tid >> 3, seg = tid & 7, tok = t0 + i, col = 128 * h + 16 * seg;
      f32x4 ov[4]; float sq = 0.f;
#pragma unroll
      for (int e = 0; e < 4; ++e) { ov[e] = *(const LAS f32x4*)(oS + i * 132 + 16 * seg + 4 * e); sq += (ov[e][0] * ov[e][0] + ov[e][1] * ov[e][1]) + (ov[e][2] * ov[e][2] + ov[e][3] * ov[e][3]); }
      sq += __shfl_xor(sq, 1); sq += __shfl_xor(sq, 2); sq += __shfl_xor(sq, 4);
      const float rs = rsqrtf(sq * (1.0f / 128.0f) + EPS);
      v4u w0, w1;
#pragma unroll
      for (int e2 = 0; e2 < 4; ++e2) { const int cc = col + 2 * e2;
          w0[e2] = pk2(ov[e2 >> 1][(2 * e2) & 3] * rs * P.g_head[cc] * bflo(E.r0[e2]), ov[e2 >> 1][(2 * e2 + 1) & 3] * rs * P.g_head[cc + 1] * bfhi(E.r0[e2]));
          w1[e2] = pk2(ov[2 + (e2 >> 1)][(2 * e2) & 3] * rs * P.g_head[cc + 8] * bflo(E.r1[e2]), ov[2 + (e2 >> 1)][(2 * e2 + 1) & 3] * rs * P.g_head[cc + 9] * bfhi(E.r1[e2])); }
      *(v4u*)(P.mix + (size_t)tok * 1024 + col) = w0; *(v4u*)(P.mix + (size_t)tok * 1024 + col + 8) = w1;
      const float rs2 = rsqrtf((((E.sa[0] + E.sa[1]) + (E.sa[2] + E.sa[3])) + ((E.sb[0] + E.sb[1]) + (E.sb[2] + E.sb[3]))) * (1.0f / 512.0f) + EPS);
      bf16* mp = P.mix + (size_t)tok * 1024 + 512 + col; v4u b0, b1;
#pragma unroll
      for (int e2 = 0; e2 < 4; ++e2) { const int cc = col + 2 * e2;
          b0[e2] = pk2(bflo(E.a0[e2]) * rs2 * P.g_swa[cc], bfhi(E.a0[e2]) * rs2 * P.g_swa[cc + 1]);
          b1[e2] = pk2(bflo(E.a1[e2]) * rs2 * P.g_swa[cc + 8], bfhi(E.a1[e2]) * rs2 * P.g_swa[cc + 9]); }
      *(v4u*)mp = b0; *(v4u*)(mp + 8) = b1; }
}
__device__ __forceinline__ void gla_out_loop(const Ptrs& P, LAS unsigned char* lds, int first, int stride, int tid, int wave, int lane) {
    int u = first; if (u >= 1024) return;
    GoRegs R; GoEpi E; gla_out_load(P, u >> 2, u & 3, tid, R); gla_out_load_epi(P, u >> 2, u & 3, tid, E);
    for (;;) {
        GoRegs C = R; const int un = u + stride; const bool more = un < 1024;
        if (more) gla_out_load(P, un >> 2, un & 3, tid, R);
        gla_out_unit(P, lds, u >> 2, u & 3, tid, wave, lane, C, E);
        if (more) gla_out_load_epi(P, un >> 2, un & 3, tid, E);
        BAR_LDS();
        if (!more) break; u = un;
    }
}

__device__ __forceinline__ void final_norm_prompt(const Ptrs& P, int wave, int lane, int bidx, int nb) {
    const int gw = bidx * NWAVES + wave, NGW = nb * NWAVES;
    f32x4 gg[4];
#pragma unroll
    for (int j = 0; j < 4; ++j) gg[j] = *((const GAS f32x4*)P.g_final + 4 * lane + j);
    for (int m0 = gw; m0 < SEQ; m0 += 4 * NGW) {
        v4u v[4][2]; float rs[4]; int mm[4];
#pragma unroll
        for (int r = 0; r < 4; ++r) { const int m = m0 + r * NGW; mm[r] = m < SEQ ? m : m0;
            const GAS v4u* xr = (const GAS v4u*)(P.xn + (size_t)mm[r] * D) + 2 * lane; v[r][0] = xr[0]; v[r][1] = xr[1]; }
#pragma unroll
        for (int r = 0; r < 4; ++r) rs[r] = pg8::row_rs16(P.ss, mm[r]);
#pragma unroll
        for (int r = 0; r < 4; ++r) { if (r > 0 && m0 + r * NGW >= SEQ) continue;
            GAS f32x4* yw = (GAS f32x4*)(P.out + (size_t)mm[r] * D) + 4 * lane;
#pragma unroll
            for (int j = 0; j < 4; ++j) { const unsigned a = v[r][j >> 1][(2 * j) & 3], b = v[r][j >> 1][(2 * j + 1) & 3];
                yw[j] = (f32x4){bflo(a), bfhi(a), bflo(b), bfhi(b)} * rs[r] * gg[j]; } }
    }
}
__device__ __forceinline__ void final_sample(const Ptrs& P, const float* slabs, int wave, int lane, int vcu, int G) {
    const int gw = vcu * NWAVES + wave, NGW = G * NWAVES;
    for (int r = gw; r < NSAMP; r += NGW) {
        const GAS unsigned long long* xb = (const GAS unsigned long long*)(P.xn + (size_t)(SEQ + r) * D) + lane;
        GAS f32x4* yr = (GAS f32x4*)(P.out + (size_t)(SEQ + r) * D) + lane;
        f32x4 v[4]; float s = 0.f;
#pragma unroll
        for (int j = 0; j < 4; ++j) { const GAS f32x4* sp = (const GAS f32x4*)(slabs + (size_t)r * D) + lane + 64 * j;
            const f32x4 a = (sp[0] + sp[(size_t)NSAMP * D / 4]) + (sp[(size_t)2 * NSAMP * D / 4] + sp[(size_t)3 * NSAMP * D / 4]);
            const unsigned long long w = xb[64 * j];
            v[j] = (f32x4){bflo((unsigned)w), bfhi((unsigned)w), bflo((unsigned)(w >> 32)), bfhi((unsigned)(w >> 32))} + a * 0.5f;
            s += (v[j].x * v[j].x + v[j].y * v[j].y) + (v[j].z * v[j].z + v[j].w * v[j].w); }
        const float rs = rsqrtf(wave_sum(s) * (1.f / D) + EPS);
#pragma unroll
        for (int j = 0; j < 4; ++j) { const f32x4 gg = *((const GAS f32x4*)P.g_final + lane + 64 * j); yr[64 * j] = v[j] * rs * gg; }
    }
}

#ifndef PROBE_REP_HI
#define PROBE_REP_HI (-1)
#endif
#ifndef MK_N_LAUNCHES
#define MK_N_LAUNCHES 1
#endif
constexpr int N_PHASES = 12;
__global__ void __launch_bounds__(NTHR, 2) hymba_fwd(Args args) {
    extern __shared__ __attribute__((aligned(16))) unsigned char lds_raw[];
    LAS unsigned char* lds = (LAS unsigned char*)lds_raw;
    volatile LAS unsigned* MISC = (volatile LAS unsigned*)(lds + MISC_OFF);
    const int tid = threadIdx.x, lane = tid & 63, wave = __builtin_amdgcn_readfirstlane(tid >> 6);
    const int G = gridDim.x, bx = blockIdx.x, vcu = (G % 8 == 0) ? (bx % 8) * (G / 8) + bx / 8 : bx;
    unsigned char* ws = args.ws;
    Ptrs P;
    P.x_p = args.in[0]; P.x_s = args.in[1]; P.state0 = args.in[2]; P.ck_in = args.in[3]; P.cv_in = args.in[4]; P.g_ffn1 = args.in[5]; P.wg1 = args.in[6]; P.wu1 = args.in[7]; P.wd1 = args.in[8];
    P.g_mix = args.in[9]; P.w_in = args.in[10]; P.w_gate_up = args.in[11]; P.b_gate = args.in[12]; P.g_head = args.in[13]; P.g_swa = args.in[14]; P.sinks = args.in[15]; P.w_out = args.in[16];
    P.g_ffn2 = args.in[17]; P.wg2 = args.in[18]; P.wu2 = args.in[19]; P.wd2 = args.in[20]; P.g_final = args.in[21];
    P.out = args.out;
    P.wgu1 = (bf16*)(ws + WS_WGU1); P.wd1t = (bf16*)(ws + WS_WD1); P.wgu2 = (bf16*)(ws + WS_WGU2); P.wd2t = (bf16*)(ws + WS_WD2); P.wint = (bf16*)(ws + WS_WIN); P.woutt = (bf16*)(ws + WS_WOUT);
    P.xn = (bf16*)(ws + WS_XN); P.mix = (bf16*)(ws + WS_MIX); P.hbuf = (bf16*)(ws + WS_R);
    P.qg = (bf16*)(ws + WS_R + R_QG); P.kg = (bf16*)(ws + WS_R + R_KG); P.vg = (bf16*)(ws + WS_R + R_VG); P.rg = (bf16*)(ws + WS_R + R_RG); P.qs = (bf16*)(ws + WS_R + R_QS); P.kvs = (bf16*)(ws + WS_R + R_KVS);
    P.cum = (float*)(ws + WS_R + R_CUM);
    P.ss = (float*)(ws + WS_SS); P.ssw = (float*)(ws + WS_SSW); P.alr = (float*)(ws + WS_ALR); P.g = (float*)(ws + WS_G); P.ds = (float*)(ws + WS_DS);

    for (int u = tid; u < (LDS_BYTES - RING_BYTES) / 4; u += NTHR) ((LAS unsigned*)(lds + RING_BYTES))[u] = 0u;
    __syncthreads();
    const int lo = args.ph_lo, hi = args.ph_hi;
    unsigned* barw = (unsigned*)(ws + WS_CTL) + args.bar_region * XCD_BAR_WORDS;
    XcdBarrier bar; bar.bar = barw; bar.x = 0; bar.st = nullptr;
    if (hi - lo > 1) bar = xcd_barrier_post(barw, MISC + 8);
#define IN(k) (lo <= (k) && (k) < hi)
#define SEAM(k) do { if (IN(k) && IN((k) + 1)) xcd_barrier(bar); } while (0)

    if (IN(0)) p0_prologue(P, lds, tid, wave, lane, vcu, G);
    SEAM(0);
    if (IN(1)) { pg8::Gemm g{P.xn, P.wgu1, M, 5632, 1024, 1024}; pg8::StaticOrder S; S.init(M, 5632, G, bx); pg8::EpiGU E{P.hbuf, P.ss, (LAS float*)(lds + RING_BYTES + 1024)};
        pg8::gemm_phase<pg8::EpiGU, pg8::StaticOrder, true, true>(lds, g, S, E); }
    SEAM(1);
    if (IN(2)) { pg8::Gemm g{P.hbuf, P.wd1t, M, 1024, 2816, 2816}; pg8::SubOrder S; S.init(64, 1024, 0, G, 0, bx); pg8::EpiRes E{P.xn, P.ss, 0.5f};
        pg8::gemm_phase<pg8::EpiRes, pg8::SubOrder, true, true>(lds, g, S, E); }
    SEAM(2);
    if (IN(3)) {
        if (bx < G - 8) { pg8::Gemm g{P.xn, P.wint, M, NPROJ, 1024, 1024}; pg8::SubOrder S; S.init(64, NPROJ, 0, G - 8, 0, bx);
            pg8::EpiProj E{P.ss, P.qg, P.kg, P.vg, P.rg, P.qs, P.kvs, P.alr, P.out + O_CKP, P.out + O_CVP, P.out + O_CKS, P.out + O_CVS, (LAS float*)(lds + RING_BYTES + 1024)};
            pg8::gemm_phase<pg8::EpiProj, pg8::SubOrder, true, true>(lds, g, S, E); }
        else { pg8::Gemm g{P.hbuf, P.wd1t, M, 1024, 2816, 2816}; pg8::SubOrder S; S.init(2, 1024, G - 8, 8, 64, bx); pg8::EpiRes E{P.xn, P.ss, 0.5f};
            pg8::gemm_phase<pg8::EpiRes, pg8::SubOrder, true, true>(lds, g, S, E); }
    }
    SEAM(3);
    if (IN(4)) {
        if (bx < G - 20) { gla_local_loop(P, lds, bx, G - 20, tid, wave, lane); swa_prompt_loop(P, lds, bx, G - 20, tid, wave, lane); }
        else { pg8::Gemm g{P.xn, P.wint, M, NPROJ, 1024, 1024}; pg8::SubOrder S; S.init(2, NPROJ, G - 20, 20, 64, bx);
            pg8::EpiProj E{P.ss, P.qg, P.kg, P.vg, P.rg, P.qs, P.kvs, P.alr, P.out + O_CKP, P.out + O_CVP, P.out + O_CKS, P.out + O_CVS, (LAS float*)(lds + RING_BYTES + 1024)};
            pg8::gemm_phase<pg8::EpiProj, pg8::SubOrder, true, true>(lds, g, S, E); }
    }
    SEAM(4);
    if (IN(5)) {
        for (int sb = bx; sb < 512; sb += G) gla_scan2(P, lds, sb, tid);
        for (int u = bx; u < 128; u += G) swa_sample_unit(P, lds, u, tid, wave, lane);
        for (int u = bx; u < 256; u += G) if (u >= 128) gla_sample_unit(P, lds, u - 128, tid, wave, lane);
    }
    SEAM(5);
    if (IN(6)) {
        if (bx < G - 8) gla_out_loop(P, lds, bx, G - 8, tid, wave, lane);
        else { pg8::Gemm g{P.mix, P.woutt, M, 1024, 1024, 1024}; pg8::SubOrder S; S.init(2, 1024, G - 8, 8, 64, bx); pg8::EpiRes E{P.xn, P.ss, 1.0f};
            pg8::gemm_phase<pg8::EpiRes, pg8::SubOrder, true, true>(lds, g, S, E); }
    }
    SEAM(6);
    if (IN(7)) { pg8::Gemm g{P.mix, P.woutt, M, 1024, 1024, 1024}; pg8::SubOrder S; S.init(64, 1024, 0, G, 0, bx); pg8::EpiRes E{P.xn, P.ss, 1.0f};
        pg8::gemm_phase<pg8::EpiRes, pg8::SubOrder, true, true>(lds, g, S, E); }
    SEAM(7);
    if (IN(8)) { pg8::Gemm g{P.xn, P.wgu2, M, 5632, 1024, 1024}; pg8::StaticOrder S; S.init(M, 5632, G, bx); pg8::EpiGU E{P.hbuf, P.ss, (LAS float*)(lds + RING_BYTES + 1024)};
        pg8::gemm_phase<pg8::EpiGU, pg8::StaticOrder, true, true>(lds, g, S, E); }
    SEAM(8);
    if (IN(9)) { pg8::Gemm g{P.hbuf, P.wd2t, M, 1024, 2816, 2816}; pg8::SubOrder S; S.init(64, 1024, 0, G, 0, bx); pg8::EpiRes E{P.xn, P.ss, 0.5f};
        pg8::gemm_phase<pg8::EpiRes, pg8::SubOrder, true, true>(lds, g, S, E); }
    SEAM(9);
    if (IN(10)) {
        if (bx < G - 32) final_norm_prompt(P, wave, lane, bx, G - 32);
        else { const int j = bx - (G - 32), ks = j >> 3, tile = j & 7;
            const int koff = ks < 2 ? 768 * ks : 1536 + 640 * (ks - 2), klen = ks < 2 ? 768 : 640;
            pg8::Gemm g{P.hbuf + koff, P.wd2t + koff, M, 1024, klen, 2816}; pg8::OneUnit S; S.u0.pm = 64 + (tile & 1); S.u0.pn = tile >> 1; S.on = true;
            pg8::EpiPartial E{P.ds + (size_t)ks * NSAMP * 1024};
            pg8::gemm_phase<pg8::EpiPartial, pg8::OneUnit, true, true>(lds, g, S, E); }
    }
    SEAM(10);
    if (IN(11)) final_sample(P, P.ds, wave, lane, vcu, G);
#undef IN
#undef SEAM
}

extern "C" void kernel_launch(void* const* d_in, const int* in_sizes, int n_in, void* d_out, int out_size, void* d_ws, size_t ws_size, hipStream_t stream) {
    static int grid = 0;
    if (grid == 0) {
        if (n_in != 22 || (size_t)out_size != O_END || ws_size < WS_END) { fprintf(stderr, "kernel_launch: unexpected shapes (n_in %d, out %d, ws %zu); nothing launched\n", n_in, out_size, ws_size); grid = -1; return; }
        int dev = 0, cus = 0, per_cu = 0;
        if (hipGetDevice(&dev) != hipSuccess || hipDeviceGetAttribute(&cus, hipDeviceAttributeMultiprocessorCount, dev) != hipSuccess) { grid = -1; return; }
        if (hipFuncSetAttribute((const void*)hymba_fwd, hipFuncAttributeMaxDynamicSharedMemorySize, LDS_BYTES) != hipSuccess) { fprintf(stderr, "kernel_launch: hipFuncSetAttribute failed\n"); grid = -1; return; }
        if (hipOccupancyMaxActiveBlocksPerMultiprocessor(&per_cu, (const void*)hymba_fwd, NTHR, LDS_BYTES) != hipSuccess || per_cu < 1) { fprintf(stderr, "kernel_launch: occupancy query says %d blocks per CU\n", per_cu); (void)hipGetLastError(); grid = -1; return; }
        grid = cus;
    }
    if (grid < 0) return;
    if (hipMemsetAsync((char*)d_ws + WS_CTL, 0, CTL_ZERO_BYTES, stream) != hipSuccess) return;
    Args a{};
    for (int i = 0; i < 22; ++i) a.in[i] = (const float*)d_in[i];
    a.out = (float*)d_out; a.ws = (unsigned char*)d_ws;
#if MK_N_LAUNCHES == 1
    void* kargs[] = {&a};
#if PROBE_REP_HI >= 0
    a.ph_lo = 0; a.ph_hi = PROBE_REP_HI + 1; a.bar_region = 1;
    (void)hipLaunchCooperativeKernel((const void*)hymba_fwd, dim3(grid), dim3(NTHR), kargs, LDS_BYTES, stream);
#endif
    a.ph_lo = 0; a.ph_hi = N_PHASES; a.bar_region = 0;
    hipError_t e = hipLaunchCooperativeKernel((const void*)hymba_fwd, dim3(grid), dim3(NTHR), kargs, LDS_BYTES, stream);
    if (e != hipSuccess) fprintf(stderr, "kernel_launch: cooperative launch failed: %s (grid %d)\n", hipGetErrorString(e), grid);
#else
    for (int p = 0; p < N_PHASES; ++p) { a.ph_lo = p; a.ph_hi = p + 1; hipLaunchKernelGGL(hymba_fwd, dim3(grid), dim3(NTHR), LDS_BYTES, stream, a); }
#endif
}
```

```cpp
#include <hip/hip_runtime.h>
#include <hip/hip_cooperative_groups.h>
#include <cstdio>
#include <cstdint>
namespace cg = cooperative_groups;

constexpr int D = 1024, SEQ = 16384, NSAMP = 512, M = SEQ + NSAMP, FF = 2816, DIN = 2320, NPROJ = 2560;
constexpr int DECB = 128, DECT = 4;
constexpr float EPS = 1e-6f;
namespace pg8 {
#define PG8_LAS __attribute__((address_space(3)))
typedef unsigned short bf16_t;
typedef short bf16x8 __attribute__((ext_vector_type(8)));
typedef float f32x4 __attribute__((ext_vector_type(4)));
typedef unsigned u32x4 __attribute__((ext_vector_type(4)));
constexpr int BM = 256, BK = 64, HALF = 128, HTB = HALF * BK * 2  , STAGE_BYTES = 8 * HTB, NXCD = 8, WGM = 8;

__host__ __device__ __forceinline__ int lds_byte(int r, int c) { const int st = (r >> 4) * 2 + (c >> 5), rr = r & 15, cc = c & 31, ob = rr * 64 + cc * 2; return st * 1024 + (ob ^ (((ob >> 9) & 1) << 5)); }
__host__ __device__ __forceinline__ void stage_rc(int b, int& R, int& C) { const int st = b / 1024, sb = b % 1024, swz = sb ^ (((sb >> 9) & 1) << 5); R = (st >> 1) * 16 + swz / 64; C = (st & 1) * 32 + (swz % 64) / 2; }
__host__ __device__ __forceinline__ int perm32(int rho) { const int n = rho >> 4, i = rho & 15; return 8 * (i >> 2) + 4 * n + (i & 3); }

struct Unit { int pm, pn; };
struct Gemm { const bf16_t* A; const bf16_t* Bt; int M, N, K, ld; };

struct StaticOrder {
    int nM, nN, nwg, G, c;
    __host__ __device__ void init(int M, int N, int G_, int c_) { nM = M / BM; nN = N / BM; nwg = nM * nN; G = G_; c = c_; }
    __host__ __device__ bool next(int i, Unit& u) const {
        const long L = (long)i * G + c; if (L >= nwg) return false;
        int wgid = (int)L; { const int q = nwg / NXCD, r = nwg % NXCD, xcd = wgid % NXCD, off = wgid / NXCD; wgid = (xcd < r ? xcd * (q + 1) : r * (q + 1) + (xcd - r) * q) + off; }
        const int nig = WGM * nN, gid = wgid / nig, fm = gid * WGM, gsz = (nM - fm) < WGM ? (nM - fm) : WGM;
        u.pm = fm + ((wgid % nig) % gsz); u.pn = (wgid % nig) / gsz; return true;
    }
    __device__ __forceinline__ void a_ready(const Unit&) const {}
    __device__ __forceinline__ void done(const Unit&) const {}
};

__device__ __forceinline__ unsigned cvt_pk_bf16(float lo, float hi) { unsigned r; asm volatile("v_cvt_pk_bf16_f32 %0, %1, %2" : "=v"(r) : "v"(lo), "v"(hi)); return r; }
typedef float f32x2 __attribute__((ext_vector_type(2)));
__device__ __forceinline__ float row_rs16(const float* ss, int row) {
    const f32x4* p = (const f32x4*)(ss + (size_t)row * 16);
    const f32x4 t = (p[0] + p[1]) + (p[2] + p[3]);
    return rsqrtf(((t[0] + t[1]) + (t[2] + t[3])) * (1.0f / 1024.0f) + 1e-6f);
}
__device__ __forceinline__ void unit_rs_table(const float* ss, int pm, PG8_LAS float* rsS) {
    const int tid = threadIdx.x;
    if (tid < 256) rsS[tid] = row_rs16(ss, pm * BM + tid);
    asm volatile("s_waitcnt lgkmcnt(0)" ::: "memory"); __builtin_amdgcn_s_barrier(); asm volatile("" ::: "memory");
}
__device__ __forceinline__ float silu_f(float g) { return g * __builtin_amdgcn_rcpf(1.0f + __builtin_amdgcn_exp2f(-1.4426950408889634f * g)); }

struct EpiGU {
    static constexpr bool PERM = true, AFTER_DRAIN = false;
    bf16_t* H; const float* ss; PG8_LAS float* rsS;
    __device__ __forceinline__ void operator()(const f32x4 (&acc)[2][2][4][2], const Unit& u, int wr, int wc, int fr, int fq) const {
        const int row0 = u.pm * BM + wr * 64 + fr;
        const int col0 = u.pn * 128 + wc * 32 + 8 * fq;
        unit_rs_table(ss, u.pm, rsS);
#pragma unroll
        for (int ai = 0; ai < 2; ++ai)
#pragma unroll
            for (int m = 0; m < 4; ++m) {
                const int row = row0 + ai * HALF + m * 16;
                const float rs = rsS[ai * HALF + wr * 64 + m * 16 + fr];
                float h[8];
#pragma unroll
                for (int n = 0; n < 2; ++n)
#pragma unroll
                    for (int e = 0; e < 4; ++e) { const float g = acc[ai][0][m][n][e] * rs, up = acc[ai][1][m][n][e] * rs; h[4 * n + e] = silu_f(g) * up; }
                u32x4 w; w.x = cvt_pk_bf16(h[0], h[1]); w.y = cvt_pk_bf16(h[2], h[3]); w.z = cvt_pk_bf16(h[4], h[5]); w.w = cvt_pk_bf16(h[6], h[7]);
                *(u32x4*)(H + (size_t)row * 2816 + col0) = w;
            }
    }
};

struct EpiRes {
    static constexpr bool PERM = true, AFTER_DRAIN = false;
    bf16_t* xb; float* ss; float scale;
    __device__ __forceinline__ void operator()(const f32x4 (&acc)[2][2][4][2], const Unit& u, int wr, int wc, int fr, int fq) const {
        const int row0 = u.pm * BM + wr * 64 + fr;
        const int col0 = u.pn * BM + wc * 32 + 8 * fq;
        u32x4 res[2][4][2];
#pragma unroll
        for (int ai = 0; ai < 2; ++ai)
#pragma unroll
            for (int m = 0; m < 4; ++m)
#pragma unroll
                for (int bj = 0; bj < 2; ++bj) res[ai][m][bj] = *(const u32x4*)(xb + (size_t)(row0 + ai * HALF + m * 16) * 1024 + col0 + bj * HALF);
#pragma unroll
        for (int ai = 0; ai < 2; ++ai)
#pragma unroll
            for (int m = 0; m < 4; ++m) {
                const int row = row0 + ai * HALF + m * 16;
                bf16_t* rp = xb + (size_t)row * 1024 + col0;
                float sq = 0.f;
#pragma unroll
                for (int bj = 0; bj < 2; ++bj) {
                    const u32x4 r = res[ai][m][bj];
                    const f32x4 r0 = (f32x4){__uint_as_float(r.x << 16), __uint_as_float(r.x & 0xffff0000u), __uint_as_float(r.y << 16), __uint_as_float(r.y & 0xffff0000u)};
                    const f32x4 r1 = (f32x4){__uint_as_float(r.z << 16), __uint_as_float(r.z & 0xffff0000u), __uint_as_float(r.w << 16), __uint_as_float(r.w & 0xffff0000u)};
                    const f32x4 v0 = r0 + acc[ai][bj][m][0] * scale, v1 = r1 + acc[ai][bj][m][1] * scale;
                    sq += (v0[0] * v0[0] + v0[1] * v0[1]) + (v0[2] * v0[2] + v0[3] * v0[3]);
                    sq += (v1[0] * v1[0] + v1[1] * v1[1]) + (v1[2] * v1[2] + v1[3] * v1[3]);
                    u32x4 w; w.x = cvt_pk_bf16(v0[0], v0[1]); w.y = cvt_pk_bf16(v0[2], v0[3]); w.z = cvt_pk_bf16(v1[0], v1[1]); w.w = cvt_pk_bf16(v1[2], v1[3]);
                    *(u32x4*)(rp + bj * HALF) = w;
                }
                sq += __shfl_xor(sq, 16); sq += __shfl_xor(sq, 32);
                if (fq == 0) ss[(size_t)row * 16 + u.pn * 4 + wc] = sq;
            }
    }
};

struct EpiProj {
    static constexpr bool PERM = true, AFTER_DRAIN = false;
    const float* ss; bf16_t *qg, *kg, *vg, *rg, *qs, *kvs; float* alr; float *ckp, *cvp, *cks, *cvs; PG8_LAS float* rsS;
    __device__ __forceinline__ void operator()(const f32x4 (&acc)[2][2][4][2], const Unit& u, int wr, int wc, int fr, int fq) const {
        const int row0 = u.pm * BM + wr * 64 + fr;
        const int pn = u.pn;
        unit_rs_table(ss, u.pm, rsS);
#pragma unroll
        for (int ai = 0; ai < 2; ++ai)
#pragma unroll
            for (int m = 0; m < 4; ++m) {
                const int row = row0 + ai * HALF + m * 16;
                const float rs = rsS[ai * HALF + wr * 64 + m * 16 + fr];
#pragma unroll
                for (int bj = 0; bj < 2; ++bj) {
                    const int cl = bj * HALF + wc * 32 + 8 * fq;
                    f32x4 v0 = acc[ai][bj][m][0] * rs, v1 = acc[ai][bj][m][1] * rs;
                    if (pn == 9) {
                        if (cl < 16) { float* p = alr + (size_t)row * 16 + cl; *(f32x4*)p = v0; *(f32x4*)(p + 4) = v1; }
                        continue;
                    }
                    bf16_t* dst;
                    if (pn == 0) { dst = qg + (size_t)row * 256 + cl; v0 = v0 * 0.125f; v1 = v1 * 0.125f; }
                    else if (pn == 1) { dst = kg + (size_t)row * 256 + cl; }
                    else if (pn < 4) { dst = vg + (size_t)row * 512 + (pn - 2) * 256 + cl; }
                    else if (pn < 6) { dst = rg + (size_t)row * 512 + (pn - 4) * 256 + cl;
#pragma unroll
                        for (int e = 0; e < 4; ++e) { v0[e] = silu_f(v0[e]); v1[e] = silu_f(v1[e]); } }
                    else if (pn < 8) { dst = qs + (size_t)row * 512 + (pn - 6) * 256 + cl; v0 = v0 * 0.125f; v1 = v1 * 0.125f; }
                    else { dst = kvs + (size_t)row * 256 + cl;
                        float* cp = nullptr;
                        if (row >= 16384) { const int sr = row - 16384; cp = (bj ? cvs : cks) + ((size_t)(sr >> 2) * 128 + 124 + (sr & 3)) * 128 + (cl & 127); }
                        else if (row >= 16384 - 128) { cp = (bj ? cvp : ckp) + (size_t)(row - (16384 - 128)) * 128 + (cl & 127); }
                        if (cp) { *(f32x4*)cp = v0; *(f32x4*)(cp + 4) = v1; }
                    }
                    u32x4 w; w.x = cvt_pk_bf16(v0[0], v0[1]); w.y = cvt_pk_bf16(v0[2], v0[3]); w.z = cvt_pk_bf16(v1[0], v1[1]); w.w = cvt_pk_bf16(v1[2], v1[3]);
                    *(u32x4*)dst = w;
                }
            }
    }
};

struct EpiPartial {
    static constexpr bool PERM = true, AFTER_DRAIN = false;
    float* slab;
    __device__ __forceinline__ void operator()(const f32x4 (&acc)[2][2][4][2], const Unit& u, int wr, int wc, int fr, int fq) const {
        const int row0 = (u.pm - 64) * BM + wr * 64 + fr;
        const int col0 = u.pn * BM + wc * 32 + 8 * fq;
#pragma unroll
        for (int ai = 0; ai < 2; ++ai)
#pragma unroll
            for (int m = 0; m < 4; ++m) { float* rp = slab + (size_t)(row0 + ai * HALF + m * 16) * 1024 + col0;
#pragma unroll
                for (int bj = 0; bj < 2; ++bj) { *(f32x4*)(rp + bj * HALF) = acc[ai][bj][m][0]; *(f32x4*)(rp + bj * HALF + 4) = acc[ai][bj][m][1]; } }
    }
};
struct SubOrder {
    StaticOrder S; int pm0; bool on;
    __device__ __forceinline__ void init(int nMp, int N, int b0, int nb, int pm0_, int bx) { on = (bx >= b0) && (bx < b0 + nb); S.init(nMp * BM, N, nb, on ? bx - b0 : 0); pm0 = pm0_; }
    __device__ __forceinline__ bool next(int i, Unit& u) const { if (!on) return false; if (!S.next(i, u)) return false; u.pm += pm0; return true; }
    __device__ __forceinline__ void a_ready(const Unit&) const {}
    __device__ __forceinline__ void done(const Unit&) const {}
};
struct OneUnit {
    Unit u0; bool on;
    __device__ __forceinline__ bool next(int i, Unit& u) const { if (!on || i != 0) return false; u = u0; return true; }
    __device__ __forceinline__ void a_ready(const Unit&) const {}
    __device__ __forceinline__ void done(const Unit&) const {}
};
template <class Epi, class Sched, bool ALIGN_EPI = false, bool SP2 = false>
__device__ __forceinline__ void gemm_phase(PG8_LAS unsigned char* lds, const Gemm g, const Sched& S, const Epi& E) {
    const int tid = threadIdx.x, wid = __builtin_amdgcn_readfirstlane(tid >> 6), lane = tid & 63, wr = wid >> 2, wc = wid & 3, fr = lane & 15, fq = lane >> 4;
    const int K = g.ld, nt = g.K / BK;
    unsigned voffA[2], voffB[2];
#pragma unroll
    for (int i = 0; i < 2; ++i) { int R, C; stage_rc(tid * 16 + i * 8192, R, C); const int Rb = Epi::PERM ? ((R & ~31) + perm32(R & 31)) : R;
        voffA[i] = (unsigned)(R * K + C) * 2u; voffB[i] = (unsigned)(Rb * K + C) * 2u; }
    const size_t kstep = (size_t)(BK * 2);
    const size_t hstep = (size_t)HALF * K * 2;
    const size_t tstep = 2 * hstep;
    const unsigned ldsw = (unsigned)wid * 1024u;
    const int aoff = lds_byte(wr * 64 + fr, fq * 8), boff = lds_byte(wc * 32 + fr, fq * 8);
#define PG8_SA(b, h) (((b) * 2 + (h)) * HTB)
#define PG8_SB(b, h) ((4 + (b) * 2 + (h)) * HTB)
#define PG8_STAGE(bufoff, gbase, voff) do { _Pragma("unroll") for (int _i = 0; _i < 2; ++_i) \
        __builtin_amdgcn_global_load_lds((const unsigned*)((const char*)(gbase) + (voff)[_i]), (PG8_LAS unsigned*)(lds + (bufoff) + ldsw + _i * 8192), 16, 0, 0); } while (0)
#define PG8_LDA(dst, b, h) do { _Pragma("unroll") for (int m = 0; m < 4; ++m) _Pragma("unroll") for (int k = 0; k < 2; ++k) dst[m][k] = *(const PG8_LAS bf16x8*)(lds + PG8_SA(b, h) + aoff + m * 2048 + k * 1024); } while (0)
#define PG8_LDB(dst, b, h) do { _Pragma("unroll") for (int n = 0; n < 2; ++n) _Pragma("unroll") for (int k = 0; k < 2; ++k) dst[n][k] = *(const PG8_LAS bf16x8*)(lds + PG8_SB(b, h) + boff + n * 2048 + k * 1024); } while (0)
#define PG8_MMA(ai, bj, At, Bt) do { __builtin_amdgcn_s_setprio(1); _Pragma("unroll") for (int m = 0; m < 4; ++m) _Pragma("unroll") for (int n = 0; n < 2; ++n) _Pragma("unroll") for (int k = 0; k < 2; ++k) \
        acc[ai][bj][m][n] = __builtin_amdgcn_mfma_f32_16x16x32_bf16(Bt[n][k], At[m][k], acc[ai][bj][m][n], 0, 0, 0); __builtin_amdgcn_s_setprio(0); } while (0)
#define PG8_WAIT_V(n) asm volatile("s_waitcnt vmcnt(" #n ")" ::: "memory")
#define PG8_WAIT_L(n) asm volatile("s_waitcnt lgkmcnt(" #n ")" ::: "memory")
#define PG8_BAR __builtin_amdgcn_s_barrier()
#define PG8_SCHED __builtin_amdgcn_sched_barrier(0)
    Unit cur, nxt; int ui = 0;
    if (!S.next(0, cur)) return;
    f32x4 acc[2][2][4][2];
#pragma unroll
    for (int a = 0; a < 2; ++a)
#pragma unroll
        for (int b = 0; b < 2; ++b)
#pragma unroll
            for (int m = 0; m < 4; ++m)
#pragma unroll
                for (int n = 0; n < 2; ++n) acc[a][b][m][n] = (f32x4){0.f, 0.f, 0.f, 0.f};
    bf16x8 At[4][2], B0[2][2], B1[2][2];
    const char* cA = (const char*)g.A + (size_t)cur.pm * tstep; const char* cB = (const char*)g.Bt + (size_t)cur.pn * tstep;
    S.a_ready(cur);
    if constexpr (SP2) {
        PG8_STAGE(PG8_SB(0, 0), cB, voffB); PG8_STAGE(PG8_SB(0, 1), cB + hstep, voffB); PG8_STAGE(PG8_SA(0, 0), cA, voffA); PG8_STAGE(PG8_SA(0, 1), cA + hstep, voffA);
        if (wr == 1) PG8_BAR;
        PG8_WAIT_V(2); PG8_BAR;
        PG8_STAGE(PG8_SB(1, 0), cB + kstep, voffB); PG8_STAGE(PG8_SA(1, 0), cA + kstep, voffA); PG8_STAGE(PG8_SB(1, 1), cB + hstep + kstep, voffB);
        PG8_WAIT_V(6); PG8_BAR;
    } else {
        PG8_STAGE(PG8_SB(0, 0), cB, voffB); PG8_STAGE(PG8_SA(0, 0), cA, voffA); PG8_STAGE(PG8_SB(0, 1), cB + hstep, voffB); PG8_STAGE(PG8_SA(0, 1), cA + hstep, voffA);
        if (wr == 1) PG8_BAR;
        PG8_WAIT_V(4); PG8_BAR;
        PG8_STAGE(PG8_SB(1, 0), cB + kstep, voffB); PG8_STAGE(PG8_SA(1, 0), cA + kstep, voffA); PG8_STAGE(PG8_SB(1, 1), cB + hstep + kstep, voffB);
        PG8_WAIT_V(6); PG8_BAR;
    }
    for (;;) {
        const bool has_next = S.next(ui + 1, nxt);
        const char* nA = has_next ? (const char*)g.A + (size_t)nxt.pm * tstep : cA; const char* nB = has_next ? (const char*)g.Bt + (size_t)nxt.pn * tstep : cB;
        for (int t = 0; t < nt; t += 2) {
            const bool last = (t == nt - 2);
            const char* a1 = cA + (size_t)(t + 1) * kstep;
            const char* a2 = last ? nA : cA + (size_t)(t + 2) * kstep; const char* b2 = last ? nB : cB + (size_t)(t + 2) * kstep;
            const char* a3 = a2 + kstep; const char* b3 = b2 + kstep;
            if (last && has_next) S.a_ready(nxt);
            if constexpr (SP2) {
            PG8_LDB(B0, 0, 0); PG8_LDB(B1, 0, 1); PG8_SCHED; PG8_LDA(At, 0, 0); PG8_STAGE(PG8_SA(1, 1), a1 + hstep, voffA);
            PG8_WAIT_V(8); PG8_WAIT_L(0); PG8_BAR; PG8_MMA(0, 0, At, B0); PG8_MMA(0, 1, At, B1); PG8_BAR; PG8_SCHED;
            PG8_LDA(At, 0, 1); PG8_STAGE(PG8_SB(0, 0), b2, voffB); PG8_STAGE(PG8_SB(0, 1), b2 + hstep, voffB); PG8_STAGE(PG8_SA(0, 0), a2, voffA);
            PG8_WAIT_V(8); PG8_WAIT_L(0); PG8_BAR; PG8_MMA(1, 0, At, B0); PG8_MMA(1, 1, At, B1); PG8_BAR; PG8_SCHED;
            PG8_LDB(B0, 1, 0); PG8_LDB(B1, 1, 1); PG8_SCHED; PG8_LDA(At, 1, 0); PG8_STAGE(PG8_SA(0, 1), a2 + hstep, voffA);
            PG8_WAIT_V(8); PG8_WAIT_L(0); PG8_BAR; PG8_MMA(0, 0, At, B0); PG8_MMA(0, 1, At, B1); PG8_BAR; PG8_SCHED;
            PG8_LDA(At, 1, 1); PG8_STAGE(PG8_SB(1, 0), b3, voffB); PG8_STAGE(PG8_SB(1, 1), b3 + hstep, voffB); PG8_STAGE(PG8_SA(1, 0), a3, voffA);
            PG8_WAIT_V(8); PG8_WAIT_L(0); PG8_BAR; PG8_MMA(1, 0, At, B0); PG8_MMA(1, 1, At, B1); PG8_BAR; PG8_SCHED;
            } else {
            PG8_LDB(B0, 0, 0); PG8_SCHED; PG8_LDA(At, 0, 0); PG8_STAGE(PG8_SA(1, 1), a1 + hstep, voffA);
            PG8_WAIT_L(8); PG8_BAR; PG8_WAIT_L(0); PG8_MMA(0, 0, At, B0); PG8_BAR; PG8_SCHED;
            PG8_LDB(B1, 0, 1); PG8_STAGE(PG8_SB(0, 0), b2, voffB);
            PG8_BAR; PG8_WAIT_L(0); PG8_MMA(0, 1, At, B1); PG8_BAR;
            PG8_LDA(At, 0, 1); PG8_STAGE(PG8_SA(0, 0), a2, voffA);
            PG8_BAR; PG8_WAIT_L(0); PG8_MMA(1, 0, At, B0); PG8_BAR; PG8_SCHED;
            PG8_STAGE(PG8_SB(0, 1), b2 + hstep, voffB);
            PG8_WAIT_V(6); PG8_BAR; PG8_MMA(1, 1, At, B1); PG8_BAR;
            PG8_LDB(B0, 1, 0); PG8_SCHED; PG8_LDA(At, 1, 0); PG8_STAGE(PG8_SA(0, 1), a2 + hstep, voffA);
            PG8_WAIT_L(8); PG8_BAR; PG8_WAIT_L(0); PG8_MMA(0, 0, At, B0); PG8_BAR; PG8_SCHED;
            PG8_LDB(B1, 1, 1); PG8_STAGE(PG8_SB(1, 0), b3, voffB);
            PG8_BAR; PG8_WAIT_L(0); PG8_MMA(0, 1, At, B1); PG8_BAR;
            PG8_LDA(At, 1, 1); PG8_STAGE(PG8_SA(1, 0), a3, voffA);
            PG8_BAR; PG8_WAIT_L(0); PG8_MMA(1, 0, At, B0); PG8_BAR; PG8_SCHED;
            PG8_STAGE(PG8_SB(1, 1), b3 + hstep, voffB);
            PG8_WAIT_V(6); PG8_BAR; PG8_MMA(1, 1, At, B1); PG8_BAR;
            }
        }
        if constexpr (ALIGN_EPI) { if (wr == 0) PG8_BAR; }
        if constexpr (!Epi::AFTER_DRAIN) { E(acc, cur, wr, wc, fr, fq); S.done(cur); }
        if (!has_next) break;
#pragma unroll
        for (int a = 0; a < 2; ++a)
#pragma unroll
            for (int b = 0; b < 2; ++b)
#pragma unroll
                for (int m = 0; m < 4; ++m)
#pragma unroll
                    for (int n = 0; n < 2; ++n) acc[a][b][m][n] = (f32x4){0.f, 0.f, 0.f, 0.f};
        cur = nxt; cA = nA; cB = nB; ++ui;
        if constexpr (ALIGN_EPI) { if (wr == 1) PG8_BAR; }
    }
    PG8_WAIT_V(0);
    if constexpr (!ALIGN_EPI) { if (wr == 0) PG8_BAR; }
    PG8_BAR;
    if constexpr (Epi::AFTER_DRAIN) { E.fused(acc, cur, wr, wc, fr, fq, lds, wid, lane); S.done(cur); }
#undef PG8_SA
#undef PG8_SB
#undef PG8_STAGE
#undef PG8_LDA
#undef PG8_LDB
#undef PG8_MMA
#undef PG8_WAIT_V
#undef PG8_WAIT_L
#undef PG8_BAR
#undef PG8_SCHED
}
}
#define GAS __attribute__((address_space(1)))
#define LAS __attribute__((address_space(3)))
typedef unsigned short bf16;
typedef unsigned v4u __attribute__((ext_vector_type(4)));
typedef float f32x4 __attribute__((ext_vector_type(4)));
typedef short bf16x8 __attribute__((ext_vector_type(8)));
typedef GAS unsigned gu32;
typedef GAS unsigned long long gu64;
#define RLX_AGENT __ATOMIC_RELAXED, __HIP_MEMORY_SCOPE_AGENT
#define LDS_WAIT() asm volatile("s_waitcnt lgkmcnt(0)" ::: "memory")
#define VM_WAIT() asm volatile("s_waitcnt vmcnt(0)" ::: "memory")
__device__ __forceinline__ unsigned long long rt() { return __builtin_amdgcn_s_memrealtime(); }
__device__ __forceinline__ unsigned f2bf(float f) { unsigned u = __builtin_bit_cast(unsigned, f); return (u + 0x7fffu + ((u >> 16) & 1u)) >> 16; }
__device__ __forceinline__ unsigned pk2(float lo, float hi) { return f2bf(lo) | (f2bf(hi) << 16); }

#define XB_TMO      128
#define XB_XCNT(j)  (256  + 64 * (j))
#define XB_XSUB(j)  (1280 + 64 * (j))
#define XB_XGEN(j)  (2304 + 64 * (j))
#define XB_TOP      3328
#define XB_TOPGEN   3392
#define XCD_BAR_WORDS 3456
#define XB_SPIN_CAP (1u << 18)

__device__ __forceinline__ unsigned xb_ld(unsigned* p)              { return __hip_atomic_load(p, __ATOMIC_RELAXED, __HIP_MEMORY_SCOPE_AGENT); }
__device__ __forceinline__ unsigned xb_add(unsigned* p, unsigned v) { return __hip_atomic_fetch_add(p, v, __ATOMIC_RELAXED, __HIP_MEMORY_SCOPE_AGENT); }
__device__ __forceinline__ unsigned xb_xcc_id() { return (unsigned)__builtin_amdgcn_s_getreg((3 << 11) | 20) & 0xFu; }
#define XB_SPIN(cond, bar) do { unsigned _sp = 0; while (cond) { __builtin_amdgcn_s_sleep(1); \
    if ((++_sp & 255u) == 0u) { if (xb_ld(&(bar)[XB_TMO])) break; if (_sp > XB_SPIN_CAP) { atomicAdd(&(bar)[XB_TMO], 1u); break; } } } } while (0)

struct XcdBarrier {
    unsigned* bar; unsigned x;
    volatile LAS unsigned* st;
};

__device__ __forceinline__ XcdBarrier xcd_barrier_post(unsigned* bar, volatile LAS unsigned* st) {
    XcdBarrier b; b.bar = bar; b.x = xb_xcc_id(); b.st = st;
    if (threadIdx.x == 0) (void)xb_add(&bar[XB_XCNT(b.x)], 1u);
    return b;
}
__device__ __forceinline__ void xcd_barrier_complete(unsigned* bar, unsigned x, unsigned& nloc, unsigned& nx) {
    const unsigned G = gridDim.x * gridDim.y * gridDim.z;
    unsigned sum, cnt, mine, sp = 0u;
    for (;;) {
        sum = 0u; cnt = 0u; mine = 0u;
#pragma unroll
        for (unsigned j = 0; j < 16; ++j) { const unsigned c = xb_ld(&bar[XB_XCNT(j)]); sum += c; cnt += (c > 0u) ? 1u : 0u; mine = (j == x) ? c : mine; }
        if (sum == G) break;
        __builtin_amdgcn_s_sleep(1);
        if ((++sp & 255u) == 0u) { if (xb_ld(&bar[XB_TMO])) break; if (sp > XB_SPIN_CAP) { atomicAdd(&bar[XB_TMO], 1u); break; } }
    }
    nloc = mine > 0u ? mine : 1u; nx = cnt > 0u ? cnt : 1u;
}

__device__ __forceinline__ void xcd_barrier(const XcdBarrier& b) {
    asm volatile("s_waitcnt vmcnt(0)" ::: "memory");
    __syncthreads();
    if (threadIdx.x == 0) {
        unsigned* bar = b.bar;
        __builtin_amdgcn_s_waitcnt(0);
        unsigned nloc = b.st[0], nx = b.st[1];
        if (nloc == 0u) { xcd_barrier_complete(bar, b.x, nloc, nx); b.st[0] = nloc; b.st[1] = nx; }
        const unsigned old = xb_add(&bar[XB_XSUB(b.x)], 1u);
        const unsigned gen = old / nloc;
        if (old + 1u == (gen + 1u) * nloc) {
            __builtin_amdgcn_fence(__ATOMIC_RELEASE, "agent");
            asm volatile("s_waitcnt vmcnt(0)" ::: "memory");
            const unsigned og = xb_add(&bar[XB_TOP], 1u);
            const unsigned tg = og / nx;
            if (og + 1u == (tg + 1u) * nx) xb_add(&bar[XB_TOPGEN], 1u);
            else XB_SPIN(xb_ld(&bar[XB_TOPGEN]) == tg, bar);
            __builtin_amdgcn_fence(__ATOMIC_ACQUIRE, "agent");
            xb_add(&bar[XB_XGEN(b.x)], 1u);
            asm volatile("s_waitcnt vmcnt(0)" ::: "memory");
        } else {
            XB_SPIN(xb_ld(&bar[XB_XGEN(b.x)]) == gen, bar);
            __builtin_amdgcn_fence(__ATOMIC_ACQUIRE, "agent");
            asm volatile("s_waitcnt vmcnt(0)" ::: "memory");
        }
    }
    __syncthreads();
}

constexpr size_t MiB = 1u << 20;
constexpr size_t WS_CTL = 0, CTL_ZERO_BYTES = 64 * 1024;
constexpr size_t SZ_WGU = (size_t)5632 * 1024 * 2, SZ_WD = (size_t)1024 * 2816 * 2, SZ_WIN = (size_t)NPROJ * 1024 * 2, SZ_WOUT = (size_t)1024 * 1024 * 2;
constexpr size_t WS_WGU1 = 1 * MiB, WS_WD1 = WS_WGU1 + SZ_WGU, WS_WGU2 = WS_WD1 + SZ_WD, WS_WD2 = WS_WGU2 + SZ_WGU, WS_WIN = WS_WD2 + SZ_WD, WS_WOUT = WS_WIN + SZ_WIN;
constexpr size_t SZ_ACT = (size_t)M * 1024 * 2;
constexpr size_t WS_XN = WS_WOUT + SZ_WOUT, WS_MIX = WS_XN + SZ_ACT, WS_SS = WS_MIX + SZ_ACT;
constexpr size_t SZ_SS = (size_t)M * 16 * 4, SZ_SSW = (size_t)M * 8 * 4, SZ_ALR = (size_t)M * 16 * 4, SZ_G = (size_t)256 * 4 * 64 * 4;
constexpr size_t WS_SSW = WS_SS + SZ_SS, WS_ALR = WS_SSW + SZ_SSW, WS_G = WS_ALR + SZ_ALR, WS_R = WS_G + SZ_G;
constexpr size_t SZ_R = (size_t)M * 2816 * 2;
constexpr size_t R_QG = 0, R_KG = R_QG + (size_t)M * 256 * 2, R_VG = R_KG + (size_t)M * 256 * 2, R_RG = R_VG + (size_t)M * 512 * 2, R_QS = R_RG + (size_t)M * 512 * 2,
                 R_KVS = R_QS + (size_t)M * 512 * 2, R_CUM = R_KVS + (size_t)M * 256 * 2, R_END = R_CUM + (size_t)SEQ * 256 * 4;
static_assert(R_END <= SZ_R, "projection overlay fits inside H");
constexpr size_t WS_DS = WS_R + SZ_R, SZ_DS = (size_t)256 * 4 * 64 * 128 * 4, WS_END = WS_DS + SZ_DS;
static_assert(WS_END <= 256 * MiB, "d_ws map");
constexpr size_t O_Y = 0, O_SP = (size_t)M * 1024, O_CKP = O_SP + 32768, O_CVP = O_CKP + 16384, O_SS = O_CVP + 16384, O_CKS = O_SS + (size_t)DECB * 32768, O_CVS = O_CKS + (size_t)DECB * 16384,
                 O_END = O_CVS + (size_t)DECB * 16384;
constexpr int RING_BYTES = 131072, MISC_OFF = RING_BYTES + 320, LDS_BYTES = 147456;
constexpr int NWAVES = 8, NTHR = 512;

struct Args {
    const float* in[22]; float* out; unsigned char* ws; int ph_lo, ph_hi, bar_region, pad;
};
struct Ptrs {
    const float *x_p, *x_s, *state0, *ck_in, *cv_in, *g_ffn1, *wg1, *wu1, *wd1, *g_mix, *w_in, *w_gate_up, *b_gate, *g_head, *g_swa, *sinks, *w_out, *g_ffn2, *wg2, *wu2, *wd2, *g_final;
    float* out;
    bf16 *wgu1, *wd1t, *wgu2, *wd2t, *wint, *woutt, *xn, *mix, *hbuf, *qg, *kg, *vg, *rg, *qs, *kvs;
    float *ss, *ssw, *alr, *g, *cum, *ds;
};

__device__ __forceinline__ float bflo(unsigned w) { return __uint_as_float(w << 16); }
__device__ __forceinline__ float bfhi(unsigned w) { return __uint_as_float(w & 0xffff0000u); }
__device__ __forceinline__ float bf1(bf16 b) { return __uint_as_float((unsigned)b << 16); }
__device__ __forceinline__ float wave_sum(float v) {
#pragma unroll
    for (int o = 1; o < 64; o <<= 1) v += __shfl_xor(v, o);
    return v;
}
__device__ __forceinline__ float logsig(float x) { return fminf(x, 0.f) - __logf(1.0f + __expf(-fabsf(x))); }
__device__ __forceinline__ bf16x8 frag(const LAS bf16* base, int row0, int ld, int k0, int fr, int fq) { return *(const LAS bf16x8*)(base + (row0 + fr) * ld + k0 + 8 * fq); }
#define pk2(lo, hi) pg8::cvt_pk_bf16((lo), (hi))
#define MFMA16(a, b, c) __builtin_amdgcn_mfma_f32_16x16x32_bf16((a), (b), (c), 0, 0, 0)

__device__ __forceinline__ int dest_row(int kind, int n) {
    if (kind == 0) return n;
    if (kind == 1) return 256 * (n >> 7) + (n & 127);
    if (kind == 2) return 256 * (n >> 7) + 128 + (n & 127);
    return n < 1536 ? n : (n < 1552 ? 2304 + (n - 1536) : n - 16);
}
__device__ __forceinline__ void p0_transpose_item(const float* W, int K, int N, bf16* WT, int kind, const float* gain, LAS float* scr, int item, int lane) {
    const int nblk = (N + 31) / 32, kb = item / nblk, nb = item % nblk, k0 = 64 * kb, n0 = 32 * nb;
    const int kr = lane >> 3, n4 = (lane & 7) * 4; const bool ok = n0 + n4 < N;
    f32x4 v[8];
#pragma unroll
    for (int i = 0; i < 8; ++i) v[i] = ok ? *(const GAS f32x4*)(W + (size_t)(k0 + 8 * i + kr) * N + n0 + n4) : (f32x4){0.f, 0.f, 0.f, 0.f};
#pragma unroll
    for (int i = 0; i < 8; ++i) { LAS float* d = scr + (8 * i + kr) * 33 + n4; d[0] = v[i].x; d[1] = v[i].y; d[2] = v[i].z; d[3] = v[i].w; }
    LDS_WAIT(); asm volatile("" ::: "memory");
    const int c = lane & 7;
    f32x4 g0 = (f32x4){1.f, 1.f, 1.f, 1.f}, g1 = g0;
    if (gain) { g0 = *(const GAS f32x4*)(gain + k0 + 8 * c); g1 = *(const GAS f32x4*)(gain + k0 + 8 * c + 4); }
#pragma unroll
    for (int j = 0; j < 4; ++j) { const int n = (lane >> 3) + 8 * j; const LAS float* s = scr + (8 * c) * 33 + n;
        v4u o; o.x = pk2(s[0 * 33] * g0.x, s[1 * 33] * g0.y); o.y = pk2(s[2 * 33] * g0.z, s[3 * 33] * g0.w); o.z = pk2(s[4 * 33] * g1.x, s[5 * 33] * g1.y); o.w = pk2(s[6 * 33] * g1.z, s[7 * 33] * g1.w);
        if (n0 + n < N) *(GAS v4u*)(WT + (size_t)dest_row(kind, n0 + n) * K + k0 + 8 * c) = o; }
    LDS_WAIT(); asm volatile("" ::: "memory");
}
__device__ __forceinline__ void p0_prologue(const Ptrs& P, LAS unsigned char* lds, int tid, int wave, int lane, int vcu, int G) {
    LAS float* scr = (LAS float*)(lds + wave * 16384);
    const int gw = vcu * NWAVES + wave, NGW = G * NWAVES;
    constexpr int I_GU = (1024 / 64) * (2816 / 32), I_D = (2816 / 64) * (1024 / 32), I_IN = (1024 / 64) * ((DIN + 31) / 32), I_O = (1024 / 64) * (1024 / 32);
    constexpr int NITEMS = 4 * I_GU + 2 * I_D + I_IN + I_O;
    for (int it = gw; it < NITEMS; it += NGW) {
        int r = it;
        if (r < I_GU) { p0_transpose_item(P.wg1, 1024, 2816, P.wgu1, 1, P.g_ffn1, scr, r, lane); continue; } r -= I_GU;
        if (r < I_GU) { p0_transpose_item(P.wu1, 1024, 2816, P.wgu1, 2, P.g_ffn1, scr, r, lane); continue; } r -= I_GU;
        if (r < I_D)  { p0_transpose_item(P.wd1, 2816, 1024, P.wd1t, 0, nullptr, scr, r, lane); continue; } r -= I_D;
        if (r < I_GU) { p0_transpose_item(P.wg2, 1024, 2816, P.wgu2, 1, P.g_ffn2, scr, r, lane); continue; } r -= I_GU;
        if (r < I_GU) { p0_transpose_item(P.wu2, 1024, 2816, P.wgu2, 2, P.g_ffn2, scr, r, lane); continue; } r -= I_GU;
        if (r < I_D)  { p0_transpose_item(P.wd2, 2816, 1024, P.wd2t, 0, nullptr, scr, r, lane); continue; } r -= I_D;
        if (r < I_IN) { p0_transpose_item(P.w_in, 1024, DIN, P.wint, 3, P.g_mix, scr, r, lane); continue; } r -= I_IN;
        p0_transpose_item(P.w_out, 1024, 1024, P.woutt, 0, nullptr, scr, r, lane);
    }
    for (int m0 = gw; m0 < M; m0 += 2 * NGW) {
        const int m1 = m0 + NGW; const bool has1 = m1 < M; const int m1c = has1 ? m1 : m0;
        const float* xrow0 = (m0 < SEQ) ? P.x_p + (size_t)m0 * D : P.x_s + (size_t)(m0 - SEQ) * D;
        const float* xrow1 = (m1c < SEQ) ? P.x_p + (size_t)m1c * D : P.x_s + (size_t)(m1c - SEQ) * D;
        const GAS f32x4* xr0 = (const GAS f32x4*)xrow0 + lane; const GAS f32x4* xr1 = (const GAS f32x4*)xrow1 + lane;
        f32x4 v[4], w[4]; float s0 = 0.f, s1 = 0.f;
#pragma unroll
        for (int j = 0; j < 4; ++j) { v[j] = xr0[64 * j]; w[j] = xr1[64 * j]; }
#pragma unroll
        for (int j = 0; j < 4; ++j) { s0 += (v[j].x * v[j].x + v[j].y * v[j].y) + (v[j].z * v[j].z + v[j].w * v[j].w); s1 += (w[j].x * w[j].x + w[j].y * w[j].y) + (w[j].z * w[j].z + w[j].w * w[j].w); }
        s0 = wave_sum(s0); s1 = wave_sum(s1);
        GAS unsigned long long* o0 = (GAS unsigned long long*)(P.xn + (size_t)m0 * D) + lane;
        GAS unsigned long long* o1 = (GAS unsigned long long*)(P.xn + (size_t)m1c * D) + lane;
#pragma unroll
        for (int j = 0; j < 4; ++j) {
            o0[64 * j] = (unsigned long long)pk2(v[j].x, v[j].y) | ((unsigned long long)pk2(v[j].z, v[j].w) << 32);
            if (has1) o1[64 * j] = (unsigned long long)pk2(w[j].x, w[j].y) | ((unsigned long long)pk2(w[j].z, w[j].w) << 32); }
        if (lane < 16) { P.ss[(size_t)m0 * 16 + lane] = (lane == 0) ? s0 : 0.f; if (has1) P.ss[(size_t)m1 * 16 + lane] = (lane == 0) ? s1 : 0.f; }
    }
    {
        const int gt = vcu * NTHR + tid, NGT = G * NTHR;
        constexpr int PER_B = 124 * 128 / 4;
#pragma unroll 4
        for (int i = gt; i < 2 * DECB * PER_B; i += NGT) {
            const int which = i / (DECB * PER_B), r = i % (DECB * PER_B), b = r / PER_B, o = r % PER_B;
            const float* src = (which ? P.cv_in : P.ck_in) + (size_t)b * 16384 + 512 + 4 * o;
            float* dst = P.out + (which ? O_CVS : O_CKS) + (size_t)b * 16384 + 4 * o;
            *(f32x4*)dst = *(const f32x4*)src;
        }
    }
}

#define BAR_LDS() do { asm volatile("s_waitcnt lgkmcnt(0)" ::: "memory"); __builtin_amdgcn_s_barrier(); asm volatile("" ::: "memory"); } while (0)

struct GlRegs { f32x4 a; v4u kk; v4u vv[2]; float w[16]; float bg; };
__device__ __forceinline__ void gla_local_load(const Ptrs& P, int c, int h, int tid, GlRegs& R) {
    const int t0 = c * 64;
    { const int t = (tid & 255) >> 2, q = (tid & 3) * 4; R.a = *(const f32x4*)(P.alr + (size_t)(t0 + t) * 16 + q); }
    { const int j = tid >> 3, dc = tid & 7; R.kk = *(const v4u*)(P.kg + (size_t)(t0 + j) * 256 + 64 * h + 8 * dc); }
#pragma unroll
    for (int i = 0; i < 2; ++i) { const int q = tid + 512 * i, jj = q >> 4, cc = q & 15; R.vv[i] = *(const v4u*)(P.vg + (size_t)(t0 + jj) * 512 + 128 * h + 8 * cc); }
    const int d = tid & 63;
#pragma unroll
    for (int r = 0; r < 16; ++r) R.w[r] = P.w_gate_up[r * 256 + 64 * h + d];
    R.bg = P.b_gate[64 * h + d];
}
__device__ __forceinline__ void gla_local_unit(const Ptrs& P, LAS unsigned char* lds, int c, int h, int tid, int wave, int lane, const GlRegs& R) {
    LAS float* alrS = (LAS float*)(lds);
    LAS bf16* kS = (LAS bf16*)(lds + 4096);
    LAS float* segS = (LAS float*)(lds + 13312);
    LAS bf16* khT = (LAS bf16*)(lds + 15360);
    LAS bf16* vT = (LAS bf16*)(lds + 24576);
    const int t0 = c * 64, fr = lane & 15, fq = lane >> 4;
    if (tid < 256) { const int t = tid >> 2, q = (tid & 3) * 4; *(LAS f32x4*)(alrS + t * 16 + q) = R.a; }
    { const int j = tid >> 3, dc = tid & 7; *(LAS v4u*)(kS + j * 72 + 8 * dc) = R.kk; }
#pragma unroll
    for (int i = 0; i < 2; ++i) { const int q = tid + 512 * i, jj = q >> 4, cc = q & 15;
#pragma unroll
        for (int e = 0; e < 8; ++e) { const unsigned w = R.vv[i][e >> 1]; vT[(8 * cc + e) * 72 + jj] = (bf16)((e & 1) ? (w >> 16) : (w & 0xffffu)); } }
    BAR_LDS();
    const int d = tid & 63, seg = wave;
    float cum[8]; float run = 0.f;
#pragma unroll
    for (int i = 0; i < 8; ++i) { const LAS f32x4* ap = (const LAS f32x4*)(alrS + (8 * seg + i) * 16); float x = R.bg;
#pragma unroll
        for (int r4 = 0; r4 < 4; ++r4) { const f32x4 a = ap[r4]; x += (a[0] * R.w[4 * r4] + a[1] * R.w[4 * r4 + 1]) + (a[2] * R.w[4 * r4 + 2] + a[3] * R.w[4 * r4 + 3]); }
        run += logsig(x) * (1.0f / 16.0f); cum[i] = run; }
    segS[seg * 64 + d] = run;
    BAR_LDS();
    { float off = 0.f, last = 0.f;
#pragma unroll
      for (int s2 = 0; s2 < 8; ++s2) { const float v = segS[s2 * 64 + d]; last += v; off += (s2 < seg) ? v : 0.f; }
      unsigned pk[4];
#pragma unroll
      for (int i = 0; i < 8; i += 2) { const float ca = cum[i] + off, cb = cum[i + 1] + off;
          P.cum[(size_t)(t0 + 8 * seg + i) * 256 + 64 * h + d] = ca; P.cum[(size_t)(t0 + 8 * seg + i + 1) * 256 + 64 * h + d] = cb;
          pk[i >> 1] = pk2(bf1(kS[(8 * seg + i) * 72 + d]) * __expf(last - ca), bf1(kS[(8 * seg + i + 1) * 72 + d]) * __expf(last - cb)); }
      *(LAS v4u*)(khT + d * 72 + 8 * seg) = (v4u){pk[0], pk[1], pk[2], pk[3]};
      if (seg == 0) P.g[(size_t)(c * 4 + h) * 64 + d] = __expf(last); }
    BAR_LDS();
    { const int d0 = (wave & 3) * 16;
#pragma unroll
      for (int q = 0; q < 4; ++q) { const int dv0 = ((wave >> 2) * 4 + q) * 16; f32x4 acc = (f32x4){0.f, 0.f, 0.f, 0.f};
#pragma unroll
          for (int kk = 0; kk < 2; ++kk) acc = MFMA16(frag(vT, dv0, 72, 32 * kk, fr, fq), frag(khT, d0, 72, 32 * kk, fr, fq), acc);
          *(f32x4*)(P.ds + ((size_t)(c * 4 + h) * 64 + d0 + fr) * 128 + dv0 + 4 * fq) = acc; } }
}
__device__ __forceinline__ void gla_local_loop(const Ptrs& P, LAS unsigned char* lds, int first, int stride, int tid, int wave, int lane) {
    int u = first; if (u >= 1024) return;
    GlRegs R; gla_local_load(P, u >> 2, u & 3, tid, R);
    for (;;) {
        GlRegs C = R; const int un = u + stride; const bool more = un < 1024;
        if (more) gla_local_load(P, un >> 2, un & 3, tid, R);
        gla_local_unit(P, lds, u >> 2, u & 3, tid, wave, lane, C);
        BAR_LDS();
        if (!more) break; u = un;
    }
}

__device__ __forceinline__ void gla_sample_unit(const Ptrs& P, LAS unsigned char* lds, int b, int tid, int wave, int lane) {
    LAS float* cumS = (LAS float*)(lds);
    LAS float* qd = (LAS float*)(lds + 4096);
    LAS float* kd = (LAS float*)(lds + 8192);
    LAS float* ke = (LAS float*)(lds + 12288);
    LAS float* vS = (LAS float*)(lds + 16384);
    LAS float* attS = (LAS float*)(lds + 24576);
    LAS float* e3S = (LAS float*)(lds + 25088);
    const int r0 = SEQ + 4 * b;
#pragma unroll 1
    for (int i = 0; i < 2; ++i) { const int item = tid + 512 * i, t = item >> 8, col = item & 255; float x = P.b_gate[col];
#pragma unroll
        for (int r = 0; r < 16; ++r) x += P.alr[(size_t)(r0 + t) * 16 + r] * P.w_gate_up[r * 256 + col];
        cumS[t * 256 + col] = logsig(x) * (1.0f / 16.0f); }
    { const int t = tid >> 7, c4 = (tid & 127) * 4; const unsigned long long w = *(const unsigned long long*)(P.vg + (size_t)(r0 + t) * 512 + c4);
      vS[t * 512 + c4] = bflo((unsigned)w); vS[t * 512 + c4 + 1] = bfhi((unsigned)w); vS[t * 512 + c4 + 2] = bflo((unsigned)(w >> 32)); vS[t * 512 + c4 + 3] = bfhi((unsigned)(w >> 32)); }
    __syncthreads();
    if (tid < 256) { const int d = tid; const float c0 = cumS[d], c1 = c0 + cumS[256 + d], c2 = c1 + cumS[512 + d], c3 = c2 + cumS[768 + d];
        cumS[256 + d] = c1; cumS[512 + d] = c2; cumS[768 + d] = c3; e3S[d] = __expf(c3); }
    __syncthreads();
#pragma unroll 1
    for (int i = 0; i < 2; ++i) { const int item = tid + 512 * i, t = item >> 8, col = item & 255; const float cu = cumS[t * 256 + col], c3 = cumS[768 + col];
        const float q = bf1(P.qg[(size_t)(r0 + t) * 256 + col]), k = bf1(P.kg[(size_t)(r0 + t) * 256 + col]);
        qd[t * 256 + col] = q * __expf(cu); kd[t * 256 + col] = k * __expf(c3 - cu); ke[t * 256 + col] = k * __expf(-cu); }
    __syncthreads();
    { const int pr = tid >> 3, l8 = tid & 7, h = pr >> 4, i = (pr >> 2) & 3, j = pr & 3; float s = 0.f;
#pragma unroll
      for (int m = 0; m < 8; ++m) { const int col = 64 * h + l8 + 8 * m; s += qd[i * 256 + col] * ke[j * 256 + col]; }
      s += __shfl_xor(s, 1); s += __shfl_xor(s, 2); s += __shfl_xor(s, 4);
      if (l8 == 0) attS[pr] = (j <= i) ? s : 0.f; }
    __syncthreads();
    { const int h = tid >> 7, dv = tid & 127, c = 128 * h + dv;
      const float v0 = vS[c], v1 = vS[512 + c], v2 = vS[1024 + c], v3 = vS[1536 + c];
      float po[4] = {0.f, 0.f, 0.f, 0.f};
      const size_t sbase = ((size_t)(b * 4 + h) * 64) * 128 + dv;
#pragma unroll 1
      for (int d0 = 0; d0 < 64; d0 += 16) { float s0r[16];
#pragma unroll
          for (int dd = 0; dd < 16; ++dd) s0r[dd] = P.state0[sbase + (size_t)(d0 + dd) * 128];
#pragma unroll
          for (int dd = 0; dd < 16; ++dd) { const int col = 64 * h + d0 + dd; const float s0 = s0r[dd];
              P.out[O_SS + sbase + (size_t)(d0 + dd) * 128] = s0 * e3S[col] + ((kd[col] * v0 + kd[256 + col] * v1) + (kd[512 + col] * v2 + kd[768 + col] * v3));
              po[0] += qd[col] * s0; po[1] += qd[256 + col] * s0; po[2] += qd[512 + col] * s0; po[3] += qd[768 + col] * s0; } }
#pragma unroll
      for (int i = 0; i < 4; ++i) {
#pragma unroll
          for (int j = 0; j < 4; ++j) po[i] += attS[h * 16 + i * 4 + j] * ((j == 0) ? v0 : (j == 1) ? v1 : (j == 2) ? v2 : v3);
          const float sq = wave_sum(po[i] * po[i]); if (lane == 0) cumS[wave * 4 + i] = sq; }
      __syncthreads();
#pragma unroll
      for (int i = 0; i < 4; ++i) { const float tot = cumS[(2 * h) * 4 + i] + cumS[(2 * h + 1) * 4 + i];
          const float rs = rsqrtf(tot * (1.0f / 128.0f) + EPS);
          P.mix[(size_t)(r0 + i) * 1024 + c] = (bf16)f2bf(po[i] * rs * P.g_head[c] * bf1(P.rg[(size_t)(r0 + i) * 512 + c])); } }
    __syncthreads();
}

__device__ __forceinline__ void swa_sample_unit(const Ptrs& P, LAS unsigned char* lds, int b, int tid, int wave, int lane) {
    LAS float* qS = (LAS float*)(lds);
    LAS float* pS = (LAS float*)(lds + 8192);
    LAS float* kL = (LAS float*)(lds + 25600);
    LAS float* oP = (LAS float*)(lds + 93952);
    const int r0 = SEQ + 4 * b;
    { const int t = tid >> 7, c4 = (tid & 127) * 4;
      const unsigned long long w = *(const unsigned long long*)(P.qs + (size_t)(r0 + t) * 512 + c4);
      qS[t * 512 + c4] = bflo((unsigned)w); qS[t * 512 + c4 + 1] = bfhi((unsigned)w); qS[t * 512 + c4 + 2] = bflo((unsigned)(w >> 32)); qS[t * 512 + c4 + 3] = bfhi((unsigned)(w >> 32)); }
    { f32x4 kr[9];
#pragma unroll
      for (int i = 0; i < 9; ++i) { const int idx = tid + 512 * i, j = idx >> 5, c4 = (idx & 31) * 4;
          kr[i] = (f32x4){0.f, 0.f, 0.f, 0.f};
          if (idx < 4224) kr[i] = *(const f32x4*)((j < 128) ? P.ck_in + ((size_t)b * 128 + j) * 128 + c4 : P.out + O_CKS + ((size_t)b * 128 + 124 + (j - 128)) * 128 + c4); }
#pragma unroll
      for (int i = 0; i < 9; ++i) { const int idx = tid + 512 * i, j = idx >> 5, c4 = (idx & 31) * 4;
          if (idx < 4224) { LAS float* d = kL + j * 129 + c4; d[0] = kr[i].x; d[1] = kr[i].y; d[2] = kr[i].z; d[3] = kr[i].w; } } }
    __syncthreads();
    f32x4 vr[9];
#pragma unroll
    for (int i = 0; i < 9; ++i) { const int idx = tid + 512 * i, j = idx >> 5, c4 = (idx & 31) * 4;
        vr[i] = (f32x4){0.f, 0.f, 0.f, 0.f};
        if (idx < 4224) vr[i] = *(const f32x4*)((j < 128) ? P.cv_in + ((size_t)b * 128 + j) * 128 + c4 : P.out + O_CVS + ((size_t)b * 128 + 124 + (j - 128)) * 128 + c4); }
    if (tid < 264) {
        const int j = tid >> 1, kvh = tid & 1; float s[16];
#pragma unroll
        for (int i = 0; i < 16; ++i) s[i] = 0.f;
#pragma unroll 2
        for (int d = 0; d < 64; ++d) { const float kv = kL[j * 129 + 64 * kvh + d];
#pragma unroll
            for (int hl = 0; hl < 4; ++hl)
#pragma unroll
                for (int t = 0; t < 4; ++t) s[hl * 4 + t] += qS[t * 512 + 64 * (4 * kvh + hl) + d] * kv; }
#pragma unroll
        for (int hl = 0; hl < 4; ++hl)
#pragma unroll
            for (int t = 0; t < 4; ++t) { const bool valid = (j <= 128 + t) && (j >= t + 1); pS[((4 * kvh + hl) * 4 + t) * 136 + j] = valid ? s[hl * 4 + t] : -INFINITY; }
    }
    __syncthreads();
#pragma unroll
    for (int i = 0; i < 9; ++i) { const int idx = tid + 512 * i, j = idx >> 5, c4 = (idx & 31) * 4;
        if (idx < 4224) { LAS float* d = kL + j * 129 + c4; d[0] = vr[i].x; d[1] = vr[i].y; d[2] = vr[i].z; d[3] = vr[i].w; } }
    {
#pragma unroll 1
        for (int rr = 0; rr < 4; ++rr) { const int row = 4 * wave + rr, hh = row >> 2; const float sink = P.sinks[hh];
            float v0 = pS[row * 136 + lane], v1 = pS[row * 136 + 64 + lane], v2 = (lane < 4) ? pS[row * 136 + 128 + lane] : -INFINITY;
            float m = fmaxf(fmaxf(v0, v1), v2);
#pragma unroll
            for (int o = 1; o < 64; o <<= 1) m = fmaxf(m, __shfl_xor(m, o));
            m = fmaxf(m, sink);
            const float e0 = __expf(v0 - m), e1 = __expf(v1 - m), e2 = (lane < 4) ? __expf(v2 - m) : 0.f;
            const float den = wave_sum(e0 + e1 + e2) + __expf(sink - m), inv = 1.0f / den;
            pS[row * 136 + lane] = e0 * inv; pS[row * 136 + 64 + lane] = e1 * inv; if (lane < 4) pS[row * 136 + 128 + lane] = e2 * inv; }
    }
    __syncthreads();
    {
        const int part = tid >> 7, kvh = (tid >> 6) & 1, d = tid & 63; float o[16];
#pragma unroll
        for (int i = 0; i < 16; ++i) o[i] = 0.f;
#pragma unroll 1
        for (int jj = 0; jj < 33; ++jj) { const int j = part * 33 + jj; const float vv = kL[j * 129 + 64 * kvh + d];
#pragma unroll
            for (int hl = 0; hl < 4; ++hl)
#pragma unroll
                for (int t = 0; t < 4; ++t) o[hl * 4 + t] += pS[((4 * kvh + hl) * 4 + t) * 136 + j] * vv; }
#pragma unroll
        for (int hl = 0; hl < 4; ++hl)
#pragma unroll
            for (int t = 0; t < 4; ++t) oP[(part * 4 + t) * 512 + 64 * (4 * kvh + hl) + d] = o[hl * 4 + t];
    }
    __syncthreads();
    if (wave < 4) { const int t = wave; float v[8]; float sq = 0.f;
#pragma unroll
        for (int e = 0; e < 8; ++e) { const int c = lane + 64 * e; v[e] = (oP[(0 * 4 + t) * 512 + c] + oP[(1 * 4 + t) * 512 + c]) + (oP[(2 * 4 + t) * 512 + c] + oP[(3 * 4 + t) * 512 + c]); sq += v[e] * v[e]; }
        const float rs = rsqrtf(wave_sum(sq) * (1.0f / 512.0f) + EPS);
#pragma unroll
        for (int e = 0; e < 8; ++e) P.mix[(size_t)(r0 + t) * 1024 + 512 + lane + 64 * e] = (bf16)f2bf(v[e] * rs * P.g_swa[lane + 64 * e]); }
    __syncthreads();
}

__device__ __forceinline__ void gla_scan2(const Ptrs& P, LAS unsigned char* lds, int blk, int tid) {
    LAS float* As = (LAS float*)lds;
    LAS float* Ps = (LAS float*)(lds + 2048);
    const int seg = tid >> 6, el = tid & 63, e = blk * 64 + el, h = e >> 13, d = (e >> 7) & 63;
    float* dsp = P.ds + e + (size_t)(seg * 32) * 32768;
    const float* gp = P.g + h * 64 + d + (size_t)(seg * 32) * 256;
    float dsv[32], gv[32];
#pragma unroll
    for (int i = 0; i < 32; ++i) { dsv[i] = dsp[(size_t)i * 32768]; gv[i] = gp[(size_t)i * 256]; }
    float A = 0.f, Pm = 1.f;
#pragma unroll
    for (int i = 0; i < 32; ++i) { A = A * gv[i] + dsv[i]; Pm *= gv[i]; }
    As[seg * 64 + el] = A; Ps[seg * 64 + el] = Pm;
    __syncthreads();
    float S = 0.f;
    for (int s2 = 0; s2 < seg; ++s2) S = S * Ps[s2 * 64 + el] + As[s2 * 64 + el];
#pragma unroll
    for (int i = 0; i < 32; ++i) { dsp[(size_t)i * 32768] = S; S = S * gv[i] + dsv[i]; }
    if (seg == 7) P.out[O_SP + e] = S;
    __syncthreads();
}

struct SwRegs { v4u kk[3], vv[3], qq[2]; };
__device__ __forceinline__ void swa_prompt_load(const Ptrs& P, int qb, int g, int tid, SwRegs& R) {
    const int q0 = qb * 32, kbase = q0 - 128;
#pragma unroll
    for (int i = 0; i < 3; ++i) { const int q = tid + 512 * i, j = q >> 3, ch = q & 7, tok = kbase + j;
        R.kk[i] = (v4u){0u, 0u, 0u, 0u}; R.vv[i] = (v4u){0u, 0u, 0u, 0u};
        if (q < 1280 && tok >= 0) { const bf16* p = P.kvs + (size_t)tok * 256 + 64 * g + 8 * ch; R.kk[i] = *(const v4u*)p; R.vv[i] = *(const v4u*)(p + 128); } }
#pragma unroll
    for (int i = 0; i < 2; ++i) { const int q = tid + 512 * i, r = q >> 3, ch = q & 7, hl = r >> 5, ql = r & 31;
        R.qq[i] = *(const v4u*)(P.qs + (size_t)(q0 + ql) * 512 + 64 * (4 * g + hl) + 8 * ch); }
}
__device__ __forceinline__ void swa_prompt_unit(const Ptrs& P, LAS unsigned char* lds, int qb, int g, int tid, int wave, int lane, const SwRegs& R) {
    LAS bf16* Ks = (LAS bf16*)(lds);
    LAS bf16* VsT = (LAS bf16*)(lds + 23040);
    LAS bf16* Qs = (LAS bf16*)(lds + 44544);
    LAS bf16* Ps = (LAS bf16*)(lds + 62976);
    const int q0 = qb * 32, kbase = q0 - 128, fr = lane & 15, fq = lane >> 4;
#pragma unroll
    for (int i = 0; i < 3; ++i) { const int q = tid + 512 * i, j = q >> 3, ch = q & 7;
        if (q < 1280) { *(LAS v4u*)(Ks + j * 72 + 8 * ch) = R.kk[i];
#pragma unroll
            for (int e = 0; e < 8; ++e) { const unsigned w = R.vv[i][e >> 1]; VsT[(8 * ch + e) * 168 + j] = (bf16)((e & 1) ? (w >> 16) : (w & 0xffffu)); } } }
#pragma unroll
    for (int i = 0; i < 2; ++i) { const int q = tid + 512 * i, r = q >> 3, ch = q & 7; *(LAS v4u*)(Qs + r * 72 + 8 * ch) = R.qq[i]; }
    BAR_LDS();
    const int r0 = 16 * wave, head = 4 * g + (wave >> 1), ql0 = 16 * (wave & 1);
    const int qpos = q0 + ql0 + fr; const float sink = P.sinks[head];
    f32x4 s[10];
#pragma unroll
    for (int t = 0; t < 10; ++t) s[t] = (f32x4){0.f, 0.f, 0.f, 0.f};
#pragma unroll
    for (int kk = 0; kk < 2; ++kk) { const bf16x8 bq = frag(Qs, r0, 72, 32 * kk, fr, fq);
#pragma unroll
        for (int t = 0; t < 10; ++t) s[t] = MFMA16(frag(Ks, 16 * t, 72, 32 * kk, fr, fq), bq, s[t]); }
    float m = -INFINITY;
#pragma unroll
    for (int t = 0; t < 10; ++t)
#pragma unroll
        for (int r = 0; r < 4; ++r) { const int kpos = kbase + 16 * t + 4 * fq + r; const bool valid = (kpos >= 0) && (kpos <= qpos) && (qpos - kpos < 128);
            s[t][r] = valid ? s[t][r] : -INFINITY; m = fmaxf(m, s[t][r]); }
    m = fmaxf(m, __shfl_xor(m, 16)); m = fmaxf(m, __shfl_xor(m, 32)); m = fmaxf(m, sink);
    float sum = 0.f;
#pragma unroll
    for (int t = 0; t < 10; ++t)
#pragma unroll
        for (int r = 0; r < 4; ++r) { const float p = __expf(s[t][r] - m); s[t][r] = p; sum += p; }
    sum += __shfl_xor(sum, 16); sum += __shfl_xor(sum, 32);
    const float inv = 1.0f / (sum + __expf(sink - m));
#pragma unroll
    for (int t = 0; t < 10; ++t) { unsigned long long w = (unsigned long long)pk2(s[t][0] * inv, s[t][1] * inv) | ((unsigned long long)pk2(s[t][2] * inv, s[t][3] * inv) << 32);
        *(LAS unsigned long long*)(Ps + (r0 + fr) * 168 + 16 * t + 4 * fq) = w; }
    asm volatile("s_waitcnt lgkmcnt(0)" ::: "memory");
    f32x4 o[4];
#pragma unroll
    for (int dt = 0; dt < 4; ++dt) o[dt] = (f32x4){0.f, 0.f, 0.f, 0.f};
#pragma unroll
    for (int ks = 0; ks < 5; ++ks) { const bf16x8 bp = frag(Ps, r0, 168, 32 * ks, fr, fq);
#pragma unroll
        for (int dt = 0; dt < 4; ++dt) o[dt] = MFMA16(frag(VsT, 16 * dt, 168, 32 * ks, fr, fq), bp, o[dt]); }
    float sq = 0.f;
#pragma unroll
    for (int dt = 0; dt < 4; ++dt) sq += (o[dt][0] * o[dt][0] + o[dt][1] * o[dt][1]) + (o[dt][2] * o[dt][2] + o[dt][3] * o[dt][3]);
    sq += __shfl_xor(sq, 16); sq += __shfl_xor(sq, 32);
    if (fq == 0) P.ssw[(size_t)qpos * 8 + head] = sq;
#pragma unroll
    for (int dt = 0; dt < 4; ++dt) { const unsigned long long w = (unsigned long long)pk2(o[dt][0], o[dt][1]) | ((unsigned long long)pk2(o[dt][2], o[dt][3]) << 32);
        *(unsigned long long*)(P.mix + (size_t)qpos * 1024 + 512 + 64 * head + 16 * dt + 4 * fq) = w; }
}
__device__ __forceinline__ void swa_prompt_loop(const Ptrs& P, LAS unsigned char* lds, int first, int stride, int tid, int wave, int lane) {
    int u = first; if (u >= 1024) return;
    SwRegs R; swa_prompt_load(P, u >> 1, u & 1, tid, R);
    for (;;) {
        SwRegs C = R; const int un = u + stride; const bool more = un < 1024;
        if (more) swa_prompt_load(P, un >> 1, un & 1, tid, R);
        swa_prompt_unit(P, lds, u >> 1, u & 1, tid, wave, lane, C);
        BAR_LDS();
        if (!more) break; u = un;
    }
}

struct GoRegs { v4u qq, kk; f32x4 c0, c1; v4u vv[2]; f32x4 sv[4]; };
struct GoEpi { v4u r0, r1, a0, a1; f32x4 sa, sb; };
__device__ __forceinline__ void gla_out_load(const Ptrs& P, int c, int h, int tid, GoRegs& R) {
    const int t0 = c * 64, j = tid >> 3, dc = tid & 7;
    R.qq = *(const v4u*)(P.qg + (size_t)(t0 + j) * 256 + 64 * h + 8 * dc); R.kk = *(const v4u*)(P.kg + (size_t)(t0 + j) * 256 + 64 * h + 8 * dc);
    const float* cp = P.cum + (size_t)(t0 + j) * 256 + 64 * h + 8 * dc; R.c0 = *(const f32x4*)cp; R.c1 = *(const f32x4*)(cp + 4);
#pragma unroll
    for (int i = 0; i < 2; ++i) { const int q = tid + 512 * i, jj = q >> 4, cc = q & 15; R.vv[i] = *(const v4u*)(P.vg + (size_t)(t0 + jj) * 512 + 128 * h + 8 * cc); }
#pragma unroll
    for (int i = 0; i < 4; ++i) { const int q = tid + 512 * i, d = q >> 5, dv4 = (q & 31) * 4; R.sv[i] = *(const f32x4*)(P.ds + ((size_t)(c * 4 + h) * 64 + d) * 128 + dv4); }
}
__device__ __forceinline__ void gla_out_load_epi(const Ptrs& P, int c, int h, int tid, GoEpi& E) {
    const int i = tid >> 3, seg = tid & 7, tok = c * 64 + i, col = 128 * h + 16 * seg;
    E.r0 = *(const v4u*)(P.rg + (size_t)tok * 512 + col); E.r1 = *(const v4u*)(P.rg + (size_t)tok * 512 + col + 8);
    const bf16* mp = P.mix + (size_t)tok * 1024 + 512 + col; E.a0 = *(const v4u*)mp; E.a1 = *(const v4u*)(mp + 8);
    E.sa = *(const f32x4*)(P.ssw + (size_t)tok * 8); E.sb = *(const f32x4*)(P.ssw + (size_t)tok * 8 + 4);
}
__device__ __forceinline__ void gla_out_unit(const Ptrs& P, LAS unsigned char* lds, int c, int h, int tid, int wave, int lane, const GoRegs& R, const GoEpi& E) {
    LAS bf16* qT = (LAS bf16*)(lds);
    LAS bf16* kT = (LAS bf16*)(lds + 9216);
    LAS bf16* vT = (LAS bf16*)(lds + 18432);
    LAS bf16* sT = (LAS bf16*)(lds + 36864);
    LAS bf16* aS = (LAS bf16*)(lds + 55296);
    LAS float* oS = (LAS float*)(lds + 64512);
    const int t0 = c * 64, fr = lane & 15, fq = lane >> 4;
    { const int j = tid >> 3, dc = tid & 7;
      float cu[8] = {R.c0[0], R.c0[1], R.c0[2], R.c0[3], R.c1[0], R.c1[1], R.c1[2], R.c1[3]}; v4u qo, ko;
#pragma unroll
      for (int e2 = 0; e2 < 4; ++e2) { const float ea = __expf(cu[2 * e2]), eb = __expf(cu[2 * e2 + 1]);
          qo[e2] = pk2(bflo(R.qq[e2]) * ea, bfhi(R.qq[e2]) * eb); ko[e2] = pk2(bflo(R.kk[e2]) * __builtin_amdgcn_rcpf(ea), bfhi(R.kk[e2]) * __builtin_amdgcn_rcpf(eb)); }
      *(LAS v4u*)(qT + j * 72 + 8 * dc) = qo; *(LAS v4u*)(kT + j * 72 + 8 * dc) = ko;
#pragma unroll
      for (int i = 0; i < 2; ++i) { const int q = tid + 512 * i, jj = q >> 4, cc = q & 15;
#pragma unroll
          for (int e = 0; e < 8; ++e) { const unsigned w = R.vv[i][e >> 1]; vT[(8 * cc + e) * 72 + jj] = (bf16)((e & 1) ? (w >> 16) : (w & 0xffffu)); } }
#pragma unroll
      for (int i = 0; i < 4; ++i) { const int q = tid + 512 * i, d = q >> 5, dv4 = (q & 31) * 4;
#pragma unroll
          for (int e = 0; e < 4; ++e) sT[(dv4 + e) * 72 + d] = (bf16)f2bf(R.sv[i][e]); } }
    BAR_LDS();
    { const int i0 = (wave >> 1) * 16;
#pragma unroll
      for (int q = 0; q < 2; ++q) { const int j0 = ((wave & 1) * 2 + q) * 16; f32x4 acc = (f32x4){0.f, 0.f, 0.f, 0.f};
#pragma unroll
          for (int kk = 0; kk < 2; ++kk) acc = MFMA16(frag(kT, j0, 72, 32 * kk, fr, fq), frag(qT, i0, 72, 32 * kk, fr, fq), acc);
          const int i = i0 + fr, jb = j0 + 4 * fq;
          const unsigned long long w = (unsigned long long)pk2(jb <= i ? acc[0] : 0.f, jb + 1 <= i ? acc[1] : 0.f) | ((unsigned long long)pk2(jb + 2 <= i ? acc[2] : 0.f, jb + 3 <= i ? acc[3] : 0.f) << 32);
          *(LAS unsigned long long*)(aS + i * 72 + jb) = w; } }
    BAR_LDS();
    { const int i0 = (wave & 3) * 16;
#pragma unroll
      for (int q = 0; q < 4; ++q) { const int dv0 = ((wave >> 2) * 4 + q) * 16; f32x4 acc = (f32x4){0.f, 0.f, 0.f, 0.f};
#pragma unroll
          for (int kk = 0; kk < 2; ++kk) { acc = MFMA16(frag(vT, dv0, 72, 32 * kk, fr, fq), frag(aS, i0, 72, 32 * kk, fr, fq), acc);
                                           acc = MFMA16(frag(sT, dv0, 72, 32 * kk, fr, fq), frag(qT, i0, 72, 32 * kk, fr, fq), acc); }
          *(LAS f32x4*)(oS + (i0 + fr) * 132 + dv0 + 4 * fq) = acc; } }
    BAR_LDS();
    { const int i = tid >> 3, seg = tid & 7, tok = t0 + i, col = 128 * h + 16 * seg;
      f32x4 ov[4]; float sq = 0.f;
#pragma unroll
      for (int e = 0; e < 4; ++e) { ov[e] = *(const LAS f32x4*)(oS + i * 132 + 16 * seg + 4 * e); sq += (ov[e][0] * ov[e][0] + ov[e][1] * ov[e][1]) + (ov[e][2] * ov[e][2] + ov[e][3] * ov[e][3]); }
      sq += __shfl_xor(sq, 1); sq += __shfl_xor(sq, 2); sq += __shfl_xor(sq, 4);
      const float rs = rsqrtf(sq * (1.0f / 128.0f) + EPS);
      v4u w0, w1;
#pragma unroll
      for (int e2 = 0; e2 < 4; ++e2) { const int cc = col + 2 * e2;
          w0[e2] = pk2(ov[e2 >> 1][(2 * e2) & 3] * rs * P.g_head[cc] * bflo(E.r0[e2]), ov[e2 >> 1][(2 * e2 + 1) & 3] * rs * P.g_head[cc + 1] * bfhi(E.r0[e2]));
          w1[e2] = pk2(ov[2 + (e2 >> 1)][(2 * e2) & 3] * rs * P.g_head[cc + 8] * bflo(E.r1[e2]), ov[2 + (e2 >> 1)][(2 * e2 + 1) & 3] * rs * P.g_head[cc + 9] * bfhi(E.r1[e2])); }
      *(v4u*)(P.mix + (size_t)tok * 1024 + col) = w0; *(v4u*)(P.mix + (size_t)tok * 1024 + col + 8) = w1;
      const float rs2 = rsqrtf((((E.sa[0] + E.sa[1]) + (E.sa[2] + E.sa[3])) + ((E.sb[0] + E.sb[1]) + (E.sb[2] + E.sb[3]))) * (1.0f / 512.0f) + EPS);
      bf16* mp = P.mix + (size_t)tok * 1024 + 512 + col; v4u b0, b1;
#pragma unroll
      for (int e2 = 0; e2 < 4; ++e2) { const int cc = col + 2 * e2;
          b0[e2] = pk2(bflo(E.a0[e2]) * rs2 * P.g_swa[cc], bfhi(E.a0[e2]) * rs2 * P.g_swa[cc + 1]);
          b1[e2] = pk2(bflo(E.a1[e2]) * rs2 * P.g_swa[cc + 8], bfhi(E.a1[e2]) * rs2 * P.g_swa[cc + 9]); }
      *(v4u*)mp = b0; *(v4u*)(mp + 8) = b1; }
}
__device__ __forceinline__ void gla_out_loop(const Ptrs& P, LAS unsigned char* lds, int first, int stride, int tid, int wave, int lane) {
    int u = first; if (u >= 1024) return;
    GoRegs R; GoEpi E; gla_out_load(P, u >> 2, u & 3, tid, R); gla_out_load_epi(P, u >> 2, u & 3, tid, E);
    for (;;) {
        GoRegs C = R; const int un = u + stride; const bool more = un < 1024;
        if (more) gla_out_load(P, un >> 2, un & 3, tid, R);
        gla_out_unit(P, lds, u >> 2, u & 3, tid, wave, lane, C, E);
        if (more) gla_out_load_epi(P, un >> 2, un & 3, tid, E);
        BAR_LDS();
        if (!more) break; u = un;
    }
}

__device__ __forceinline__ void final_norm_prompt(const Ptrs& P, int wave, int lane, int bidx, int nb) {
    const int gw = bidx * NWAVES + wave, NGW = nb * NWAVES;
    f32x4 gg[4];
#pragma unroll
    for (int j = 0; j < 4; ++j) gg[j] = *((const GAS f32x4*)P.g_final + 4 * lane + j);
    for (int m0 = gw; m0 < SEQ; m0 += 4 * NGW) {
        v4u v[4][2]; float rs[4]; int mm[4];
#pragma unroll
        for (int r = 0; r < 4; ++r) { const int m = m0 + r * NGW; mm[r] = m < SEQ ? m : m0;
            const GAS v4u* xr = (const GAS v4u*)(P.xn + (size_t)mm[r] * D) + 2 * lane; v[r][0] = xr[0]; v[r][1] = xr[1]; }
#pragma unroll
        for (int r = 0; r < 4; ++r) rs[r] = pg8::row_rs16(P.ss, mm[r]);
#pragma unroll
        for (int r = 0; r < 4; ++r) { if (r > 0 && m0 + r * NGW >= SEQ) continue;
            GAS f32x4* yw = (GAS f32x4*)(P.out + (size_t)mm[r] * D) + 4 * lane;
#pragma unroll
            for (int j = 0; j < 4; ++j) { const unsigned a = v[r][j >> 1][(2 * j) & 3], b = v[r][j >> 1][(2 * j + 1) & 3];
                yw[j] = (f32x4){bflo(a), bfhi(a), bflo(b), bfhi(b)} * rs[r] * gg[j]; } }
    }
}
__device__ __forceinline__ void final_sample(const Ptrs& P, const float* slabs, int wave, int lane, int vcu, int G) {
    const int gw = vcu * NWAVES + wave, NGW = G * NWAVES;
    for (int r = gw; r < NSAMP; r += NGW) {
        const GAS unsigned long long* xb = (const GAS unsigned long long*)(P.xn + (size_t)(SEQ + r) * D) + lane;
        GAS f32x4* yr = (GAS f32x4*)(P.out + (size_t)(SEQ + r) * D) + lane;
        f32x4 v[4]; float s = 0.f;
#pragma unroll
        for (int j = 0; j < 4; ++j) { const GAS f32x4* sp = (const GAS f32x4*)(slabs + (size_t)r * D) + lane + 64 * j;
            const f32x4 a = (sp[0] + sp[(size_t)NSAMP * D / 4]) + (sp[(size_t)2 * NSAMP * D / 4] + sp[(size_t)3 * NSAMP * D / 4]);
            const unsigned long long w = xb[64 * j];
            v[j] = (f32x4){bflo((unsigned)w), bfhi((unsigned)w), bflo((unsigned)(w >> 32)), bfhi((unsigned)(w >> 32))} + a * 0.5f;
            s += (v[j].x * v[j].x + v[j].y * v[j].y) + (v[j].z * v[j].z + v[j].w * v[j].w); }
        const float rs = rsqrtf(wave_sum(s) * (1.f / D) + EPS);
#pragma unroll
        for (int j = 0; j < 4; ++j) { const f32x4 gg = *((const GAS f32x4*)P.g_final + lane + 64 * j); yr[64 * j] = v[j] * rs * gg; }
    }
}

#ifndef PROBE_REP_HI
#define PROBE_REP_HI (-1)
#endif
#ifndef MK_N_LAUNCHES
#define MK_N_LAUNCHES 1
#endif
constexpr int N_PHASES = 12;
__global__ void __launch_bounds__(NTHR, 2) hymba_fwd(Args args) {
    extern __shared__ __attribute__((aligned(16))) unsigned char lds_raw[];
    LAS unsigned char* lds = (LAS unsigned char*)lds_raw;
    volatile LAS unsigned* MISC = (volatile LAS unsigned*)(lds + MISC_OFF);
    const int tid = threadIdx.x, lane = tid & 63, wave = __builtin_amdgcn_readfirstlane(tid >> 6);
    const int G = gridDim.x, bx = blockIdx.x, vcu = (G % 8 == 0) ? (bx % 8) * (G / 8) + bx / 8 : bx;
    unsigned char* ws = args.ws;
    Ptrs P;
    P.x_p = args.in[0]; P.x_s = args.in[1]; P.state0 = args.in[2]; P.ck_in = args.in[3]; P.cv_in = args.in[4]; P.g_ffn1 = args.in[5]; P.wg1 = args.in[6]; P.wu1 = args.in[7]; P.wd1 = args.in[8];
    P.g_mix = args.in[9]; P.w_in = args.in[10]; P.w_gate_up = args.in[11]; P.b_gate = args.in[12]; P.g_head = args.in[13]; P.g_swa = args.in[14]; P.sinks = args.in[15]; P.w_out = args.in[16];
    P.g_ffn2 = args.in[17]; P.wg2 = args.in[18]; P.wu2 = args.in[19]; P.wd2 = args.in[20]; P.g_final = args.in[21];
    P.out = args.out;
    P.wgu1 = (bf16*)(ws + WS_WGU1); P.wd1t = (bf16*)(ws + WS_WD1); P.wgu2 = (bf16*)(ws + WS_WGU2); P.wd2t = (bf16*)(ws + WS_WD2); P.wint = (bf16*)(ws + WS_WIN); P.woutt = (bf16*)(ws + WS_WOUT);
    P.xn = (bf16*)(ws + WS_XN); P.mix = (bf16*)(ws + WS_MIX); P.hbuf = (bf16*)(ws + WS_R);
    P.qg = (bf16*)(ws + WS_R + R_QG); P.kg = (bf16*)(ws + WS_R + R_KG); P.vg = (bf16*)(ws + WS_R + R_VG); P.rg = (bf16*)(ws + WS_R + R_RG); P.qs = (bf16*)(ws + WS_R + R_QS); P.kvs = (bf16*)(ws + WS_R + R_KVS);
    P.cum = (float*)(ws + WS_R + R_CUM);
    P.ss = (float*)(ws + WS_SS); P.ssw = (float*)(ws + WS_SSW); P.alr = (float*)(ws + WS_ALR); P.g = (float*)(ws + WS_G); P.ds = (float*)(ws + WS_DS);

    for (int u = tid; u < (LDS_BYTES - RING_BYTES) / 4; u += NTHR) ((LAS unsigned*)(lds + RING_BYTES))[u] = 0u;
    __syncthreads();
    const int lo = args.ph_lo, hi = args.ph_hi;
    unsigned* barw = (unsigned*)(ws + WS_CTL) + args.bar_region * XCD_BAR_WORDS;
    XcdBarrier bar; bar.bar = barw; bar.x = 0; bar.st = nullptr;
    if (hi - lo > 1) bar = xcd_barrier_post(barw, MISC + 8);
#define IN(k) (lo <= (k) && (k) < hi)
#define SEAM(k) do { if (IN(k) && IN((k) + 1)) xcd_barrier(bar); } while (0)

    if (IN(0)) p0_prologue(P, lds, tid, wave, lane, vcu, G);
    SEAM(0);
    if (IN(1)) { pg8::Gemm g{P.xn, P.wgu1, M, 5632, 1024, 1024}; pg8::StaticOrder S; S.init(M, 5632, G, bx); pg8::EpiGU E{P.hbuf, P.ss, (LAS float*)(lds + RING_BYTES + 1024)};
        pg8::gemm_phase<pg8::EpiGU, pg8::StaticOrder, true, true>(lds, g, S, E); }
    SEAM(1);
    if (IN(2)) { pg8::Gemm g{P.hbuf, P.wd1t, M, 1024, 2816, 2816}; pg8::SubOrder S; S.init(64, 1024, 0, G, 0, bx); pg8::EpiRes E{P.xn, P.ss, 0.5f};
        pg8::gemm_phase<pg8::EpiRes, pg8::SubOrder, true, true>(lds, g, S, E); }
    SEAM(2);
    if (IN(3)) {
        if (bx < G - 8) { pg8::Gemm g{P.xn, P.wint, M, NPROJ, 1024, 1024}; pg8::SubOrder S; S.init(64, NPROJ, 0, G - 8, 0, bx);
            pg8::EpiProj E{P.ss, P.qg, P.kg, P.vg, P.rg, P.qs, P.kvs, P.alr, P.out + O_CKP, P.out + O_CVP, P.out + O_CKS, P.out + O_CVS, (LAS float*)(lds + RING_BYTES + 1024)};
            pg8::gemm_phase<pg8::EpiProj, pg8::SubOrder, true, true>(lds, g, S, E); }
        else { pg8::Gemm g{P.hbuf, P.wd1t, M, 1024, 2816, 2816}; pg8::SubOrder S; S.init(2, 1024, G - 8, 8, 64, bx); pg8::EpiRes E{P.xn, P.ss, 0.5f};
            pg8::gemm_phase<pg8::EpiRes, pg8::SubOrder, true, true>(lds, g, S, E); }
    }
    SEAM(3);
    if (IN(4)) {
        if (bx < G - 20) { gla_local_loop(P, lds, bx, G - 20, tid, wave, lane);
#ifdef PROBE_REP_GL
            gla_local_loop(P, lds, bx, G - 20, tid, wave, lane);
#endif
            swa_prompt_loop(P, lds, bx, G - 20, tid, wave, lane);
#ifdef PROBE_REP_SW
            swa_prompt_loop(P, lds, bx, G - 20, tid, wave, lane);
#endif
        }
        else { pg8::Gemm g{P.xn, P.wint, M, NPROJ, 1024, 1024}; pg8::SubOrder S; S.init(2, NPROJ, G - 20, 20, 64, bx);
            pg8::EpiProj E{P.ss, P.qg, P.kg, P.vg, P.rg, P.qs, P.kvs, P.alr, P.out + O_CKP, P.out + O_CVP, P.out + O_CKS, P.out + O_CVS, (LAS float*)(lds + RING_BYTES + 1024)};
            pg8::gemm_phase<pg8::EpiProj, pg8::SubOrder, true, true>(lds, g, S, E); }
    }
    SEAM(4);
    if (IN(5)) {
        for (int sb = bx; sb < 512; sb += G) gla_scan2(P, lds, sb, tid);
        for (int u = bx; u < 128; u += G) swa_sample_unit(P, lds, u, tid, wave, lane);
        for (int u = bx; u < 256; u += G) if (u >= 128) gla_sample_unit(P, lds, u - 128, tid, wave, lane);
    }
    SEAM(5);
    if (IN(6)) {
        if (bx < G - 8) gla_out_loop(P, lds, bx, G - 8, tid, wave, lane);
        else { pg8::Gemm g{P.mix, P.woutt, M, 1024, 1024, 1024}; pg8::SubOrder S; S.init(2, 1024, G - 8, 8, 64, bx); pg8::EpiRes E{P.xn, P.ss, 1.0f};
            pg8::gemm_phase<pg8::EpiRes, pg8::SubOrder, true, true>(lds, g, S, E); }
    }
    SEAM(6);
    if (IN(7)) { pg8::Gemm g{P.mix, P.woutt, M, 1024, 1024, 1024}; pg8::SubOrder S; S.init(64, 1024, 0, G, 0, bx); pg8::EpiRes E{P.xn, P.ss, 1.0f};
        pg8::gemm_phase<pg8::EpiRes, pg8::SubOrder, true, true>(lds, g, S, E); }
    SEAM(7);
    if (IN(8)) { pg8::Gemm g{P.xn, P.wgu2, M, 5632, 1024, 1024}; pg8::StaticOrder S; S.init(M, 5632, G, bx); pg8::EpiGU E{P.hbuf, P.ss, (LAS float*)(lds + RING_BYTES + 1024)};
        pg8::gemm_phase<pg8::EpiGU, pg8::StaticOrder, true, true>(lds, g, S, E); }
    SEAM(8);
    if (IN(9)) { pg8::Gemm g{P.hbuf, P.wd2t, M, 1024, 2816, 2816}; pg8::SubOrder S; S.init(64, 1024, 0, G, 0, bx); pg8::EpiRes E{P.xn, P.ss, 0.5f};
        pg8::gemm_phase<pg8::EpiRes, pg8::SubOrder, true, true>(lds, g, S, E); }
    SEAM(9);
    if (IN(10)) {
        if (bx < G - 32) final_norm_prompt(P, wave, lane, bx, G - 32);
        else { const int j = bx - (G - 32), ks = j >> 3, tile = j & 7;
            const int koff = ks < 2 ? 768 * ks : 1536 + 640 * (ks - 2), klen = ks < 2 ? 768 : 640;
            pg8::Gemm g{P.hbuf + koff, P.wd2t + koff, M, 1024, klen, 2816}; pg8::OneUnit S; S.u0.pm = 64 + (tile & 1); S.u0.pn = tile >> 1; S.on = true;
            pg8::EpiPartial E{P.ds + (size_t)ks * NSAMP * 1024};
            pg8::gemm_phase<pg8::EpiPartial, pg8::OneUnit, true, true>(lds, g, S, E); }
    }
    SEAM(10);
    if (IN(11)) final_sample(P, P.ds, wave, lane, vcu, G);
#undef IN
#undef SEAM
}

extern "C" void kernel_launch(void* const* d_in, const int* in_sizes, int n_in, void* d_out, int out_size, void* d_ws, size_t ws_size, hipStream_t stream) {
    static int grid = 0;
    if (grid == 0) {
        if (n_in != 22 || (size_t)out_size != O_END || ws_size < WS_END) { fprintf(stderr, "kernel_launch: unexpected shapes (n_in %d, out %d, ws %zu); nothing launched\n", n_in, out_size, ws_size); grid = -1; return; }
        int dev = 0, cus = 0, per_cu = 0;
        if (hipGetDevice(&dev) != hipSuccess || hipDeviceGetAttribute(&cus, hipDeviceAttributeMultiprocessorCount, dev) != hipSuccess) { grid = -1; return; }
        if (hipFuncSetAttribute((const void*)hymba_fwd, hipFuncAttributeMaxDynamicSharedMemorySize, LDS_BYTES) != hipSuccess) { fprintf(stderr, "kernel_launch: hipFuncSetAttribute failed\n"); grid = -1; return; }
        if (hipOccupancyMaxActiveBlocksPerMultiprocessor(&per_cu, (const void*)hymba_fwd, NTHR, LDS_BYTES) != hipSuccess || per_cu < 1) { fprintf(stderr, "kernel_launch: occupancy query says %d blocks per CU\n", per_cu); (void)hipGetLastError(); grid = -1; return; }
        grid = cus;
    }
    if (grid < 0) return;
    if (hipMemsetAsync((char*)d_ws + WS_CTL, 0, CTL_ZERO_BYTES, stream) != hipSuccess) return;
    Args a{};
    for (int i = 0; i < 22; ++i) a.in[i] = (const float*)d_in[i];
    a.out = (float*)d_out; a.ws = (unsigned char*)d_ws;
#if MK_N_LAUNCHES == 1
    void* kargs[] = {&a};
#if PROBE_REP_HI >= 0
    a.ph_lo = 0; a.ph_hi = PROBE_REP_HI + 1; a.bar_region = 1;
    (void)hipLaunchCooperativeKernel((const void*)hymba_fwd, dim3(grid), dim3(NTHR), kargs, LDS_BYTES, stream);
#endif
    a.ph_lo = 0; a.ph_hi = N_PHASES; a.bar_region = 0;
    hipError_t e = hipLaunchCooperativeKernel((const void*)hymba_fwd, dim3(grid), dim3(NTHR), kargs, LDS_BYTES, stream);
    if (e != hipSuccess) fprintf(stderr, "kernel_launch: cooperative launch failed: %s (grid %d)\n", hipGetErrorString(e), grid);
#else
    for (int p = 0; p < N_PHASES; ++p) { a.ph_lo = p; a.ph_hi = p + 1; hipLaunchKernelGGL(hymba_fwd, dim3(grid), dim3(NTHR), LDS_BYTES, stream, a); }
#endif
}
```
